# Optimizing an MI355X kernel written in HIP

```python
import math
import jax, jax.numpy as jnp
from jax import lax
import numpy as np

D_MODEL = 1024
BATCH = 8
SEQ = 2048
DEPTH = 1
DEC_BATCH = 128
DEC_SEQ = 4
PAST_LEN = 16384
PAGE_SIZE = 128

D_SSM = D_MODEL // 2
SSM_GROUP = 16
N_SSM_GROUPS = D_SSM // SSM_GROUP
SSM_STATE = 64
DT_MIN = 1e-3
DT_MAX = 1e-1
D_POOL = D_MODEL - D_SSM
POOL_WINDOWS = (2, 4, 8, 16)
N_POOL_GROUPS = len(POOL_WINDOWS)
POOL_GROUP = D_POOL // N_POOL_GROUPS
POOL_OUT = D_MODEL // N_POOL_GROUPS
POOL_HIST = max(POOL_WINDOWS) - 1
D_FF = -(-8 * D_MODEL // (3 * 256)) * 256
N_MOD = 6
EPS = 1e-6

kernel_name = "s5_pool_gated_hybrid_decode_step"


def rmsnorm(x, g):
    xf = x.astype(jnp.float32)
    y = xf * lax.rsqrt(jnp.mean(xf * xf, axis=-1, keepdims=True) + EPS)
    return (y * g.astype(jnp.float32)).astype(x.dtype)


def modulate(h, shift, scale):
    return h * (1.0 + scale[:, None, :]) + shift[:, None, :]


def cmul(ar, ai, br, bi):
    return ar * br - ai * bi, ar * bi + ai * br


def ssm_combine(e1, e2):
    a1r, a1i, b1r, b1i = e1
    a2r, a2i, b2r, b2i = e2
    ar, ai = cmul(a1r, a1i, a2r, a2i)
    br, bi = cmul(a2r, a2i, b1r, b1i)
    return ar, ai, br + b2r, bi + b2i


def s5_mixer(u, h0_re, h0_im, lam_re, lam_im, log_dt, b_re, b_im, c_re, c_im, d_skip):
    bsz, t_len, _ = u.shape
    uf = u.astype(jnp.float32)
    ug = uf.reshape(bsz, t_len, N_SSM_GROUPS, SSM_GROUP)
    lr = lam_re.astype(jnp.float32)
    li = lam_im.astype(jnp.float32)
    dt = jnp.exp(log_dt.astype(jnp.float32))[:, None]
    mag = jnp.exp(lr * dt)
    abar_r = mag * jnp.cos(li * dt)
    abar_i = mag * jnp.sin(li * dt)
    den = lr * lr + li * li
    nr = abar_r - 1.0
    ni = abar_i
    f_r = (nr * lr + ni * li) / den
    f_i = (ni * lr - nr * li) / den
    bb_r, bb_i = cmul(f_r[..., None], f_i[..., None],
                      b_re.astype(jnp.float32), b_im.astype(jnp.float32))
    bu_r = jnp.einsum('btgc,gpc->btgp', ug, bb_r)
    bu_i = jnp.einsum('btgc,gpc->btgp', ug, bb_i)
    h0r, h0i = cmul(abar_r, abar_i, h0_re.astype(jnp.float32), h0_im.astype(jnp.float32))
    bu_r = bu_r.at[:, 0].add(h0r)
    bu_i = bu_i.at[:, 0].add(h0i)
    a_r = jnp.broadcast_to(abar_r, (1, t_len, N_SSM_GROUPS, SSM_STATE))
    a_i = jnp.broadcast_to(abar_i, (1, t_len, N_SSM_GROUPS, SSM_STATE))
    _, _, s_r, s_i = lax.associative_scan(ssm_combine, (a_r, a_i, bu_r, bu_i), axis=1)
    y = (jnp.einsum('btgp,gcp->btgc', s_r, c_re.astype(jnp.float32))
         - jnp.einsum('btgp,gcp->btgc', s_i, c_im.astype(jnp.float32)))
    y = y.reshape(bsz, t_len, D_SSM) + d_skip.astype(jnp.float32) * uf
    return y, s_r[:, -1], s_i[:, -1]


def pool_mixer(u, buf, pos, w_pool, pool_scale):
    bsz, t_len, _ = u.shape
    uf = u.astype(jnp.float32)
    ext = jnp.concatenate([buf.astype(jnp.float32), uf], axis=1)
    cs = jnp.cumsum(jnp.pad(ext, ((0, 0), (1, 0), (0, 0))), axis=1)
    top = cs[:, POOL_HIST + 1:]
    groups = []
    for k, w in enumerate(POOL_WINDOWS):
        sl = slice(k * POOL_GROUP, (k + 1) * POOL_GROUP)
        lo = cs[:, POOL_HIST + 1 - w:POOL_HIST + 1 - w + t_len, sl]
        count = jnp.minimum(pos + 1, w).astype(jnp.float32)[None, :, None]
        groups.append((top[..., sl] - lo) / count)
    pooled = jnp.concatenate(groups, axis=-1) - uf
    z = jnp.einsum('btgc,gco->btgo',
                   pooled.reshape(bsz, t_len, N_POOL_GROUPS, POOL_GROUP),
                   w_pool.astype(jnp.float32)).reshape(bsz, t_len, D_MODEL)
    z = z * pool_scale.astype(jnp.float32)
    new_buf = ext[:, -POOL_HIST:].astype(u.dtype)
    return z, new_buf


def hybrid_layer(x, c, pos, h0_re, h0_im, pool_buf,
                 norm1_g, norm2_g, w_ada, b_ada, w_in,
                 ssm_lam_re, ssm_lam_im, ssm_log_dt, ssm_b_re, ssm_b_im, ssm_c_re, ssm_c_im, ssm_d,
                 w_glu, w_pool, pool_scale, w_out, w_ffn_in, w_ffn_out):
    bsz = c.shape[0]
    mod = (jax.nn.silu(c.astype(jnp.float32)) @ w_ada + b_ada).reshape(bsz, N_MOD, D_MODEL)
    shift1, scale1, gate1 = mod[:, 0], mod[:, 1], mod[:, 2]
    shift2, scale2, gate2 = mod[:, 3], mod[:, 4], mod[:, 5]

    h = modulate(rmsnorm(x, norm1_g), shift1, scale1)
    proj = h @ w_in
    u_ssm, u_pool, g_ssm, g_pool = jnp.split(
        proj, [D_SSM, D_SSM + D_POOL, D_SSM + D_POOL + D_MODEL], axis=-1)
    y_ssm, h_re, h_im = s5_mixer(u_ssm, h0_re, h0_im, ssm_lam_re, ssm_lam_im, ssm_log_dt,
                                 ssm_b_re, ssm_b_im, ssm_c_re, ssm_c_im, ssm_d)
    glu_a, glu_b = jnp.split(jax.nn.gelu(y_ssm) @ w_glu, 2, axis=-1)
    br_ssm = glu_a * jax.nn.sigmoid(glu_b)
    br_pool, new_buf = pool_mixer(u_pool, pool_buf, pos, w_pool, pool_scale)
    merged = jax.nn.sigmoid(g_ssm) * br_ssm + jax.nn.sigmoid(g_pool) * br_pool
    x = x + gate1[:, None, :] * (merged @ w_out)

    h2 = modulate(rmsnorm(x, norm2_g), shift2, scale2)
    f_a, f_b = jnp.split(h2 @ w_ffn_in, 2, axis=-1)
    x = x + gate2[:, None, :] * ((jax.nn.silu(f_a) * f_b) @ w_ffn_out)
    return x, h_re, h_im, new_buf


def trunk(x, c, pos, st_re, st_im, st_pool, normf_g, params):
    (norm1_g, norm2_g, w_ada, b_ada, w_in, ssm_lam_re, ssm_lam_im, ssm_log_dt, ssm_b_re, ssm_b_im,
     ssm_c_re, ssm_c_im, ssm_d, w_glu, w_pool, pool_scale, w_out, w_ffn_in, w_ffn_out) = params
    out_re, out_im, out_pool = [], [], []
    for l in range(DEPTH):
        x, h_re, h_im, nb = hybrid_layer(
            x, c, pos, st_re[l], st_im[l], st_pool[l],
            norm1_g[l], norm2_g[l], w_ada[l], b_ada[l], w_in[l],
            ssm_lam_re[l], ssm_lam_im[l], ssm_log_dt[l], ssm_b_re[l], ssm_b_im[l],
            ssm_c_re[l], ssm_c_im[l], ssm_d[l], w_glu[l], w_pool[l], pool_scale[l],
            w_out[l], w_ffn_in[l], w_ffn_out[l])
        out_re.append(h_re)
        out_im.append(h_im)
        out_pool.append(nb)
    y = rmsnorm(x, normf_g)
    return y, jnp.stack(out_re), jnp.stack(out_im), jnp.stack(out_pool)


def setup_inputs(seed: int = 0) -> dict:
    key = jax.random.key(seed)
    ks = jax.random.split(key, 32)
    f32 = jnp.float32
    G, P, C = N_SSM_GROUPS, SSM_STATE, SSM_GROUP
    nrm = lambda k, shape, s: jax.random.normal(k, shape, f32) * s
    n_idx = jnp.arange(P, dtype=f32)
    return {
        "x_prompt": nrm(ks[0], (BATCH, SEQ, D_MODEL), 1.0),
        "x_sample": nrm(ks[1], (DEC_BATCH, DEC_SEQ, D_MODEL), 1.0),
        "c_prompt": nrm(ks[2], (BATCH, D_MODEL), 1.0),
        "c_sample": nrm(ks[3], (DEC_BATCH, D_MODEL), 1.0),
        "state_ssm_re": nrm(ks[4], (DEPTH, DEC_BATCH, G, P), 0.3),
        "state_ssm_im": nrm(ks[5], (DEPTH, DEC_BATCH, G, P), 0.3),
        "state_pool": nrm(ks[6], (DEPTH, DEC_BATCH, POOL_HIST, D_POOL), 1.0),
        "norm1_g": 1.0 + nrm(ks[7], (DEPTH, D_MODEL), 0.05),
        "norm2_g": 1.0 + nrm(ks[8], (DEPTH, D_MODEL), 0.05),
        "normf_g": 1.0 + nrm(ks[9], (D_MODEL,), 0.05),
        "w_ada": nrm(ks[10], (DEPTH, D_MODEL, N_MOD * D_MODEL), 0.5 * D_MODEL ** -0.5),
        "b_ada": nrm(ks[11], (DEPTH, N_MOD * D_MODEL), 0.02),
        "w_in": nrm(ks[12], (DEPTH, D_MODEL, D_SSM + D_POOL + 2 * D_MODEL), D_MODEL ** -0.5),
        "ssm_lam_re": -0.5 + nrm(ks[13], (DEPTH, G, P), 0.01),
        "ssm_lam_im": jnp.pi * n_idx + nrm(ks[14], (DEPTH, G, P), 0.01),
        "ssm_log_dt": jax.random.uniform(ks[15], (DEPTH, G), f32,
                                         minval=math.log(DT_MIN), maxval=math.log(DT_MAX)),
        "ssm_b_re": nrm(ks[16], (DEPTH, G, P, C), (2 * C) ** -0.5),
        "ssm_b_im": nrm(ks[17], (DEPTH, G, P, C), (2 * C) ** -0.5),
        "ssm_c_re": nrm(ks[18], (DEPTH, G, C, P), P ** -0.5),
        "ssm_c_im": nrm(ks[19], (DEPTH, G, C, P), P ** -0.5),
        "ssm_d": nrm(ks[20], (DEPTH, D_SSM), 1.0),
        "w_glu": nrm(ks[21], (DEPTH, D_SSM, 2 * D_MODEL), D_SSM ** -0.5),
        "w_pool": nrm(ks[22], (DEPTH, N_POOL_GROUPS, POOL_GROUP, POOL_OUT), POOL_GROUP ** -0.5),
        "pool_scale": 1.0 + nrm(ks[23], (DEPTH, D_MODEL), 0.1),
        "w_out": nrm(ks[24], (DEPTH, D_MODEL, D_MODEL), D_MODEL ** -0.5),
        "w_ffn_in": nrm(ks[25], (DEPTH, D_MODEL, 2 * D_FF), D_MODEL ** -0.5),
        "w_ffn_out": nrm(ks[26], (DEPTH, D_FF, D_MODEL), D_FF ** -0.5),
    }


def reference(x_prompt, x_sample, c_prompt, c_sample, state_ssm_re, state_ssm_im, state_pool,
              norm1_g, norm2_g, normf_g, w_ada, b_ada, w_in,
              ssm_lam_re, ssm_lam_im, ssm_log_dt, ssm_b_re, ssm_b_im, ssm_c_re, ssm_c_im, ssm_d,
              w_glu, w_pool, pool_scale, w_out, w_ffn_in, w_ffn_out):
    params = (norm1_g, norm2_g, w_ada, b_ada, w_in, ssm_lam_re, ssm_lam_im, ssm_log_dt,
              ssm_b_re, ssm_b_im, ssm_c_re, ssm_c_im, ssm_d, w_glu, w_pool, pool_scale,
              w_out, w_ffn_in, w_ffn_out)
    n_prompt, t_prompt = x_prompt.shape[0], x_prompt.shape[1]
    zero_ssm = jnp.zeros((DEPTH, n_prompt, N_SSM_GROUPS, SSM_STATE), jnp.float32)
    zero_pool = jnp.zeros((DEPTH, n_prompt, POOL_HIST, D_POOL), x_prompt.dtype)
    pos_prompt = jnp.arange(t_prompt, dtype=jnp.int32)
    y_prompt, p_ssm_re, p_ssm_im, p_pool = trunk(
        x_prompt, c_prompt, pos_prompt, zero_ssm, zero_ssm, zero_pool, normf_g, params)
    pos_sample = PAST_LEN + jnp.arange(x_sample.shape[1], dtype=jnp.int32)
    y_sample, s_ssm_re, s_ssm_im, s_pool = trunk(
        x_sample, c_sample, pos_sample, state_ssm_re, state_ssm_im, state_pool, normf_g, params)
    return (y_prompt, y_sample, p_ssm_re, p_ssm_im, p_pool, s_ssm_re, s_ssm_im, s_pool)
```

```cpp
#include <hip/hip_runtime.h>
#include <hip/hip_cooperative_groups.h>
#include <cstdio>
#include <cstdint>
namespace cg = cooperative_groups;
namespace pg8 {
#define PG8_LAS __attribute__((address_space(3)))
typedef unsigned short bf16_t;
typedef short bf16x8 __attribute__((ext_vector_type(8)));
typedef float f32x4 __attribute__((ext_vector_type(4)));
typedef unsigned u32x4 __attribute__((ext_vector_type(4)));
constexpr int BM = 256, BK = 64, HALF = 128, HTB = HALF * BK * 2  , STAGE_BYTES = 8 * HTB, NXCD = 8, WGM = 8;

__host__ __device__ __forceinline__ int lds_byte(int r, int c) { const int st = (r >> 4) * 2 + (c >> 5), rr = r & 15, cc = c & 31, ob = rr * 64 + cc * 2; return st * 1024 + (ob ^ (((ob >> 9) & 1) << 5)); }
__host__ __device__ __forceinline__ void stage_rc(int b, int& R, int& C) { const int st = b / 1024, sb = b % 1024, swz = sb ^ (((sb >> 9) & 1) << 5); R = (st >> 1) * 16 + swz / 64; C = (st & 1) * 32 + (swz % 64) / 2; }
__host__ __device__ __forceinline__ int perm32(int rho) { const int n = rho >> 4, i = rho & 15; return 8 * (i >> 2) + 4 * n + (i & 3); }

struct Unit { int pm, pn; };
struct Gemm { const bf16_t* A; const bf16_t* Bt; int M, N, K; };

struct StaticOrder {
    int nM, nN, nwg, G, c;
    __host__ __device__ void init(int M, int N, int G_, int c_) { nM = M / BM; nN = N / BM; nwg = nM * nN; G = G_; c = c_; }
    __host__ __device__ bool next(int i, Unit& u) const {
        const long L = (long)i * G + c; if (L >= nwg) return false;
        int wgid = (int)L; { const int q = nwg / NXCD, r = nwg % NXCD, xcd = wgid % NXCD, off = wgid / NXCD; wgid = (xcd < r ? xcd * (q + 1) : r * (q + 1) + (xcd - r) * q) + off; }
        const int nig = WGM * nN, gid = wgid / nig, fm = gid * WGM, gsz = (nM - fm) < WGM ? (nM - fm) : WGM;
        u.pm = fm + ((wgid % nig) % gsz); u.pn = (wgid % nig) / gsz; return true;
    }
    __device__ __forceinline__ void a_ready(const Unit&) const {}
    __device__ __forceinline__ void done(const Unit&) const {}
};
__device__ __forceinline__ unsigned cvt_pk_bf16(float lo, float hi) { unsigned r; asm volatile("v_cvt_pk_bf16_f32 %0, %1, %2" : "=v"(r) : "v"(lo), "v"(hi)); return r; }
template <class Epi, class Sched, bool ALIGN_EPI = false, bool SP2 = false>
__device__ __forceinline__ void gemm_phase(PG8_LAS unsigned char* lds, const Gemm g, const Sched& S, const Epi& E) {
    const int tid = threadIdx.x, wid = __builtin_amdgcn_readfirstlane(tid >> 6), lane = tid & 63, wr = wid >> 2, wc = wid & 3, fr = lane & 15, fq = lane >> 4;
    const int K = g.K, nt = K / BK;
    unsigned voffA[2], voffB[2];
#pragma unroll
    for (int i = 0; i < 2; ++i) { int R, C; stage_rc(tid * 16 + i * 8192, R, C); const int Rb = Epi::PERM ? ((R & ~31) + perm32(R & 31)) : R;
        voffA[i] = (unsigned)(R * K + C) * 2u; voffB[i] = (unsigned)(Rb * K + C) * 2u; }
    const size_t kstep = (size_t)(BK * 2);
    const size_t hstep = (size_t)HALF * K * 2;
    const size_t tstep = 2 * hstep;
    const unsigned ldsw = (unsigned)wid * 1024u;
    const int aoff = lds_byte(wr * 64 + fr, fq * 8), boff = lds_byte(wc * 32 + fr, fq * 8);
#define PG8_SA(b, h) (((b) * 2 + (h)) * HTB)
#define PG8_SB(b, h) ((4 + (b) * 2 + (h)) * HTB)
#define PG8_STAGE(bufoff, gbase, voff) do { _Pragma("unroll") for (int _i = 0; _i < 2; ++_i) \
        __builtin_amdgcn_global_load_lds((const unsigned*)((const char*)(gbase) + (voff)[_i]), (PG8_LAS unsigned*)(lds + (bufoff) + ldsw + _i * 8192), 16, 0, 0); } while (0)
#define PG8_LDA(dst, b, h) do { _Pragma("unroll") for (int m = 0; m < 4; ++m) _Pragma("unroll") for (int k = 0; k < 2; ++k) dst[m][k] = *(const PG8_LAS bf16x8*)(lds + PG8_SA(b, h) + aoff + m * 2048 + k * 1024); } while (0)
#define PG8_LDB(dst, b, h) do { _Pragma("unroll") for (int n = 0; n < 2; ++n) _Pragma("unroll") for (int k = 0; k < 2; ++k) dst[n][k] = *(const PG8_LAS bf16x8*)(lds + PG8_SB(b, h) + boff + n * 2048 + k * 1024); } while (0)
#define PG8_MMA(ai, bj, At, Bt) do { __builtin_amdgcn_s_setprio(1); _Pragma("unroll") for (int m = 0; m < 4; ++m) _Pragma("unroll") for (int n = 0; n < 2; ++n) _Pragma("unroll") for (int k = 0; k < 2; ++k) \
        acc[ai][bj][m][n] = __builtin_amdgcn_mfma_f32_16x16x32_bf16(Bt[n][k], At[m][k], acc[ai][bj][m][n], 0, 0, 0); __builtin_amdgcn_s_setprio(0); } while (0)
#define PG8_WAIT_V(n) asm volatile("s_waitcnt vmcnt(" #n ")" ::: "memory")
#define PG8_WAIT_L(n) asm volatile("s_waitcnt lgkmcnt(" #n ")" ::: "memory")
#define PG8_BAR __builtin_amdgcn_s_barrier()
#define PG8_SCHED __builtin_amdgcn_sched_barrier(0)
    Unit cur, nxt; int ui = 0;
    if (!S.next(0, cur)) return;
    f32x4 acc[2][2][4][2];
#pragma unroll
    for (int a = 0; a < 2; ++a)
#pragma unroll
        for (int b = 0; b < 2; ++b)
#pragma unroll
            for (int m = 0; m < 4; ++m)
#pragma unroll
                for (int n = 0; n < 2; ++n) acc[a][b][m][n] = (f32x4){0.f, 0.f, 0.f, 0.f};
    bf16x8 At[4][2], B0[2][2], B1[2][2];
    const char* cA = (const char*)g.A + (size_t)cur.pm * tstep; const char* cB = (const char*)g.Bt + (size_t)cur.pn * tstep;
    S.a_ready(cur);
    if constexpr (SP2) {
        PG8_STAGE(PG8_SB(0, 0), cB, voffB); PG8_STAGE(PG8_SB(0, 1), cB + hstep, voffB); PG8_STAGE(PG8_SA(0, 0), cA, voffA); PG8_STAGE(PG8_SA(0, 1), cA + hstep, voffA);
        if (wr == 1) PG8_BAR;
        PG8_WAIT_V(2); PG8_BAR;
        PG8_STAGE(PG8_SB(1, 0), cB + kstep, voffB); PG8_STAGE(PG8_SA(1, 0), cA + kstep, voffA); PG8_STAGE(PG8_SB(1, 1), cB + hstep + kstep, voffB);
        PG8_WAIT_V(6); PG8_BAR;
    } else {
        PG8_STAGE(PG8_SB(0, 0), cB, voffB); PG8_STAGE(PG8_SA(0, 0), cA, voffA); PG8_STAGE(PG8_SB(0, 1), cB + hstep, voffB); PG8_STAGE(PG8_SA(0, 1), cA + hstep, voffA);
        if (wr == 1) PG8_BAR;
        PG8_WAIT_V(4); PG8_BAR;
        PG8_STAGE(PG8_SB(1, 0), cB + kstep, voffB); PG8_STAGE(PG8_SA(1, 0), cA + kstep, voffA); PG8_STAGE(PG8_SB(1, 1), cB + hstep + kstep, voffB);
        PG8_WAIT_V(6); PG8_BAR;
    }
    for (;;) {
        const bool has_next = S.next(ui + 1, nxt);
        const char* nA = has_next ? (const char*)g.A + (size_t)nxt.pm * tstep : cA; const char* nB = has_next ? (const char*)g.Bt + (size_t)nxt.pn * tstep : cB;
        for (int t = 0; t < nt; t += 2) {
            const bool last = (t == nt - 2);
            const char* a1 = cA + (size_t)(t + 1) * kstep;
            const char* a2 = last ? nA : cA + (size_t)(t + 2) * kstep; const char* b2 = last ? nB : cB + (size_t)(t + 2) * kstep;
            const char* a3 = a2 + kstep; const char* b3 = b2 + kstep;
            if (last && has_next) S.a_ready(nxt);
            if constexpr (SP2) {
            PG8_LDB(B0, 0, 0); PG8_LDB(B1, 0, 1); PG8_SCHED; PG8_LDA(At, 0, 0); PG8_STAGE(PG8_SA(1, 1), a1 + hstep, voffA);
            PG8_WAIT_V(8); PG8_WAIT_L(0); PG8_BAR; PG8_MMA(0, 0, At, B0); PG8_MMA(0, 1, At, B1); PG8_BAR; PG8_SCHED;
            PG8_LDA(At, 0, 1); PG8_STAGE(PG8_SB(0, 0), b2, voffB); PG8_STAGE(PG8_SB(0, 1), b2 + hstep, voffB); PG8_STAGE(PG8_SA(0, 0), a2, voffA);
            PG8_WAIT_V(8); PG8_WAIT_L(0); PG8_BAR; PG8_MMA(1, 0, At, B0); PG8_MMA(1, 1, At, B1); PG8_BAR; PG8_SCHED;
            PG8_LDB(B0, 1, 0); PG8_LDB(B1, 1, 1); PG8_SCHED; PG8_LDA(At, 1, 0); PG8_STAGE(PG8_SA(0, 1), a2 + hstep, voffA);
            PG8_WAIT_V(8); PG8_WAIT_L(0); PG8_BAR; PG8_MMA(0, 0, At, B0); PG8_MMA(0, 1, At, B1); PG8_BAR; PG8_SCHED;
            PG8_LDA(At, 1, 1); PG8_STAGE(PG8_SB(1, 0), b3, voffB); PG8_STAGE(PG8_SB(1, 1), b3 + hstep, voffB); PG8_STAGE(PG8_SA(1, 0), a3, voffA);
            PG8_WAIT_V(8); PG8_WAIT_L(0); PG8_BAR; PG8_MMA(1, 0, At, B0); PG8_MMA(1, 1, At, B1); PG8_BAR; PG8_SCHED;
            } else {
            PG8_LDB(B0, 0, 0); PG8_SCHED; PG8_LDA(At, 0, 0); PG8_STAGE(PG8_SA(1, 1), a1 + hstep, voffA);
            PG8_WAIT_L(8); PG8_BAR; PG8_WAIT_L(0); PG8_MMA(0, 0, At, B0); PG8_BAR; PG8_SCHED;
            PG8_LDB(B1, 0, 1); PG8_STAGE(PG8_SB(0, 0), b2, voffB);
            PG8_BAR; PG8_WAIT_L(0); PG8_MMA(0, 1, At, B1); PG8_BAR;
            PG8_LDA(At, 0, 1); PG8_STAGE(PG8_SA(0, 0), a2, voffA);
            PG8_BAR; PG8_WAIT_L(0); PG8_MMA(1, 0, At, B0); PG8_BAR; PG8_SCHED;
            PG8_STAGE(PG8_SB(0, 1), b2 + hstep, voffB);
            PG8_WAIT_V(6); PG8_BAR; PG8_MMA(1, 1, At, B1); PG8_BAR;
            PG8_LDB(B0, 1, 0); PG8_SCHED; PG8_LDA(At, 1, 0); PG8_STAGE(PG8_SA(0, 1), a2 + hstep, voffA);
            PG8_WAIT_L(8); PG8_BAR; PG8_WAIT_L(0); PG8_MMA(0, 0, At, B0); PG8_BAR; PG8_SCHED;
            PG8_LDB(B1, 1, 1); PG8_STAGE(PG8_SB(1, 0), b3, voffB);
            PG8_BAR; PG8_WAIT_L(0); PG8_MMA(0, 1, At, B1); PG8_BAR;
            PG8_LDA(At, 1, 1); PG8_STAGE(PG8_SA(1, 0), a3, voffA);
            PG8_BAR; PG8_WAIT_L(0); PG8_MMA(1, 0, At, B0); PG8_BAR; PG8_SCHED;
            PG8_STAGE(PG8_SB(1, 1), b3 + hstep, voffB);
            PG8_WAIT_V(6); PG8_BAR; PG8_MMA(1, 1, At, B1); PG8_BAR;
            }
        }
        if constexpr (ALIGN_EPI) { if (wr == 0) PG8_BAR; }
        if constexpr (!Epi::AFTER_DRAIN) { E(acc, cur, wr, wc, fr, fq); S.done(cur); }
        if (!has_next) break;
#pragma unroll
        for (int a = 0; a < 2; ++a)
#pragma unroll
            for (int b = 0; b < 2; ++b)
#pragma unroll
                for (int m = 0; m < 4; ++m)
#pragma unroll
                    for (int n = 0; n < 2; ++n) acc[a][b][m][n] = (f32x4){0.f, 0.f, 0.f, 0.f};
        cur = nxt; cA = nA; cB = nB; ++ui;
        if constexpr (ALIGN_EPI) { if (wr == 1) PG8_BAR; }
    }
    PG8_WAIT_V(0);
    if constexpr (!ALIGN_EPI) { if (wr == 0) PG8_BAR; }
    PG8_BAR;
    if constexpr (Epi::AFTER_DRAIN) { E.fused(acc, cur, wr, wc, fr, fq, lds, wid, lane); S.done(cur); }
#undef PG8_SA
#undef PG8_SB
#undef PG8_STAGE
#undef PG8_LDA
#undef PG8_LDB
#undef PG8_MMA
#undef PG8_WAIT_V
#undef PG8_WAIT_L
#undef PG8_BAR
#undef PG8_SCHED
}
}

using pg8::f32x4; using pg8::u32x4; using pg8::bf16x8; using pg8::bf16_t; using pg8::Unit; using pg8::cvt_pk_bf16;
typedef unsigned u32x2 __attribute__((ext_vector_type(2)));
typedef float f32x2 __attribute__((ext_vector_type(2)));

constexpr int DM = 1024, NP = 16384, NS = 512, NTOK = NP + NS, NMODROW = 136, DFF = 2816;
constexpr float EPS = 1e-6f;
constexpr int LDS_BYTES = 147456;
constexpr size_t MiB = 1u << 20;
constexpr size_t WS_CTR = 16384;
constexpr size_t WS_MOD = 1 * MiB;
constexpr size_t WS_SP = 5 * MiB;
constexpr size_t WS_MG = 6 * MiB, WS_EG = 10 * MiB, WS_RG = 12 * MiB;
constexpr size_t WS_WIN = 16 * MiB, WS_WGLU = 22 * MiB, WS_WPOOL = 24 * MiB, WS_WOUT = 25 * MiB, WS_WFI = 27 * MiB, WS_WFO = 39 * MiB;
constexpr size_t WS_H = 48 * MiB;
constexpr size_t WS_US = 82 * MiB, WS_UP = 99 * MiB;
constexpr size_t WS_SGS = 116 * MiB, WS_SGP = 149 * MiB;
constexpr size_t WS_GY = 182 * MiB;
constexpr size_t WS_ZS = 199 * MiB;
constexpr size_t WS_XB = 116 * MiB;
constexpr size_t WS_ACT = 116 * MiB;
constexpr int SP_AR = 0, SP_AI = 2048, SP_A16R = 4096, SP_A16I = 6144, SP_BBR = 8192, SP_BBI = 8192 + 32768;

struct Params {
    const float* in[27];
    float* out;
    unsigned char* ws;
    int ph_lo, ph_hi;
};

__device__ __forceinline__ float fsigmoid(float x) { return __builtin_amdgcn_rcpf(1.0f + __builtin_amdgcn_exp2f(-1.44269504089f * x)); }
__device__ __forceinline__ float fsilu(float x) { return x * fsigmoid(x); }
__device__ __forceinline__ float fgelu_tanh(float y) { return y * fsigmoid(1.59576912161f * y * (1.0f + 0.044715f * y * y)); }
__device__ __forceinline__ float bf_lo(unsigned u) { return __builtin_bit_cast(float, u << 16); }
__device__ __forceinline__ float bf_hi(unsigned u) { return __builtin_bit_cast(float, u & 0xffff0000u); }
__device__ __forceinline__ int mrow(int r) { return r < NP ? (r >> 11) : 8 + ((r - NP) >> 2); }
__device__ __forceinline__ bf16x8 pack8(f32x4 a, f32x4 b) {
    u32x4 w; w.x = cvt_pk_bf16(a[0], a[1]); w.y = cvt_pk_bf16(a[2], a[3]); w.z = cvt_pk_bf16(b[0], b[1]); w.w = cvt_pk_bf16(b[2], b[3]);
    return __builtin_bit_cast(bf16x8, w);
}
__device__ __forceinline__ float wave_sum(float v) {
#pragma unroll
    for (int o = 1; o < 64; o <<= 1) v += __shfl_xor(v, o);
    return v;
}
#define MFMA16(a, b, c) __builtin_amdgcn_mfma_f32_16x16x32_bf16((a), (b), (c), 0, 0, 0)

struct EpiG1 {
    static constexpr bool PERM = true, AFTER_DRAIN = false;
    bf16_t *US, *UP, *SGS, *SGP; float* ppool; float* spool;
    __device__ __forceinline__ void emit(int r, int c, int cls, f32x4 v0, f32x4 v1) const {
        if (cls < 2) {
            u32x4 w; w.x = cvt_pk_bf16(v0[0], v0[1]); w.y = cvt_pk_bf16(v0[2], v0[3]); w.z = cvt_pk_bf16(v1[0], v1[1]); w.w = cvt_pk_bf16(v1[2], v1[3]);
            *(u32x4*)(US + (size_t)r * 512 + c) = w;
        } else if (cls < 4) {
            const int cc = c - 512;
            u32x4 w; w.x = cvt_pk_bf16(v0[0], v0[1]); w.y = cvt_pk_bf16(v0[2], v0[3]); w.z = cvt_pk_bf16(v1[0], v1[1]); w.w = cvt_pk_bf16(v1[2], v1[3]);
            *(u32x4*)(UP + (size_t)r * 512 + cc) = w;
            if (r < NP) { const int t = r & 2047; if (t >= 2033) { float* o = ppool + ((size_t)(r >> 11) * 15 + (t - 2033)) * 512 + cc; *(f32x4*)o = v0; *(f32x4*)(o + 4) = v1; } }
            else { const int s = (r - NP) >> 2, i = (r - NP) & 3; float* o = spool + ((size_t)s * 15 + 11 + i) * 512 + cc; *(f32x4*)o = v0; *(f32x4*)(o + 4) = v1; }
        } else {
#pragma unroll
            for (int j = 0; j < 4; ++j) { v0[j] = fsigmoid(v0[j]); v1[j] = fsigmoid(v1[j]); }
            u32x4 w; w.x = cvt_pk_bf16(v0[0], v0[1]); w.y = cvt_pk_bf16(v0[2], v0[3]); w.z = cvt_pk_bf16(v1[0], v1[1]); w.w = cvt_pk_bf16(v1[2], v1[3]);
            if (cls < 8) *(u32x4*)(SGS + (size_t)r * 1024 + (c - 1024)) = w; else *(u32x4*)(SGP + (size_t)r * 1024 + (c - 2048)) = w;
        }
    }
    __device__ __forceinline__ void operator()(const f32x4 (&acc)[2][2][4][2], const Unit& u, int wr, int wc, int fr, int fq) const {
        const int row0 = u.pm * 256 + wr * 64 + fr, colt = u.pn * 256 + wc * 32 + 8 * fq;
#pragma unroll
        for (int ai = 0; ai < 2; ++ai)
#pragma unroll
            for (int m = 0; m < 4; ++m)
#pragma unroll
                for (int bj = 0; bj < 2; ++bj) emit(row0 + ai * 128 + m * 16, colt + bj * 128, u.pn, acc[ai][bj][m][0], acc[ai][bj][m][1]);
    }
};
struct EpiGLU {
    static constexpr bool PERM = true, AFTER_DRAIN = false;
    const bf16_t *SGS, *ZS; bf16_t* MGD;
    __device__ __forceinline__ void operator()(const f32x4 (&acc)[2][2][4][2], const Unit& u, int wr, int wc, int fr, int fq) const {
        const int row0 = u.pm * 256 + wr * 64 + fr, j0 = u.pn * 128 + wc * 32 + 8 * fq;
#pragma unroll
        for (int ai = 0; ai < 2; ++ai)
#pragma unroll
            for (int m = 0; m < 4; ++m) {
                const size_t off = (size_t)(row0 + ai * 128 + m * 16) * 1024 + j0;
                const u32x4 sg = *(const u32x4*)(SGS + off), zs = *(const u32x4*)(ZS + off);
                const f32x4 a0 = acc[ai][0][m][0], a1 = acc[ai][0][m][1], b0 = acc[ai][1][m][0], b1 = acc[ai][1][m][1];
                float o[8];
                o[0] = bf_lo(sg.x) * a0[0] * fsigmoid(b0[0]) + bf_lo(zs.x); o[1] = bf_hi(sg.x) * a0[1] * fsigmoid(b0[1]) + bf_hi(zs.x);
                o[2] = bf_lo(sg.y) * a0[2] * fsigmoid(b0[2]) + bf_lo(zs.y); o[3] = bf_hi(sg.y) * a0[3] * fsigmoid(b0[3]) + bf_hi(zs.y);
                o[4] = bf_lo(sg.z) * a1[0] * fsigmoid(b1[0]) + bf_lo(zs.z); o[5] = bf_hi(sg.z) * a1[1] * fsigmoid(b1[1]) + bf_hi(zs.z);
                o[6] = bf_lo(sg.w) * a1[2] * fsigmoid(b1[2]) + bf_lo(zs.w); o[7] = bf_hi(sg.w) * a1[3] * fsigmoid(b1[3]) + bf_hi(zs.w);
                u32x4 w; w.x = cvt_pk_bf16(o[0], o[1]); w.y = cvt_pk_bf16(o[2], o[3]); w.z = cvt_pk_bf16(o[4], o[5]); w.w = cvt_pk_bf16(o[6], o[7]);
                *(u32x4*)(MGD + off) = w;
            }
    }
};
struct EpiSwiGLU {
    static constexpr bool PERM = true, AFTER_DRAIN = false;
    bf16_t* ACT;
    __device__ __forceinline__ void operator()(const f32x4 (&acc)[2][2][4][2], const Unit& u, int wr, int wc, int fr, int fq) const {
        const int row0 = u.pm * 256 + wr * 64 + fr, j0 = u.pn * 128 + wc * 32 + 8 * fq;
#pragma unroll
        for (int ai = 0; ai < 2; ++ai)
#pragma unroll
            for (int m = 0; m < 4; ++m) {
                const size_t off = (size_t)(row0 + ai * 128 + m * 16) * DFF + j0;
                const f32x4 a0 = acc[ai][0][m][0], a1 = acc[ai][0][m][1], b0 = acc[ai][1][m][0], b1 = acc[ai][1][m][1];
                u32x4 w;
                w.x = cvt_pk_bf16(fsilu(a0[0]) * b0[0], fsilu(a0[1]) * b0[1]); w.y = cvt_pk_bf16(fsilu(a0[2]) * b0[2], fsilu(a0[3]) * b0[3]);
                w.z = cvt_pk_bf16(fsilu(a1[0]) * b1[0], fsilu(a1[1]) * b1[1]); w.w = cvt_pk_bf16(fsilu(a1[2]) * b1[2], fsilu(a1[3]) * b1[3]);
                *(u32x4*)(ACT + off) = w;
            }
    }
};
template <int MODE> struct EpiRes {
    static constexpr bool PERM = false, AFTER_DRAIN = false;
    const float* baseP; const float* baseS; const float* gate; float* out; bf16_t* XB;
    __device__ __forceinline__ void operator()(const f32x4 (&acc)[2][2][4][2], const Unit& u, int wr, int wc, int fr, int fq) const {
        const int row0 = u.pm * 256 + wr * 64 + fr, col0 = u.pn * 256 + wc * 32 + 4 * fq;
#pragma unroll
        for (int ai = 0; ai < 2; ++ai)
#pragma unroll
            for (int m = 0; m < 4; ++m) {
                const int r = row0 + ai * 128 + m * 16;
                const float* bp = (r < NP ? baseP + (size_t)r * DM : baseS + (size_t)(r - NP) * DM) + col0;
                const float* gp = gate + (size_t)mrow(r) * 6144 + col0;
                float* op = out + (size_t)r * DM + col0;
                bf16_t* xp = XB + (size_t)r * DM + col0;
#pragma unroll
                for (int bj = 0; bj < 2; ++bj)
#pragma unroll
                    for (int n = 0; n < 2; ++n) {
                        const f32x4 x = *(const f32x4*)(bp + bj * 128 + n * 16), gt = *(const f32x4*)(gp + bj * 128 + n * 16);
                        const f32x4 v = x + gt * acc[ai][bj][m][n];
                        if (MODE == 0) *(f32x4*)(op + bj * 128 + n * 16) = v;
                        u32x2 w; w.x = cvt_pk_bf16(v[0], v[1]); w.y = cvt_pk_bf16(v[2], v[3]);
                        *(u32x2*)(xp + bj * 128 + n * 16) = w;
                    }
            }
    }
};

__device__ __forceinline__ void transpose_item(const float* W, int ldw, int k0, int n0, bf16_t* WT, int ldt, int drow0, float* scr, int lane) {
    float tv[32];
#pragma unroll
    for (int i = 0; i < 32; ++i) tv[i] = W[(size_t)(k0 + 2 * i + (lane >> 5)) * ldw + n0 + (lane & 31)];
#pragma unroll
    for (int i = 0; i < 32; ++i) scr[(2 * i + (lane >> 5)) * 33 + (lane & 31)] = tv[i];
    asm volatile("s_waitcnt lgkmcnt(0)" ::: "memory");
    const int c = lane & 7;
#pragma unroll
    for (int j = 0; j < 4; ++j) { const int n = (lane >> 3) + 8 * j; const float* s = scr + (8 * c) * 33 + n;
        u32x4 o; o.x = cvt_pk_bf16(s[0 * 33], s[1 * 33]); o.y = cvt_pk_bf16(s[2 * 33], s[3 * 33]); o.z = cvt_pk_bf16(s[4 * 33], s[5 * 33]); o.w = cvt_pk_bf16(s[6 * 33], s[7 * 33]);
        *(u32x4*)(WT + (size_t)(drow0 + n) * ldt + k0 + 8 * c) = o; }
    asm volatile("s_waitcnt lgkmcnt(0)" ::: "memory");
}
__device__ __forceinline__ int glu_row(int n, int half) { return n < half ? 256 * (n >> 7) + (n & 127) : 256 * ((n - half) >> 7) + 128 + ((n - half) & 127); }

constexpr int TR_ITEMS[6] = {16 * 96, 8 * 64, 16 * 32, 16 * 176, 44 * 32, 4 * 2 * 8};
__device__ __forceinline__ void tr_item(const Params& p, int which, int r, float* scr, int lane) {
    if (which == 0) { const int kb = r / 96, nb = r % 96; transpose_item(p.in[12], 3072, 64 * kb, 32 * nb, (bf16_t*)(p.ws + WS_WIN), 1024, 32 * nb, scr, lane); }
    else if (which == 1) { const int kb = r / 64, nb = r % 64; transpose_item(p.in[21], 2048, 64 * kb, 32 * nb, (bf16_t*)(p.ws + WS_WGLU), 512, glu_row(32 * nb, 1024), scr, lane); }
    else if (which == 2) { const int kb = r / 32, nb = r % 32; transpose_item(p.in[24], 1024, 64 * kb, 32 * nb, (bf16_t*)(p.ws + WS_WOUT), 1024, 32 * nb, scr, lane); }
    else if (which == 3) { const int kb = r / 176, nb = r % 176; transpose_item(p.in[25], 5632, 64 * kb, 32 * nb, (bf16_t*)(p.ws + WS_WFI), 1024, glu_row(32 * nb, DFF), scr, lane); }
    else if (which == 4) { const int kb = r / 32, nb = r % 32; transpose_item(p.in[26], 1024, 64 * kb, 32 * nb, (bf16_t*)(p.ws + WS_WFO), DFF, 32 * nb, scr, lane); }
    else { const int gk = r / 16, q = r % 16, kb = q / 8, nb = q % 8; transpose_item(p.in[22] + (size_t)gk * 128 * 256, 256, 64 * kb, 32 * nb, (bf16_t*)(p.ws + WS_WPOOL) + (size_t)gk * 256 * 128, 128, 32 * nb, scr, lane); }
}
__device__ __forceinline__ void ada_unit(const Params& p, int unit, unsigned char* lds, int tid) {
    const int lane = tid & 63, w = tid >> 6, lr = lane & 15, lq = lane >> 4, kq = w & 3, mh = w >> 2;
    const int n0 = unit * 32, mt0 = mh ? 5 : 0, mcnt = mh ? 4 : 5;
    const float* cp = p.in[2]; const float* cs = p.in[3]; const float* wa = p.in[10]; const float* ba = p.in[11];
    float* mod = (float*)(p.ws + WS_MOD);
    float* red = (float*)lds;
    f32x4 acc[5][2];
#pragma unroll
    for (int i = 0; i < 5; ++i) { acc[i][0] = (f32x4){0.f, 0.f, 0.f, 0.f}; acc[i][1] = (f32x4){0.f, 0.f, 0.f, 0.f}; }
#pragma unroll 2
    for (int ks = 0; ks < 8; ++ks) {
        const int k0 = kq * 256 + ks * 32 + 8 * lq;
        bf16x8 bfr[2];
#pragma unroll
        for (int nt = 0; nt < 2; ++nt) {
            const float* bp = wa + (size_t)k0 * 6144 + n0 + 16 * nt + lr;
            f32x4 x0, x1;
            x0[0] = bp[0]; x0[1] = bp[6144]; x0[2] = bp[2 * 6144]; x0[3] = bp[3 * 6144]; x1[0] = bp[4 * 6144]; x1[1] = bp[5 * 6144]; x1[2] = bp[6 * 6144]; x1[3] = bp[7 * 6144];
            bfr[nt] = pack8(x0, x1);
        }
#pragma unroll
        for (int mi = 0; mi < 5; ++mi) {
            if (mi < mcnt) {
                const int row = 16 * (mt0 + mi) + lr;
                f32x4 x0 = (f32x4){0.f, 0.f, 0.f, 0.f}, x1 = x0;
                if (row < NMODROW) { const float* ap = (row < 8 ? cp + (size_t)row * DM : cs + (size_t)(row - 8) * DM) + k0; x0 = *(const f32x4*)ap; x1 = *(const f32x4*)(ap + 4); }
#pragma unroll
                for (int j = 0; j < 4; ++j) { x0[j] = fsilu(x0[j]); x1[j] = fsilu(x1[j]); }
                const bf16x8 af = pack8(x0, x1);
                acc[mi][0] = MFMA16(bfr[0], af, acc[mi][0]); acc[mi][1] = MFMA16(bfr[1], af, acc[mi][1]);
            }
        }
    }
#pragma unroll
    for (int mi = 0; mi < 5; ++mi) if (mi < mcnt) {
        const int row = 16 * (mt0 + mi) + lr;
        *(f32x4*)(red + ((size_t)(kq * 144 + row)) * 32 + 4 * lq) = acc[mi][0];
        *(f32x4*)(red + ((size_t)(kq * 144 + row)) * 32 + 16 + 4 * lq) = acc[mi][1];
    }
    __syncthreads();
    for (int o = tid; o < NMODROW * 32; o += 512) {
        const int row = o >> 5, col = o & 31;
        const float v = ((red[(0 * 144 + row) * 32 + col] + red[(1 * 144 + row) * 32 + col]) + (red[(2 * 144 + row) * 32 + col] + red[(3 * 144 + row) * 32 + col])) + ba[n0 + col];
        mod[(size_t)row * 6144 + n0 + col] = v;
    }
    __syncthreads();
}

__device__ __forceinline__ void ssm_prep_unit(const Params& p, int g, int part, unsigned char* lds, int tid) {
    float* L = (float*)lds;
    float* pwr = L;            float* pwi = L + 17 * 64;
    float* bbr = L + 2176;     float* bbi = bbr + 1024;
    float* crT = bbi + 1024;   float* ciT = crT + 1024;
    float* ktab = ciT + 1024;
    float* spf = (float*)(p.ws + WS_SP);
    bf16_t* MG = (bf16_t*)(p.ws + WS_MG) + (size_t)g * 256 * 256;
    bf16_t* EG = (bf16_t*)(p.ws + WS_EG) + (size_t)g * 256 * 128;
    bf16_t* RG = (bf16_t*)(p.ws + WS_RG) + (size_t)g * 128 * 256;
    const float dt = expf(p.in[15][g]);
    for (int i = tid; i < 17 * 64; i += 512) {
        const int pp = i & 63, d = i >> 6, gp = g * 64 + pp;
        const float lr = p.in[13][gp], li = p.in[14][gp];
        const float mag = expf(lr * dt * (float)d), ang = li * dt * (float)d; float sn, cs; sincosf(ang, &sn, &cs); pwr[d * 64 + pp] = mag * cs; pwi[d * 64 + pp] = mag * sn;
    }
    for (int i = tid; i < 1024; i += 512) {
        const int pp = i >> 4, c = i & 15, gp = g * 64 + pp;
        const float lr = p.in[13][gp], li = p.in[14][gp];
        const float mag = expf(lr * dt), ang = li * dt; float sn, cs; sincosf(ang, &sn, &cs);
        const float abr = mag * cs, abi = mag * sn, den = lr * lr + li * li, nr = abr - 1.0f, ni = abi;
        const float fr = (nr * lr + ni * li) / den, fi = (ni * lr - nr * li) / den;
        const float br = p.in[16][(size_t)gp * 16 + c], bi = p.in[17][(size_t)gp * 16 + c];
        const float xr = fr * br - fi * bi, xi = fr * bi + fi * br; bbr[pp * 16 + c] = xr; bbi[pp * 16 + c] = xi;
        if (part == 2) { spf[SP_BBR + gp * 16 + c] = xr; spf[SP_BBI + gp * 16 + c] = xi; }
    }
    for (int i = tid; i < 1024; i += 512) { const int c = i >> 6, pp = i & 63; crT[pp * 16 + c] = p.in[18][(size_t)(g * 16 + c) * 64 + pp]; ciT[pp * 16 + c] = p.in[19][(size_t)(g * 16 + c) * 64 + pp]; }
    __syncthreads();
    if (part == 0) {
        {
            const int pair = tid & 255, d = pair >> 4, c2 = pair & 15, ch = tid >> 8;
            float a8[8];
#pragma unroll
            for (int i = 0; i < 8; ++i) a8[i] = 0.f;
#pragma unroll 8
            for (int pp = 0; pp < 64; ++pp) {
                const float ar = pwr[d * 64 + pp], ai = pwi[d * 64 + pp], br = bbr[pp * 16 + c2], bi = bbi[pp * 16 + c2];
                const float tr = ar * br - ai * bi, ti = ar * bi + ai * br;
                const f32x4 cr0 = *(const f32x4*)(crT + pp * 16 + 8 * ch), cr1 = *(const f32x4*)(crT + pp * 16 + 8 * ch + 4);
                const f32x4 ci0 = *(const f32x4*)(ciT + pp * 16 + 8 * ch), ci1 = *(const f32x4*)(ciT + pp * 16 + 8 * ch + 4);
#pragma unroll
                for (int i = 0; i < 4; ++i) { a8[i] += cr0[i] * tr - ci0[i] * ti; a8[4 + i] += cr1[i] * tr - ci1[i] * ti; }
            }
#pragma unroll
            for (int i = 0; i < 8; ++i) { const int c = 8 * ch + i; float v = a8[i]; if (d == 0 && c == c2) v += p.in[20][g * 16 + c]; ktab[d * 256 + c * 16 + c2] = v; }
        }
        __syncthreads();
        for (int idx = tid; idx < 8192; idx += 512) {
            const int n = idx >> 5, kk = (idx & 31) * 8, tau = n >> 4, c = n & 15, tp = kk >> 4, c0 = kk & 15;
            f32x4 x0 = (f32x4){0.f, 0.f, 0.f, 0.f}, x1 = x0;
            if (tau >= tp) { const float* s = ktab + (tau - tp) * 256 + c * 16 + c0; x0 = *(const f32x4*)s; x1 = *(const f32x4*)(s + 4); }
            *(bf16x8*)(MG + (size_t)n * 256 + kk) = pack8(x0, x1);
        }
    } else if (part == 1) {
        for (int idx = tid; idx < 4096; idx += 512) {
            const int n = idx >> 4, q0 = (idx & 15) * 8, tau = n >> 4, c = n & 15;
            float v[8];
#pragma unroll
            for (int j = 0; j < 8; ++j) { const int q = q0 + j, pp = q & 63; const float pr = pwr[(tau + 1) * 64 + pp], pi = pwi[(tau + 1) * 64 + pp], cr = crT[pp * 16 + c], ci = ciT[pp * 16 + c];
                v[j] = q < 64 ? (cr * pr - ci * pi) : -(cr * pi + ci * pr); }
            *(bf16x8*)(EG + (size_t)n * 128 + q0) = pack8((f32x4){v[0], v[1], v[2], v[3]}, (f32x4){v[4], v[5], v[6], v[7]});
        }
    } else {
        if (tid < 64) { const int gp = g * 64 + tid; spf[SP_AR + gp] = pwr[64 + tid]; spf[SP_AI + gp] = pwi[64 + tid]; spf[SP_A16R + gp] = pwr[16 * 64 + tid]; spf[SP_A16I + gp] = pwi[16 * 64 + tid]; }
        for (int idx = tid; idx < 4096; idx += 512) {
            const int q = idx >> 5, kk = (idx & 31) * 8, tp = kk >> 4, c0 = kk & 15, pp = q & 63;
            const float pr = pwr[(15 - tp) * 64 + pp], pi = pwi[(15 - tp) * 64 + pp];
            const f32x4 br0 = *(const f32x4*)(bbr + pp * 16 + c0), br1 = *(const f32x4*)(bbr + pp * 16 + c0 + 4), bi0 = *(const f32x4*)(bbi + pp * 16 + c0), bi1 = *(const f32x4*)(bbi + pp * 16 + c0 + 4);
            const f32x4 v0 = q < 64 ? (br0 * pr - bi0 * pi) : (bi0 * pr + br0 * pi), v1 = q < 64 ? (br1 * pr - bi1 * pi) : (bi1 * pr + br1 * pi);
            *(bf16x8*)(RG + (size_t)q * 256 + kk) = pack8(v0, v1);
        }
    }
    __syncthreads();
}

template <bool BF> __device__ __forceinline__ void modnorm_rows(const float* xa, const float* xb, const float* gvec, const float* mod, int jshift, int jscale, bf16_t* H, int rbeg, int rend, int wave, int lane) {
    for (int r0 = rbeg + wave; r0 < rend; r0 += 16) {
        const int rr[2] = {r0, (r0 + 8 < rend) ? r0 + 8 : r0};
        f32x4 v[2][4], sc[2][4], sh[2][4], gg[4];
#pragma unroll
        for (int h = 0; h < 2; ++h) {
            const int r = rr[h];
            const float* xr = (r < NP ? xa + (size_t)r * DM : xb + (size_t)(r - NP) * DM) + 4 * lane;
            const bf16_t* xbr = (const bf16_t*)xa + (size_t)r * DM + 4 * lane;
#pragma unroll
            for (int j = 0; j < 4; ++j) { if (BF) { const u32x2 q = *(const u32x2*)(xbr + 256 * j); v[h][j] = (f32x4){bf_lo(q.x), bf_hi(q.x), bf_lo(q.y), bf_hi(q.y)}; } else v[h][j] = *(const f32x4*)(xr + 256 * j); }
            const float* mr = mod + (size_t)mrow(r) * 6144 + 4 * lane;
#pragma unroll
            for (int j = 0; j < 4; ++j) { sc[h][j] = *(const f32x4*)(mr + jscale * DM + 256 * j); sh[h][j] = *(const f32x4*)(mr + jshift * DM + 256 * j); }
        }
#pragma unroll
        for (int j = 0; j < 4; ++j) gg[j] = *(const f32x4*)(gvec + 4 * lane + 256 * j);
        float s[2];
#pragma unroll
        for (int h = 0; h < 2; ++h) { s[h] = 0.f;
#pragma unroll
            for (int j = 0; j < 4; ++j) s[h] += (v[h][j][0] * v[h][j][0] + v[h][j][1] * v[h][j][1]) + (v[h][j][2] * v[h][j][2] + v[h][j][3] * v[h][j][3]); }
#pragma unroll
        for (int o = 1; o < 64; o <<= 1) { s[0] += __shfl_xor(s[0], o); s[1] += __shfl_xor(s[1], o); }
#pragma unroll
        for (int h = 0; h < 2; ++h) {
            const float inv = rsqrtf(s[h] * (1.0f / DM) + EPS);
            if (h == 0 || rr[1] != rr[0]) {
#pragma unroll
                for (int j = 0; j < 4; ++j) {
                    const f32x4 hv = (v[h][j] * inv) * gg[j] * (sc[h][j] + 1.0f) + sh[h][j];
                    u32x2 w; w.x = cvt_pk_bf16(hv[0], hv[1]); w.y = cvt_pk_bf16(hv[2], hv[3]);
                    *(u32x2*)(H + (size_t)rr[h] * DM + 4 * lane + 256 * j) = w;
                }
            }
        }
    }
}

constexpr int UP_PITCH = 264;
constexpr int RS_PITCH = 132;
__device__ __forceinline__ void ssm_block(const Params& p, int b, int g, unsigned char* lds, int tid) {
    const int lane = tid & 63, w = tid >> 6, lr = lane & 15, lq = lane >> 4;
    bf16_t* U = (bf16_t*)lds;
    float* RS = (float*)(lds + 128 * UP_PITCH * 2);
    const bf16_t* US = (const bf16_t*)(p.ws + WS_US);
    bf16_t* GY = (bf16_t*)(p.ws + WS_GY);
    const float* spf = (const float*)(p.ws + WS_SP);
    u32x4 uraw[8];
#pragma unroll
    for (int i = 0; i < 8; ++i) { const int q = tid + 512 * i, tok = q >> 1, half = q & 1; uraw[i] = *(const u32x4*)(US + ((size_t)(b * 2048 + tok) * 512 + g * 16 + half * 8)); }
    const bf16_t* Rb = (const bf16_t*)(p.ws + WS_RG) + ((size_t)g * 128 + 16 * w + lr) * 256 + 8 * lq;
    bf16x8 rf[8];
#pragma unroll
    for (int ks = 0; ks < 8; ++ks) rf[ks] = *(const bf16x8*)(Rb + 32 * ks);
    const bf16_t* Mb = (const bf16_t*)(p.ws + WS_MG) + ((size_t)g * 256 + 32 * w + lr) * 256 + 8 * lq;
    bf16x8 m0[8], m1[8];
#pragma unroll
    for (int ks = 0; ks < 8; ++ks) { m0[ks] = *(const bf16x8*)(Mb + 32 * ks); m1[ks] = *(const bf16x8*)(Mb + 16 * 256 + 32 * ks); }
#pragma unroll
    for (int i = 0; i < 8; ++i) { const int q = tid + 512 * i, tok = q >> 1, half = q & 1; *(u32x4*)(U + (tok >> 4) * UP_PITCH + (tok & 15) * 16 + half * 8) = uraw[i]; }
    __syncthreads();
    f32x4 acc[8][2];
    {
        f32x4 acc1[8];
#pragma unroll
        for (int i = 0; i < 8; ++i) acc1[i] = (f32x4){0.f, 0.f, 0.f, 0.f};
#pragma unroll
        for (int ks = 0; ks < 8; ++ks) {
#pragma unroll
            for (int mt = 0; mt < 8; ++mt) { const bf16x8 af = *(const bf16x8*)(U + (16 * mt + lr) * UP_PITCH + 32 * ks + 8 * lq); acc1[mt] = MFMA16(rf[ks], af, acc1[mt]); }
            __builtin_amdgcn_sched_barrier(0);
        }
#pragma unroll
        for (int mt = 0; mt < 8; ++mt) *(f32x4*)(RS + (16 * mt + lr) * RS_PITCH + 16 * w + 4 * lq) = acc1[mt];
    }
    {
#pragma unroll
        for (int i = 0; i < 8; ++i) { acc[i][0] = (f32x4){0.f, 0.f, 0.f, 0.f}; acc[i][1] = (f32x4){0.f, 0.f, 0.f, 0.f}; }
#pragma unroll
        for (int ks = 0; ks < 8; ++ks) if (ks <= w) {
#pragma unroll
            for (int mt = 0; mt < 8; ++mt) { const bf16x8 af = *(const bf16x8*)(U + (16 * mt + lr) * UP_PITCH + 32 * ks + 8 * lq);
                acc[mt][0] = MFMA16(m0[ks], af, acc[mt][0]); acc[mt][1] = MFMA16(m1[ks], af, acc[mt][1]); }
            __builtin_amdgcn_sched_barrier(0);
        }
    }
    const bf16_t* Eb = (const bf16_t*)(p.ws + WS_EG) + ((size_t)g * 256 + 32 * w + lr) * 128 + 8 * lq;
    bf16x8 e0[4], e1[4];
#pragma unroll
    for (int ks = 0; ks < 4; ++ks) { e0[ks] = *(const bf16x8*)(Eb + 32 * ks); e1[ks] = *(const bf16x8*)(Eb + 16 * 128 + 32 * ks); }
    __syncthreads();
    {
        float* TT = RS + 128 * RS_PITCH;
        const int gp = g * 64 + lane; const float ar = spf[SP_A16R + gp], ai = spf[SP_A16I + gp];
        float sr = 0.f, si = 0.f;
#pragma unroll
        for (int jj = 0; jj < 16; ++jj) {
            const int j = 16 * w + jj;
            const float rr = RS[j * RS_PITCH + lane], ri = RS[j * RS_PITCH + 64 + lane];
            RS[j * RS_PITCH + lane] = sr; RS[j * RS_PITCH + 64 + lane] = si;
            const float nr = ar * sr - ai * si + rr, ni = ar * si + ai * sr + ri; sr = nr; si = ni;
        }
        TT[w * 128 + lane] = sr; TT[w * 128 + 64 + lane] = si;
        float br = ar, bi = ai;
#pragma unroll
        for (int i = 0; i < 4; ++i) { const float xr = br * br - bi * bi, xi = 2.0f * br * bi; br = xr; bi = xi; }
        __syncthreads();
        float cr = 0.f, ci = 0.f;
        for (int v = 0; v < w; ++v) { const float tr = TT[v * 128 + lane], ti = TT[v * 128 + 64 + lane]; const float nr = br * cr - bi * ci + tr, ni = br * ci + bi * cr + ti; cr = nr; ci = ni; }
        float pr = 1.f, pi = 0.f;
#pragma unroll
        for (int jj = 0; jj < 16; ++jj) {
            const int j = 16 * w + jj;
            RS[j * RS_PITCH + lane] += pr * cr - pi * ci; RS[j * RS_PITCH + 64 + lane] += pr * ci + pi * cr;
            const float nr = pr * ar - pi * ai, ni = pr * ai + pi * ar; pr = nr; pi = ni;
        }
        if (w == 7) {
            float* ore = p.out + (size_t)NTOK * DM; float* oim = ore + 16384;
            ore[(size_t)(b * 32 + g) * 64 + lane] = br * cr - bi * ci + sr; oim[(size_t)(b * 32 + g) * 64 + lane] = br * ci + bi * cr + si;
        }
    }
    __syncthreads();
    {
#pragma unroll
        for (int ks = 0; ks < 4; ++ks) {
#pragma unroll
            for (int mt = 0; mt < 8; ++mt) { const float* f = RS + (16 * mt + lr) * RS_PITCH + 32 * ks + 8 * lq;
                const bf16x8 af = pack8(*(const f32x4*)f, *(const f32x4*)(f + 4));
                acc[mt][0] = MFMA16(e0[ks], af, acc[mt][0]); acc[mt][1] = MFMA16(e1[ks], af, acc[mt][1]); }
            __builtin_amdgcn_sched_barrier(0);
        }
#pragma unroll
        for (int mt = 0; mt < 8; ++mt)
#pragma unroll
            for (int nt = 0; nt < 2; ++nt) {
                const int j = 16 * mt + lr, tau = 2 * w + nt; const size_t row = (size_t)b * 2048 + 16 * j + tau;
                const f32x4 y = acc[mt][nt];
                u32x2 o; o.x = cvt_pk_bf16(fgelu_tanh(y[0]), fgelu_tanh(y[1])); o.y = cvt_pk_bf16(fgelu_tanh(y[2]), fgelu_tanh(y[3]));
                *(u32x2*)(GY + row * 512 + g * 16 + 4 * lq) = o;
            }
    }
    __syncthreads();
}

__device__ __forceinline__ void ssm_sample_item(const Params& p, int s, int g, int lane) {
    const bf16_t* US = (const bf16_t*)(p.ws + WS_US);
    bf16_t* GY = (bf16_t*)(p.ws + WS_GY);
    const float* spf = (const float*)(p.ws + WS_SP);
    const int gp = g * 64 + lane;
    const float ar = spf[SP_AR + gp], ai = spf[SP_AI + gp];
    float bbr[16], bbi[16];
#pragma unroll
    for (int i = 0; i < 4; ++i) { const f32x4 x = *(const f32x4*)(spf + SP_BBR + (size_t)gp * 16 + 4 * i), y = *(const f32x4*)(spf + SP_BBI + (size_t)gp * 16 + 4 * i);
#pragma unroll
        for (int j = 0; j < 4; ++j) { bbr[4 * i + j] = x[j]; bbi[4 * i + j] = y[j]; } }
    float hr = p.in[4][(size_t)(s * 32 + g) * 64 + lane], hi = p.in[5][(size_t)(s * 32 + g) * 64 + lane];
    float sr[4], si[4];
#pragma unroll
    for (int t = 0; t < 4; ++t) {
        const bf16_t* up = US + (size_t)(NP + 4 * s + t) * 512 + g * 16;
        const u32x4 u0 = *(const u32x4*)up, u1 = *(const u32x4*)(up + 8);
        float uu[16];
        uu[0] = bf_lo(u0.x); uu[1] = bf_hi(u0.x); uu[2] = bf_lo(u0.y); uu[3] = bf_hi(u0.y); uu[4] = bf_lo(u0.z); uu[5] = bf_hi(u0.z); uu[6] = bf_lo(u0.w); uu[7] = bf_hi(u0.w);
        uu[8] = bf_lo(u1.x); uu[9] = bf_hi(u1.x); uu[10] = bf_lo(u1.y); uu[11] = bf_hi(u1.y); uu[12] = bf_lo(u1.z); uu[13] = bf_hi(u1.z); uu[14] = bf_lo(u1.w); uu[15] = bf_hi(u1.w);
        float br = 0.f, bi = 0.f;
#pragma unroll
        for (int c = 0; c < 16; ++c) { br += bbr[c] * uu[c]; bi += bbi[c] * uu[c]; }
        const float nr = ar * hr - ai * hi + br, ni = ar * hi + ai * hr + bi; hr = nr; hi = ni; sr[t] = hr; si[t] = hi;
    }
    float* ore = p.out + (size_t)NTOK * DM + 16384 + 16384 + 61440; float* oim = ore + 262144;
    ore[(size_t)(s * 32 + g) * 64 + lane] = hr; oim[(size_t)(s * 32 + g) * 64 + lane] = hi;
    float v[64];
#pragma unroll
    for (int c = 0; c < 16; ++c) { const float cr = p.in[18][(size_t)(g * 16 + c) * 64 + lane], ci = p.in[19][(size_t)(g * 16 + c) * 64 + lane];
#pragma unroll
        for (int t = 0; t < 4; ++t) v[t * 16 + c] = sr[t] * cr - si[t] * ci; }
#define TR_STEP(OFF) { const bool up = (lane & OFF) != 0; _Pragma("unroll") for (int i = 0; i < OFF; ++i) { const float snd = up ? v[i] : v[i + OFF], kp = up ? v[i + OFF] : v[i]; v[i] = kp + __shfl_xor(snd, OFF); } }
    TR_STEP(32) TR_STEP(16) TR_STEP(8) TR_STEP(4) TR_STEP(2) TR_STEP(1)
#undef TR_STEP
    const int t = lane >> 4, c = lane & 15; const size_t row = (size_t)NP + 4 * s + t;
    const float uval = __builtin_bit_cast(float, ((unsigned)US[row * 512 + g * 16 + c]) << 16);
    const float y = v[0] + p.in[20][g * 16 + c] * uval;
    GY[row * 512 + g * 16 + c] = (bf16_t)(cvt_pk_bf16(fgelu_tanh(y), 0.f) & 0xffffu);
}

constexpr int PA_PITCH = 136;
template <int KG> __device__ __forceinline__ void pool_fill(const Params& p, int r0, bf16_t* A, int tid) {
    constexpr int WIN = 2 << KG;
    const bf16_t* UPb = (const bf16_t*)(p.ws + WS_UP);
    const int cp = tid & 63, seg = tid >> 6, ch = 128 * KG + 2 * cp, base = r0 + 16 * seg;
    constexpr float rw = 1.0f / (float)WIN;
    if (r0 < NP) {
        const int t0 = base & 2047;
        unsigned raw[WIN - 1 + 16];
#pragma unroll
        for (int e = 0; e < WIN - 1 + 16; ++e) { const int rel = e - (WIN - 1); raw[e] = (t0 + rel >= 0) ? *(const unsigned*)(UPb + (size_t)(base + rel) * 512 + ch) : 0u; }
        float s0 = 0.f, s1 = 0.f;
#pragma unroll
        for (int e = 0; e < WIN - 1; ++e) { s0 += bf_lo(raw[e]); s1 += bf_hi(raw[e]); }
#pragma unroll
        for (int i = 0; i < 16; ++i) {
            const int t = t0 + i; const float c0 = bf_lo(raw[WIN - 1 + i]), c1 = bf_hi(raw[WIN - 1 + i]);
            s0 += c0; s1 += c1;
            const float rc = (t + 1 < WIN) ? 1.0f / (float)(t + 1) : rw;
            *(unsigned*)(A + (16 * seg + i) * PA_PITCH + 2 * cp) = cvt_pk_bf16(s0 * rc - c0, s1 * rc - c1);
            s0 -= bf_lo(raw[i]); s1 -= bf_hi(raw[i]);
        }
    } else {
        const float* sp = p.in[6];
#pragma unroll
        for (int q = 0; q < 4; ++q) {
            const int r = base + 4 * q, sidx = (r - NP) >> 2;
            float e0[WIN - 1 + 4], e1[WIN - 1 + 4];
#pragma unroll
            for (int e = 0; e < WIN - 1; ++e) { const f32x2 v = *(const f32x2*)(sp + ((size_t)sidx * 15 + (15 - (WIN - 1)) + e) * 512 + ch); e0[e] = v[0]; e1[e] = v[1]; }
#pragma unroll
            for (int i = 0; i < 4; ++i) { const unsigned v = *(const unsigned*)(UPb + (size_t)(r + i) * 512 + ch); e0[WIN - 1 + i] = bf_lo(v); e1[WIN - 1 + i] = bf_hi(v); }
            float s0 = 0.f, s1 = 0.f;
#pragma unroll
            for (int e = 0; e < WIN - 1; ++e) { s0 += e0[e]; s1 += e1[e]; }
#pragma unroll
            for (int i = 0; i < 4; ++i) {
                const float c0 = e0[WIN - 1 + i], c1 = e1[WIN - 1 + i];
                s0 += c0; s1 += c1;
                *(unsigned*)(A + (16 * seg + 4 * q + i) * PA_PITCH + 2 * cp) = cvt_pk_bf16(s0 * rw - c0, s1 * rw - c1);
                s0 -= e0[i]; s1 -= e1[i];
            }
        }
    }
}
template <int KG> __device__ __forceinline__ void pool_fill2(const Params& p, int r0a, int r0b, bf16_t* A, int tid) {
    constexpr int WIN = 2 << KG, NR = WIN - 1 + 16;
    const bf16_t* UPb = (const bf16_t*)(p.ws + WS_UP);
    const int cp = tid & 63, seg = tid >> 6, ch = 128 * KG + 2 * cp;
    constexpr float rw = 1.0f / (float)WIN;
    unsigned raw[2][NR];
#pragma unroll
    for (int h = 0; h < 2; ++h) { const int base = (h ? r0b : r0a) + 16 * seg, t0 = base & 2047;
#pragma unroll
        for (int e = 0; e < NR; ++e) { const int rel = e - (WIN - 1); raw[h][e] = (t0 + rel >= 0) ? *(const unsigned*)(UPb + (size_t)(base + rel) * 512 + ch) : 0u; } }
#pragma unroll
    for (int h = 0; h < 2; ++h) { const int base = (h ? r0b : r0a) + 16 * seg, t0 = base & 2047;
        float s0 = 0.f, s1 = 0.f;
#pragma unroll
        for (int e = 0; e < WIN - 1; ++e) { s0 += bf_lo(raw[h][e]); s1 += bf_hi(raw[h][e]); }
#pragma unroll
        for (int i = 0; i < 16; ++i) {
            const int t = t0 + i; const float c0 = bf_lo(raw[h][WIN - 1 + i]), c1 = bf_hi(raw[h][WIN - 1 + i]);
            s0 += c0; s1 += c1;
            const float rc = (t + 1 < WIN) ? 1.0f / (float)(t + 1) : rw;
            *(unsigned*)(A + (h * 128 + 16 * seg + i) * PA_PITCH + 2 * cp) = cvt_pk_bf16(s0 * rc - c0, s1 * rc - c1);
            s0 -= bf_lo(raw[h][i]); s1 -= bf_hi(raw[h][i]);
        }
    }
}
__device__ __forceinline__ void pool_pair(const Params& p, int rt, int k, unsigned char* lds, int tid) {
    const int lane = tid & 63, w8 = tid >> 6, lr = lane & 15, lq = lane >> 4;
    bf16_t* A = (bf16_t*)lds;
    const bf16_t* Wb = (const bf16_t*)(p.ws + WS_WPOOL) + ((size_t)k * 256 + 32 * w8 + lr) * 128 + 8 * lq;
    bf16x8 b0[4], b1[4];
#pragma unroll
    for (int ks = 0; ks < 4; ++ks) { b0[ks] = *(const bf16x8*)(Wb + 32 * ks); b1[ks] = *(const bf16x8*)(Wb + 16 * 128 + 32 * ks); }
    const int colb = k * 256 + 32 * w8 + 4 * lq;
    const f32x4 ps0 = *(const f32x4*)(p.in[23] + colb), ps1 = *(const f32x4*)(p.in[23] + colb + 16);
    const int r0a = rt * 128, r0b = (rt + 64) * 128;
    if (k == 0) pool_fill2<0>(p, r0a, r0b, A, tid); else if (k == 1) pool_fill2<1>(p, r0a, r0b, A, tid); else if (k == 2) pool_fill2<2>(p, r0a, r0b, A, tid); else pool_fill2<3>(p, r0a, r0b, A, tid);
    const bf16_t* SGP = (const bf16_t*)(p.ws + WS_SGP); bf16_t* ZS = (bf16_t*)(p.ws + WS_ZS);
    __syncthreads();
#pragma unroll 1
    for (int h = 0; h < 2; ++h) {
        const int r0 = h ? r0b : r0a;
        u32x2 sg[8][2];
#pragma unroll
        for (int mt = 0; mt < 8; ++mt) { const size_t off = (size_t)(r0 + 16 * mt + lr) * 1024 + colb; sg[mt][0] = *(const u32x2*)(SGP + off); sg[mt][1] = *(const u32x2*)(SGP + off + 16); }
        f32x4 acc[8][2];
#pragma unroll
        for (int i = 0; i < 8; ++i) { acc[i][0] = (f32x4){0.f, 0.f, 0.f, 0.f}; acc[i][1] = (f32x4){0.f, 0.f, 0.f, 0.f}; }
#pragma unroll
        for (int ks = 0; ks < 4; ++ks) {
#pragma unroll
            for (int mt = 0; mt < 8; ++mt) { const bf16x8 af = *(const bf16x8*)(A + (h * 128 + 16 * mt + lr) * PA_PITCH + 32 * ks + 8 * lq);
                acc[mt][0] = MFMA16(b0[ks], af, acc[mt][0]); acc[mt][1] = MFMA16(b1[ks], af, acc[mt][1]); }
            __builtin_amdgcn_sched_barrier(0);
        }
#pragma unroll
        for (int mt = 0; mt < 8; ++mt) {
            const size_t off = (size_t)(r0 + 16 * mt + lr) * 1024 + colb;
            const f32x4 z0 = acc[mt][0], z1 = acc[mt][1];
            u32x2 o; o.x = cvt_pk_bf16(z0[0] * ps0[0] * bf_lo(sg[mt][0].x), z0[1] * ps0[1] * bf_hi(sg[mt][0].x)); o.y = cvt_pk_bf16(z0[2] * ps0[2] * bf_lo(sg[mt][0].y), z0[3] * ps0[3] * bf_hi(sg[mt][0].y));
            *(u32x2*)(ZS + off) = o;
            o.x = cvt_pk_bf16(z1[0] * ps1[0] * bf_lo(sg[mt][1].x), z1[1] * ps1[1] * bf_hi(sg[mt][1].x)); o.y = cvt_pk_bf16(z1[2] * ps1[2] * bf_lo(sg[mt][1].y), z1[3] * ps1[3] * bf_hi(sg[mt][1].y));
            *(u32x2*)(ZS + off + 16) = o;
        }
    }
    __syncthreads();
}
__device__ __forceinline__ void pool_unit(const Params& p, int rt, int k, unsigned char* lds, int tid) {
    const int lane = tid & 63, w8 = tid >> 6, lr = lane & 15, lq = lane >> 4;
    bf16_t* A = (bf16_t*)lds;
    const int r0 = rt * 128;
    if (k == 0) pool_fill<0>(p, r0, A, tid); else if (k == 1) pool_fill<1>(p, r0, A, tid); else if (k == 2) pool_fill<2>(p, r0, A, tid); else pool_fill<3>(p, r0, A, tid);
    __syncthreads();
    f32x4 acc[8][2];
#pragma unroll
    for (int i = 0; i < 8; ++i) { acc[i][0] = (f32x4){0.f, 0.f, 0.f, 0.f}; acc[i][1] = (f32x4){0.f, 0.f, 0.f, 0.f}; }
    const bf16_t* Wb = (const bf16_t*)(p.ws + WS_WPOOL) + ((size_t)k * 256 + 32 * w8 + lr) * 128 + 8 * lq;
#pragma unroll
    for (int ks = 0; ks < 4; ++ks) {
        const bf16x8 b0 = *(const bf16x8*)(Wb + 32 * ks), b1 = *(const bf16x8*)(Wb + 16 * 128 + 32 * ks);
#pragma unroll
        for (int mt = 0; mt < 8; ++mt) { const bf16x8 af = *(const bf16x8*)(A + (16 * mt + lr) * PA_PITCH + 32 * ks + 8 * lq);
            acc[mt][0] = MFMA16(b0, af, acc[mt][0]); acc[mt][1] = MFMA16(b1, af, acc[mt][1]); }
    }
    const bf16_t* SGP = (const bf16_t*)(p.ws + WS_SGP); bf16_t* ZS = (bf16_t*)(p.ws + WS_ZS);
#pragma unroll
    for (int nt = 0; nt < 2; ++nt) {
        const int col = k * 256 + 32 * w8 + 16 * nt + 4 * lq;
        const f32x4 ps = *(const f32x4*)(p.in[23] + col);
#pragma unroll
        for (int mt = 0; mt < 8; ++mt) {
            const size_t off = (size_t)(r0 + 16 * mt + lr) * 1024 + col;
            const u32x2 sg = *(const u32x2*)(SGP + off); const f32x4 z = acc[mt][nt];
            u32x2 o; o.x = cvt_pk_bf16(z[0] * ps[0] * bf_lo(sg.x), z[1] * ps[1] * bf_hi(sg.x)); o.y = cvt_pk_bf16(z[2] * ps[2] * bf_lo(sg.y), z[3] * ps[3] * bf_hi(sg.y));
            *(u32x2*)(ZS + off) = o;
        }
    }
    __syncthreads();
}

template <int NT> __device__ __forceinline__ void skinny_unit(const bf16_t* A, int lda, const bf16_t* Bt, int ldb, int K, int arow0, const int (&brow)[NT], unsigned char* lds, int tid) {
    const int lane = tid & 63, w = tid >> 6, lr = lane & 15, lq = lane >> 4, kper = K >> 3, k0 = w * kper;
    constexpr int TW = 16 * NT;
    float* red = (float*)lds;
    f32x4 acc[4][NT];
#pragma unroll
    for (int i = 0; i < 4; ++i)
#pragma unroll
        for (int n = 0; n < NT; ++n) acc[i][n] = (f32x4){0.f, 0.f, 0.f, 0.f};
    const bf16_t* Ap = A + (size_t)(arow0 + lr) * lda + k0 + 8 * lq;
    const bf16_t* Bp[NT];
#pragma unroll
    for (int n = 0; n < NT; ++n) Bp[n] = Bt + (size_t)(brow[n] + lr) * ldb + k0 + 8 * lq;
    const int nks = kper >> 5;
    int ks = 0;
    for (; ks + 2 <= nks; ks += 2) {
        bf16x8 bf[2][NT], af[2][4];
#pragma unroll
        for (int u = 0; u < 2; ++u) {
#pragma unroll
            for (int n = 0; n < NT; ++n) bf[u][n] = *(const bf16x8*)(Bp[n] + 32 * (ks + u));
#pragma unroll
            for (int mt = 0; mt < 4; ++mt) af[u][mt] = *(const bf16x8*)(Ap + (size_t)(16 * mt) * lda + 32 * (ks + u)); }
#pragma unroll
        for (int u = 0; u < 2; ++u)
#pragma unroll
            for (int mt = 0; mt < 4; ++mt)
#pragma unroll
                for (int n = 0; n < NT; ++n) acc[mt][n] = MFMA16(bf[u][n], af[u][mt], acc[mt][n]);
    }
    for (; ks < nks; ++ks) {
        bf16x8 bf[NT];
#pragma unroll
        for (int n = 0; n < NT; ++n) bf[n] = *(const bf16x8*)(Bp[n] + 32 * ks);
#pragma unroll
        for (int mt = 0; mt < 4; ++mt) { const bf16x8 af = *(const bf16x8*)(Ap + (size_t)(16 * mt) * lda + 32 * ks);
#pragma unroll
            for (int n = 0; n < NT; ++n) acc[mt][n] = MFMA16(bf[n], af, acc[mt][n]); }
    }
#pragma unroll
    for (int mt = 0; mt < 4; ++mt)
#pragma unroll
        for (int n = 0; n < NT; ++n) *(f32x4*)(red + ((size_t)(w * 64 + 16 * mt + lr)) * TW + 16 * n + 4 * lq) = acc[mt][n];
    __syncthreads();
#pragma unroll
    for (int q = 0; q < NT / 2; ++q) {
        const int o = (q * 512 + tid) * 4;
        f32x4 s = *(const f32x4*)(red + o);
#pragma unroll
        for (int v = 1; v < 8; ++v) s += *(const f32x4*)(red + v * 64 * TW + o);
        *(f32x4*)(red + o) = s;
    }
    __syncthreads();
}
#define LAS __attribute__((address_space(3)))
#define XB_TMO      128
#define XB_XCNT(j)  (256  + 64 * (j))
#define XB_XSUB(j)  (1280 + 64 * (j))
#define XB_XGEN(j)  (2304 + 64 * (j))
#define XB_TOP      3328
#define XB_TOPGEN   3392
#define XCD_BAR_WORDS 3456
#define XB_SPIN_CAP (1u << 18)

__device__ __forceinline__ unsigned xb_ld(unsigned* p)              { return __hip_atomic_load(p, __ATOMIC_RELAXED, __HIP_MEMORY_SCOPE_AGENT); }
__device__ __forceinline__ unsigned xb_add(unsigned* p, unsigned v) { return __hip_atomic_fetch_add(p, v, __ATOMIC_RELAXED, __HIP_MEMORY_SCOPE_AGENT); }
__device__ __forceinline__ unsigned xb_xcc_id() { return (unsigned)__builtin_amdgcn_s_getreg((3 << 11) | 20) & 0xFu; }
#define XB_SPIN(cond, bar) do { unsigned _sp = 0; while (cond) { __builtin_amdgcn_s_sleep(1); \
    if ((++_sp & 255u) == 0u) { if (xb_ld(&(bar)[XB_TMO])) break; if (_sp > XB_SPIN_CAP) { atomicAdd(&(bar)[XB_TMO], 1u); break; } } } } while (0)

struct XcdBarrier {
    unsigned* bar; unsigned x;
    volatile LAS unsigned* st;
};

__device__ __forceinline__ XcdBarrier xcd_barrier_post(unsigned* bar, volatile LAS unsigned* st) {
    XcdBarrier b; b.bar = bar; b.x = xb_xcc_id(); b.st = st;
    if (threadIdx.x == 0) (void)xb_add(&bar[XB_XCNT(b.x)], 1u);
    return b;
}
__device__ __forceinline__ void xcd_barrier_complete(unsigned* bar, unsigned x, unsigned& nloc, unsigned& nx) {
    const unsigned G = gridDim.x * gridDim.y * gridDim.z;
    unsigned sum, cnt, mine, sp = 0u;
    for (;;) {
        sum = 0u; cnt = 0u; mine = 0u;
#pragma unroll
        for (unsigned j = 0; j < 16; ++j) { const unsigned c = xb_ld(&bar[XB_XCNT(j)]); sum += c; cnt += (c > 0u) ? 1u : 0u; mine = (j == x) ? c : mine; }
        if (sum == G) break;
        __builtin_amdgcn_s_sleep(1);
        if ((++sp & 255u) == 0u) { if (xb_ld(&bar[XB_TMO])) break; if (sp > XB_SPIN_CAP) { atomicAdd(&bar[XB_TMO], 1u); break; } }
    }
    nloc = mine > 0u ? mine : 1u; nx = cnt > 0u ? cnt : 1u;
}

__device__ __forceinline__ void xcd_barrier(const XcdBarrier& b) {
    asm volatile("s_waitcnt vmcnt(0)" ::: "memory");
    __syncthreads();
    if (threadIdx.x == 0) {
        unsigned* bar = b.bar;
        __builtin_amdgcn_s_waitcnt(0);
        unsigned nloc = b.st[0], nx = b.st[1];
        if (nloc == 0u) { xcd_barrier_complete(bar, b.x, nloc, nx); b.st[0] = nloc; b.st[1] = nx; }
        const unsigned old = xb_add(&bar[XB_XSUB(b.x)], 1u);
        const unsigned gen = old / nloc;
        if (old + 1u == (gen + 1u) * nloc) {
            __builtin_amdgcn_fence(__ATOMIC_RELEASE, "agent");
            asm volatile("s_waitcnt vmcnt(0)" ::: "memory");
            const unsigned og = xb_add(&bar[XB_TOP], 1u);
            const unsigned tg = og / nx;
            if (og + 1u == (tg + 1u) * nx) xb_add(&bar[XB_TOPGEN], 1u);
            else XB_SPIN(xb_ld(&bar[XB_TOPGEN]) == tg, bar);
            __builtin_amdgcn_fence(__ATOMIC_ACQUIRE, "agent");
            xb_add(&bar[XB_XGEN(b.x)], 1u);
            asm volatile("s_waitcnt vmcnt(0)" ::: "memory");
        } else {
            XB_SPIN(xb_ld(&bar[XB_XGEN(b.x)]) == gen, bar);
            __builtin_amdgcn_fence(__ATOMIC_ACQUIRE, "agent");
            asm volatile("s_waitcnt vmcnt(0)" ::: "memory");
        }
    }
    __syncthreads();
}

constexpr int MISC_OFF = LDS_BYTES - 64;
constexpr size_t WS_BAR = 0;
#ifndef PG_ALIGN
#define PG_ALIGN true
#endif
#ifndef PG_SP2
#define PG_SP2 true
#endif
#ifndef REP3A
#define REP3A 1
#endif
#ifndef REP3B
#define REP3B 1
#endif
#ifndef REP3C
#define REP3C 1
#endif
#ifndef REP0
#define REP0 1
#endif
#ifndef REP1
#define REP1 1
#endif
#ifndef REP2
#define REP2 1
#endif
#ifndef REP3
#define REP3 1
#endif
#ifndef REP4
#define REP4 1
#endif
#ifndef REP5
#define REP5 1
#endif
#ifndef REP6
#define REP6 1
#endif
#ifndef REP7
#define REP7 1
#endif
#ifndef REP8
#define REP8 1
#endif
#ifndef REP9
#define REP9 1
#endif
__global__ void __launch_bounds__(512, 2) mk_fwd(Params p) {
    extern __shared__ __attribute__((aligned(16))) unsigned char lds[];
    cg::grid_group grid = cg::this_grid();
    const int tid = threadIdx.x, lane = tid & 63, wave = __builtin_amdgcn_readfirstlane(tid >> 6), G = gridDim.x, bid = blockIdx.x;
    const int gw = bid * 8 + wave, NGW = G * 8;
    PG8_LAS unsigned char* ldsg = (PG8_LAS unsigned char*)lds;
    float* mod = (float*)(p.ws + WS_MOD);
    float* out = p.out;
    if (tid < 16) ((volatile LAS unsigned*)(ldsg + MISC_OFF))[tid] = 0u;
    __syncthreads();
    XcdBarrier xbar = xcd_barrier_post((unsigned*)(p.ws + WS_BAR), (volatile LAS unsigned*)(ldsg + MISC_OFF));
    if (p.ph_hi > 1000) grid.sync();
#define IN(k) (p.ph_lo <= (k) && (k) < p.ph_hi)
#define GSYNC() xcd_barrier(xbar)
#define SEAM(k) do { if (IN(k) && IN((k) + 1)) GSYNC(); } while (0)

#ifdef EXTRA_SYNCS
    for (int i_ = 0; i_ < EXTRA_SYNCS; ++i_) GSYNC();
#endif
    if (IN(0)) for (int rep_ = 0; rep_ < REP0; ++rep_) { if (rep_) GSYNC();
        for (int u = bid; u < 192; u += G) ada_unit(p, u, lds, tid);
        float* scr = (float*)lds + wave * (64 * 33);
        {
            const bool freeblk = bid >= 192;
            for (int i = 0; i < (freeblk ? 2 : 1); ++i) {
                int r = freeblk ? i * 512 + (gw - 1536) : 1024 + gw;
                if (r < TR_ITEMS[0]) tr_item(p, 0, r, scr, lane);
                else if ((r -= TR_ITEMS[0]) < TR_ITEMS[1]) tr_item(p, 1, r, scr, lane);
                else if ((r -= TR_ITEMS[1]) < TR_ITEMS[5]) tr_item(p, 5, r, scr, lane);
            }
        }
        {
            float* spool = out + (size_t)NTOK * DM + 16384 + 16384 + 61440 + 262144 + 262144;
            const float* sp = p.in[6];
            for (int i = bid * 512 + tid; i < 128 * 11 * 128; i += G * 512) { const int s = i / (11 * 128), q = i % (11 * 128);
                *(f32x4*)(spool + (size_t)s * 15 * 512 + 4 * q) = *(const f32x4*)(sp + (size_t)s * 15 * 512 + 4 * 512 + 4 * q); }
        }
    }
    SEAM(0);
    if (IN(1)) for (int rep_ = 0; rep_ < REP1; ++rep_) { if (rep_) GSYNC(); for (int u = bid; u < 96; u += G) ssm_prep_unit(p, u / 3, u % 3, lds, tid); modnorm_rows<false>(p.in[0], p.in[1], p.in[7], mod, 0, 1, (bf16_t*)(p.ws + WS_H), bid < 96 ? 44 * bid : 4224 + 80 * (bid - 96), bid < 96 ? 44 * bid + 44 : (4224 + 80 * (bid - 95) < NTOK ? 4224 + 80 * (bid - 95) : NTOK), wave, lane); }
    SEAM(1);
    if (IN(2)) for (int rep_ = 0; rep_ < REP2; ++rep_) { if (rep_) GSYNC();
        pg8::Gemm g{(const bf16_t*)(p.ws + WS_H), (const bf16_t*)(p.ws + WS_WIN), NP, 3072, 1024}; pg8::StaticOrder S; S.init(NP, 3072, G, bid);
        EpiG1 E{(bf16_t*)(p.ws + WS_US), (bf16_t*)(p.ws + WS_UP), (bf16_t*)(p.ws + WS_SGS), (bf16_t*)(p.ws + WS_SGP),
                out + (size_t)NTOK * DM + 32768, out + (size_t)NTOK * DM + 32768 + 61440 + 524288};
        pg8::gemm_phase<EpiG1, pg8::StaticOrder, PG_ALIGN, PG_SP2>(ldsg, g, S, E);
        for (int u = bid; u < 8 * 48; u += G) {
            const int rt = u / 48, ct = u % 48;
            const int br_[4] = {64 * ct, 64 * ct + 16, 64 * ct + 32, 64 * ct + 48};
            skinny_unit<4>((const bf16_t*)(p.ws + WS_H), 1024, (const bf16_t*)(p.ws + WS_WIN), 1024, 1024, NP + 64 * rt, br_, lds, tid);
            const float* tp = (const float*)lds + (tid >> 3) * 64 + (tid & 7) * 8;
            E.emit(NP + 64 * rt + (tid >> 3), 64 * ct + (tid & 7) * 8, ct >> 2, *(const f32x4*)tp, *(const f32x4*)(tp + 4));
            __syncthreads();
        }
    }
    SEAM(2);
    if (IN(3)) for (int rep_ = 0; rep_ < REP3; ++rep_) { if (rep_) GSYNC();
        for (int ra_ = 0; ra_ < REP3A; ++ra_) for (int u = bid; u < 256; u += G) ssm_block(p, u >> 5, u & 31, lds, tid);
        for (int rb_ = 0; rb_ < REP3B; ++rb_) { for (int u = bid; u < 256; u += G) pool_pair(p, u >> 2, u & 3, lds, tid); for (int u = G - 1 - bid; u < 16; u += G) pool_unit(p, 128 + (u >> 2), u & 3, lds, tid); }
        for (int rc_ = 0; rc_ < REP3C; ++rc_) for (int it = gw; it < 128 * 32; it += NGW) ssm_sample_item(p, it >> 5, it & 31, lane);
        {
            float* scr = (float*)lds + wave * (64 * 33);
            for (int it = gw; it < TR_ITEMS[2] + TR_ITEMS[3]; it += NGW) { if (it < TR_ITEMS[2]) tr_item(p, 2, it, scr, lane); else tr_item(p, 3, it - TR_ITEMS[2], scr, lane); }
        }
    }
    SEAM(3);
    if (IN(4)) for (int rep_ = 0; rep_ < REP4; ++rep_) { if (rep_) GSYNC();
        pg8::Gemm g{(const bf16_t*)(p.ws + WS_GY), (const bf16_t*)(p.ws + WS_WGLU), NP, 2048, 512}; pg8::StaticOrder S; S.init(NP, 2048, G, bid);
        EpiGLU E{(const bf16_t*)(p.ws + WS_SGS), (const bf16_t*)(p.ws + WS_ZS), (bf16_t*)(p.ws + WS_H)};
        pg8::gemm_phase<EpiGLU, pg8::StaticOrder, PG_ALIGN, PG_SP2>(ldsg, g, S, E);
        for (int u = bid; u < 256; u += G) {
            const int rt = u >> 5, jt = u & 31, j0 = 32 * jt, ra = 256 * (j0 >> 7) + (j0 & 127);
            const int br_[4] = {ra, ra + 16, ra + 128, ra + 144};
            skinny_unit<4>((const bf16_t*)(p.ws + WS_GY), 512, (const bf16_t*)(p.ws + WS_WGLU), 512, 512, NP + 64 * rt, br_, lds, tid);
            const float* tp = (const float*)lds + (tid >> 3) * 64 + (tid & 7) * 4;
            const f32x4 a = *(const f32x4*)tp, b = *(const f32x4*)(tp + 32);
            const size_t off = (size_t)(NP + 64 * rt + (tid >> 3)) * 1024 + j0 + (tid & 7) * 4;
            const u32x2 sg = *(const u32x2*)(E.SGS + off), zs = *(const u32x2*)(E.ZS + off);
            u32x2 o;
            o.x = cvt_pk_bf16(bf_lo(sg.x) * a[0] * fsigmoid(b[0]) + bf_lo(zs.x), bf_hi(sg.x) * a[1] * fsigmoid(b[1]) + bf_hi(zs.x));
            o.y = cvt_pk_bf16(bf_lo(sg.y) * a[2] * fsigmoid(b[2]) + bf_lo(zs.y), bf_hi(sg.y) * a[3] * fsigmoid(b[3]) + bf_hi(zs.y));
            *(u32x2*)(E.MGD + off) = o;
            __syncthreads();
        }
    }
    SEAM(4);
    if (IN(5)) for (int rep_ = 0; rep_ < REP5; ++rep_) { if (rep_) GSYNC();
        pg8::Gemm g{(const bf16_t*)(p.ws + WS_H), (const bf16_t*)(p.ws + WS_WOUT), NP, 1024, 1024}; pg8::StaticOrder S; S.init(NP, 1024, G, bid);
        EpiRes<0> E{p.in[0], p.in[1], mod + 2 * DM, out, (bf16_t*)(p.ws + WS_XB)};
        pg8::gemm_phase<EpiRes<0>, pg8::StaticOrder, PG_ALIGN, PG_SP2>(ldsg, g, S, E);
        for (int u = bid; u < 256; u += G) {
            const int rt = u >> 5, ct = u & 31;
            const int br_[2] = {32 * ct, 32 * ct + 16};
            skinny_unit<2>((const bf16_t*)(p.ws + WS_H), 1024, (const bf16_t*)(p.ws + WS_WOUT), 1024, 1024, NP + 64 * rt, br_, lds, tid);
            const int row = 64 * rt + (tid >> 3), col = 32 * ct + 4 * (tid & 7), r = NP + row;
            const f32x4 a = *(const f32x4*)((const float*)lds + tid * 4);
            const f32x4 x = *(const f32x4*)(p.in[1] + (size_t)row * DM + col), gt = *(const f32x4*)(mod + (size_t)mrow(r) * 6144 + 2 * DM + col);
            { const f32x4 v = x + gt * a; *(f32x4*)(out + (size_t)r * DM + col) = v; u32x2 wv; wv.x = cvt_pk_bf16(v[0], v[1]); wv.y = cvt_pk_bf16(v[2], v[3]); *(u32x2*)((bf16_t*)(p.ws + WS_XB) + (size_t)r * DM + col) = wv; }
            __syncthreads();
        }
    }
    SEAM(5);
    if (IN(6)) for (int rep_ = 0; rep_ < REP6; ++rep_) { if (rep_) GSYNC(); modnorm_rows<true>((const float*)(p.ws + WS_XB), nullptr, p.in[8], mod, 3, 4, (bf16_t*)(p.ws + WS_H), 66 * bid, 66 * bid + 66, wave, lane); }
    SEAM(6);
    if (IN(7)) for (int rep_ = 0; rep_ < REP7; ++rep_) { if (rep_) GSYNC();
        pg8::Gemm g{(const bf16_t*)(p.ws + WS_H), (const bf16_t*)(p.ws + WS_WFI), NTOK, 2 * DFF, 1024}; pg8::StaticOrder S; S.init(NTOK, 2 * DFF, G, bid);
        EpiSwiGLU E{(bf16_t*)(p.ws + WS_ACT)};
        pg8::gemm_phase<EpiSwiGLU, pg8::StaticOrder, PG_ALIGN, PG_SP2>(ldsg, g, S, E);
        {
            const int nun = (NTOK / 256) * (2 * DFF / 256), full = nun / G, rem = nun % G;
            if (rem != 0 && bid >= rem) { float* scr = (float*)lds + wave * (64 * 33); const int nidle = (G - rem) * 8;
                for (int it = (bid - rem) * 8 + wave; it < TR_ITEMS[4]; it += nidle) tr_item(p, 4, it, scr, lane); }
            else if (rem == 0) { float* scr = (float*)lds + wave * (64 * 33); for (int it = gw; it < TR_ITEMS[4]; it += NGW) tr_item(p, 4, it, scr, lane); }
            (void)full;
        }
    }
    SEAM(7);
    if (IN(8)) for (int rep_ = 0; rep_ < REP8; ++rep_) { if (rep_) GSYNC();
        pg8::Gemm g{(const bf16_t*)(p.ws + WS_ACT), (const bf16_t*)(p.ws + WS_WFO), NP, 1024, DFF}; pg8::StaticOrder S; S.init(NP, 1024, G, bid);
        EpiRes<1> E{out, out + (size_t)NP * DM, mod + 5 * DM, out, (bf16_t*)(p.ws + WS_H)};
        pg8::gemm_phase<EpiRes<1>, pg8::StaticOrder, PG_ALIGN, PG_SP2>(ldsg, g, S, E);
        for (int u = bid; u < 256; u += G) {
            const int rt = u >> 5, ct = u & 31;
            const int br_[2] = {32 * ct, 32 * ct + 16};
            skinny_unit<2>((const bf16_t*)(p.ws + WS_ACT), DFF, (const bf16_t*)(p.ws + WS_WFO), DFF, DFF, NP + 64 * rt, br_, lds, tid);
            const int row = 64 * rt + (tid >> 3), col = 32 * ct + 4 * (tid & 7), r = NP + row;
            const f32x4 a = *(const f32x4*)((const float*)lds + tid * 4);
            float* op = out + (size_t)r * DM + col;
            const f32x4 x = *(const f32x4*)op, gt = *(const f32x4*)(mod + (size_t)mrow(r) * 6144 + 5 * DM + col);
            { const f32x4 v = x + gt * a; u32x2 wv; wv.x = cvt_pk_bf16(v[0], v[1]); wv.y = cvt_pk_bf16(v[2], v[3]); *(u32x2*)((bf16_t*)(p.ws + WS_H) + (size_t)r * DM + col) = wv; }
            __syncthreads();
        }
    }
    SEAM(8);
    if (IN(9)) for (int rep_ = 0; rep_ < REP9; ++rep_) { if (rep_) GSYNC();
        const float* gf = p.in[9];
        f32x4 gg[4];
#pragma unroll
        for (int j = 0; j < 4; ++j) gg[j] = *(const f32x4*)(gf + 4 * lane + 256 * j);
        for (int r0 = gw; r0 < NTOK; r0 += 2 * NGW) {
            const int rr[2] = {r0, (r0 + NGW < NTOK) ? r0 + NGW : r0};
            f32x4 v[2][4]; float s[2];
#pragma unroll
            for (int h = 0; h < 2; ++h) { const bf16_t* xbr = (const bf16_t*)(p.ws + WS_H) + (size_t)rr[h] * DM + 4 * lane;
#pragma unroll
                for (int j = 0; j < 4; ++j) { const u32x2 q = *(const u32x2*)(xbr + 256 * j); v[h][j] = (f32x4){bf_lo(q.x), bf_hi(q.x), bf_lo(q.y), bf_hi(q.y)}; } }
#pragma unroll
            for (int h = 0; h < 2; ++h) { s[h] = 0.f;
#pragma unroll
                for (int j = 0; j < 4; ++j) s[h] += (v[h][j][0] * v[h][j][0] + v[h][j][1] * v[h][j][1]) + (v[h][j][2] * v[h][j][2] + v[h][j][3] * v[h][j][3]); }
#pragma unroll
            for (int o = 1; o < 64; o <<= 1) { s[0] += __shfl_xor(s[0], o); s[1] += __shfl_xor(s[1], o); }
#pragma unroll
            for (int h = 0; h < 2; ++h) if (h == 0 || rr[1] != rr[0]) {
                const float inv = rsqrtf(s[h] * (1.0f / DM) + EPS); float* xr = out + (size_t)rr[h] * DM + 4 * lane;
#pragma unroll
                for (int j = 0; j < 4; ++j) *(f32x4*)(xr + 256 * j) = (v[h][j] * inv) * gg[j];
            }
        }
    }
#undef IN
#undef SEAM
}

#ifndef MK_N_LAUNCHES
#define MK_N_LAUNCHES 1
#endif
extern "C" void kernel_launch(void* const* d_in, const int* in_sizes, int n_in, void* d_out, int out_size, void* d_ws, size_t ws_size, hipStream_t stream) {
    static int grid = 0;
    if (grid == 0) {
        int dev = 0, cus = 0, per_cu = 0;
        if (hipGetDevice(&dev) != hipSuccess || hipDeviceGetAttribute(&cus, hipDeviceAttributeMultiprocessorCount, dev) != hipSuccess) { fprintf(stderr, "kernel_launch: device query failed\n"); grid = -1; return; }
        if (hipFuncSetAttribute((const void*)mk_fwd, hipFuncAttributeMaxDynamicSharedMemorySize, LDS_BYTES) != hipSuccess) { fprintf(stderr, "kernel_launch: hipFuncSetAttribute failed\n"); grid = -1; return; }
        if (hipOccupancyMaxActiveBlocksPerMultiprocessor(&per_cu, (const void*)mk_fwd, 512, LDS_BYTES) != hipSuccess || per_cu < 1) { fprintf(stderr, "kernel_launch: occupancy query says %d blocks/CU\n", per_cu); (void)hipGetLastError(); grid = -1; return; }
        grid = cus * per_cu;
        if (n_in != 27 || ws_size < 232 * MiB) { fprintf(stderr, "kernel_launch: unexpected n_in %d / ws %zu\n", n_in, ws_size); grid = -1; return; }
    }
    if (grid < 0) return;
    if (hipMemsetAsync((char*)d_ws + WS_BAR, 0, 32768, stream) != hipSuccess) { fprintf(stderr, "kernel_launch: memset failed\n"); return; }
    Params p{};
    for (int i = 0; i < 27; ++i) p.in[i] = (const float*)d_in[i];
    p.out = (float*)d_out; p.ws = (unsigned char*)d_ws;
#if MK_N_LAUNCHES == 1
    p.ph_lo = 0; p.ph_hi = 10;
    void* args[] = {&p};
    hipError_t e = hipLaunchCooperativeKernel((const void*)mk_fwd, dim3(grid), dim3(512), args, LDS_BYTES, stream);
    if (e != hipSuccess) fprintf(stderr, "kernel_launch: cooperative launch failed: %s (grid %d)\n", hipGetErrorString(e), grid);
#else
    for (int ph = 0; ph < 10; ++ph) { p.ph_lo = ph; p.ph_hi = ph + 1; hipLaunchKernelGGL(mk_fwd, dim3(grid), dim3(512), LDS_BYTES, stream, p); }
#endif
}
```

```cpp
#include <hip/hip_runtime.h>
#include <hip/hip_cooperative_groups.h>
#include <cstdio>
#include <cstdint>
namespace cg = cooperative_groups;
namespace pg8 {
#define PG8_LAS __attribute__((address_space(3)))
typedef unsigned short bf16_t;
typedef short bf16x8 __attribute__((ext_vector_type(8)));
typedef float f32x4 __attribute__((ext_vector_type(4)));
typedef unsigned u32x4 __attribute__((ext_vector_type(4)));
constexpr int BM = 256, BK = 64, HALF = 128, HTB = HALF * BK * 2  , STAGE_BYTES = 8 * HTB, NXCD = 8, WGM = 8;

__host__ __device__ __forceinline__ int lds_byte(int r, int c) { const int st = (r >> 4) * 2 + (c >> 5), rr = r & 15, cc = c & 31, ob = rr * 64 + cc * 2; return st * 1024 + (ob ^ (((ob >> 9) & 1) << 5)); }
__host__ __device__ __forceinline__ void stage_rc(int b, int& R, int& C) { const int st = b / 1024, sb = b % 1024, swz = sb ^ (((sb >> 9) & 1) << 5); R = (st >> 1) * 16 + swz / 64; C = (st & 1) * 32 + (swz % 64) / 2; }
__host__ __device__ __forceinline__ int perm32(int rho) { const int n = rho >> 4, i = rho & 15; return 8 * (i >> 2) + 4 * n + (i & 3); }

struct Unit { int pm, pn; };
struct Gemm { const bf16_t* A; const bf16_t* Bt; int M, N, K; };

struct StaticOrder {
    int nM, nN, nwg, G, c;
    __host__ __device__ void init(int M, int N, int G_, int c_) { nM = M / BM; nN = N / BM; nwg = nM * nN; G = G_; c = c_; }
    __host__ __device__ bool next(int i, Unit& u) const {
        const long L = (long)i * G + c; if (L >= nwg) return false;
        int wgid = (int)L; { const int q = nwg / NXCD, r = nwg % NXCD, xcd = wgid % NXCD, off = wgid / NXCD; wgid = (xcd < r ? xcd * (q + 1) : r * (q + 1) + (xcd - r) * q) + off; }
        const int nig = WGM * nN, gid = wgid / nig, fm = gid * WGM, gsz = (nM - fm) < WGM ? (nM - fm) : WGM;
        u.pm = fm + ((wgid % nig) % gsz); u.pn = (wgid % nig) / gsz; return true;
    }
    __device__ __forceinline__ void a_ready(const Unit&) const {}
    __device__ __forceinline__ void done(const Unit&) const {}
};
__device__ __forceinline__ unsigned cvt_pk_bf16(float lo, float hi) { unsigned r; asm volatile("v_cvt_pk_bf16_f32 %0, %1, %2" : "=v"(r) : "v"(lo), "v"(hi)); return r; }
template <class Epi, class Sched, bool ALIGN_EPI = false, bool SP2 = false>
__device__ __forceinline__ void gemm_phase(PG8_LAS unsigned char* lds, const Gemm g, const Sched& S, const Epi& E) {
    const int tid = threadIdx.x, wid = __builtin_amdgcn_readfirstlane(tid >> 6), lane = tid & 63, wr = wid >> 2, wc = wid & 3, fr = lane & 15, fq = lane >> 4;
    const int K = g.K, nt = K / BK;
    unsigned voffA[2], voffB[2];
#pragma unroll
    for (int i = 0; i < 2; ++i) { int R, C; stage_rc(tid * 16 + i * 8192, R, C); const int Rb = Epi::PERM ? ((R & ~31) + perm32(R & 31)) : R;
        voffA[i] = (unsigned)(R * K + C) * 2u; voffB[i] = (unsigned)(Rb * K + C) * 2u; }
    const size_t kstep = (size_t)(BK * 2);
    const size_t hstep = (size_t)HALF * K * 2;
    const size_t tstep = 2 * hstep;
    const unsigned ldsw = (unsigned)wid * 1024u;
    const int aoff = lds_byte(wr * 64 + fr, fq * 8), boff = lds_byte(wc * 32 + fr, fq * 8);
#define PG8_SA(b, h) (((b) * 2 + (h)) * HTB)
#define PG8_SB(b, h) ((4 + (b) * 2 + (h)) * HTB)
#define PG8_STAGE(bufoff, gbase, voff) do { _Pragma("unroll") for (int _i = 0; _i < 2; ++_i) \
        __builtin_amdgcn_global_load_lds((const unsigned*)((const char*)(gbase) + (voff)[_i]), (PG8_LAS unsigned*)(lds + (bufoff) + ldsw + _i * 8192), 16, 0, 0); } while (0)
#define PG8_LDA(dst, b, h) do { _Pragma("unroll") for (int m = 0; m < 4; ++m) _Pragma("unroll") for (int k = 0; k < 2; ++k) dst[m][k] = *(const PG8_LAS bf16x8*)(lds + PG8_SA(b, h) + aoff + m * 2048 + k * 1024); } while (0)
#define PG8_LDB(dst, b, h) do { _Pragma("unroll") for (int n = 0; n < 2; ++n) _Pragma("unroll") for (int k = 0; k < 2; ++k) dst[n][k] = *(const PG8_LAS bf16x8*)(lds + PG8_SB(b, h) + boff + n * 2048 + k * 1024); } while (0)
#define PG8_MMA(ai, bj, At, Bt) do { __builtin_amdgcn_s_setprio(1); _Pragma("unroll") for (int m = 0; m < 4; ++m) _Pragma("unroll") for (int n = 0; n < 2; ++n) _Pragma("unroll") for (int k = 0; k < 2; ++k) \
        acc[ai][bj][m][n] = __builtin_amdgcn_mfma_f32_16x16x32_bf16(Bt[n][k], At[m][k], acc[ai][bj][m][n], 0, 0, 0); __builtin_amdgcn_s_setprio(0); } while (0)
#define PG8_WAIT_V(n) asm volatile("s_waitcnt vmcnt(" #n ")" ::: "memory")
#define PG8_WAIT_L(n) asm volatile("s_waitcnt lgkmcnt(" #n ")" ::: "memory")
#define PG8_BAR __builtin_amdgcn_s_barrier()
#define PG8_SCHED __builtin_amdgcn_sched_barrier(0)
    Unit cur, nxt; int ui = 0;
    if (!S.next(0, cur)) return;
    f32x4 acc[2][2][4][2];
#pragma unroll
    for (int a = 0; a < 2; ++a)
#pragma unroll
        for (int b = 0; b < 2; ++b)
#pragma unroll
            for (int m = 0; m < 4; ++m)
#pragma unroll
                for (int n = 0; n < 2; ++n) acc[a][b][m][n] = (f32x4){0.f, 0.f, 0.f, 0.f};
    bf16x8 At[4][2], B0[2][2], B1[2][2];
    const char* cA = (const char*)g.A + (size_t)cur.pm * tstep; const char* cB = (const char*)g.Bt + (size_t)cur.pn * tstep;
    S.a_ready(cur);
    if constexpr (SP2) {
        PG8_STAGE(PG8_SB(0, 0), cB, voffB); PG8_STAGE(PG8_SB(0, 1), cB + hstep, voffB); PG8_STAGE(PG8_SA(0, 0), cA, voffA); PG8_STAGE(PG8_SA(0, 1), cA + hstep, voffA);
        if (wr == 1) PG8_BAR;
        PG8_WAIT_V(2); PG8_BAR;
        PG8_STAGE(PG8_SB(1, 0), cB + kstep, voffB); PG8_STAGE(PG8_SA(1, 0), cA + kstep, voffA); PG8_STAGE(PG8_SB(1, 1), cB + hstep + kstep, voffB);
        PG8_WAIT_V(6); PG8_BAR;
    } else {
        PG8_STAGE(PG8_SB(0, 0), cB, voffB); PG8_STAGE(PG8_SA(0, 0), cA, voffA); PG8_STAGE(PG8_SB(0, 1), cB + hstep, voffB); PG8_STAGE(PG8_SA(0, 1), cA + hstep, voffA);
        if (wr == 1) PG8_BAR;
        PG8_WAIT_V(4); PG8_BAR;
        PG8_STAGE(PG8_SB(1, 0), cB + kstep, voffB); PG8_STAGE(PG8_SA(1, 0), cA + kstep, voffA); PG8_STAGE(PG8_SB(1, 1), cB + hstep + kstep, voffB);
        PG8_WAIT_V(6); PG8_BAR;
    }
    for (;;) {
        const bool has_next = S.next(ui + 1, nxt);
        const char* nA = has_next ? (const char*)g.A + (size_t)nxt.pm * tstep : cA; const char* nB = has_next ? (const char*)g.Bt + (size_t)nxt.pn * tstep : cB;
        for (int t = 0; t < nt; t += 2) {
            const bool last = (t == nt - 2);
            const char* a1 = cA + (size_t)(t + 1) * kstep;
            const char* a2 = last ? nA : cA + (size_t)(t + 2) * kstep; const char* b2 = last ? nB : cB + (size_t)(t + 2) * kstep;
            const char* a3 = a2 + kstep; const char* b3 = b2 + kstep;
            if (last && has_next) S.a_ready(nxt);
            if constexpr (SP2) {
            PG8_LDB(B0, 0, 0); PG8_LDB(B1, 0, 1); PG8_SCHED; PG8_LDA(At, 0, 0); PG8_STAGE(PG8_SA(1, 1), a1 + hstep, voffA);
            PG8_WAIT_V(8); PG8_WAIT_L(0); PG8_BAR; PG8_MMA(0, 0, At, B0); PG8_MMA(0, 1, At, B1); PG8_BAR; PG8_SCHED;
            PG8_LDA(At, 0, 1); PG8_STAGE(PG8_SB(0, 0), b2, voffB); PG8_STAGE(PG8_SB(0, 1), b2 + hstep, voffB); PG8_STAGE(PG8_SA(0, 0), a2, voffA);
            PG8_WAIT_V(8); PG8_WAIT_L(0); PG8_BAR; PG8_MMA(1, 0, At, B0); PG8_MMA(1, 1, At, B1); PG8_BAR; PG8_SCHED;
            PG8_LDB(B0, 1, 0); PG8_LDB(B1, 1, 1); PG8_SCHED; PG8_LDA(At, 1, 0); PG8_STAGE(PG8_SA(0, 1), a2 + hstep, voffA);
            PG8_WAIT_V(8); PG8_WAIT_L(0); PG8_BAR; PG8_MMA(0, 0, At, B0); PG8_MMA(0, 1, At, B1); PG8_BAR; PG8_SCHED;
            PG8_LDA(At, 1, 1); PG8_STAGE(PG8_SB(1, 0), b3, voffB); PG8_STAGE(PG8_SB(1, 1), b3 + hstep, voffB); PG8_STAGE(PG8_SA(1, 0), a3, voffA);
            PG8_WAIT_V(8); PG8_WAIT_L(0); PG8_BAR; PG8_MMA(1, 0, At, B0); PG8_MMA(1, 1, At, B1); PG8_BAR; PG8_SCHED;
            } else {
            PG8_LDB(B0, 0, 0); PG8_SCHED; PG8_LDA(At, 0, 0); PG8_STAGE(PG8_SA(1, 1), a1 + hstep, voffA);
            PG8_WAIT_L(8); PG8_BAR; PG8_WAIT_L(0); PG8_MMA(0, 0, At, B0); PG8_BAR; PG8_SCHED;
            PG8_LDB(B1, 0, 1); PG8_STAGE(PG8_SB(0, 0), b2, voffB);
            PG8_BAR; PG8_WAIT_L(0); PG8_MMA(0, 1, At, B1); PG8_BAR;
            PG8_LDA(At, 0, 1); PG8_STAGE(PG8_SA(0, 0), a2, voffA);
            PG8_BAR; PG8_WAIT_L(0); PG8_MMA(1, 0, At, B0); PG8_BAR; PG8_SCHED;
            PG8_STAGE(PG8_SB(0, 1), b2 + hstep, voffB);
            PG8_WAIT_V(6); PG8_BAR; PG8_MMA(1, 1, At, B1); PG8_BAR;
            PG8_LDB(B0, 1, 0); PG8_SCHED; PG8_LDA(At, 1, 0); PG8_STAGE(PG8_SA(0, 1), a2 + hstep, voffA);
            PG8_WAIT_L(8); PG8_BAR; PG8_WAIT_L(0); PG8_MMA(0, 0, At, B0); PG8_BAR; PG8_SCHED;
            PG8_LDB(B1, 1, 1); PG8_STAGE(PG8_SB(1, 0), b3, voffB);
            PG8_BAR; PG8_WAIT_L(0); PG8_MMA(0, 1, At, B1); PG8_BAR;
            PG8_LDA(At, 1, 1); PG8_STAGE(PG8_SA(1, 0), a3, voffA);
            PG8_BAR; PG8_WAIT_L(0); PG8_MMA(1, 0, At, B0); PG8_BAR; PG8_SCHED;
            PG8_STAGE(PG8_SB(1, 1), b3 + hstep, voffB);
            PG8_WAIT_V(6); PG8_BAR; PG8_MMA(1, 1, At, B1); PG8_BAR;
            }
        }
        if constexpr (ALIGN_EPI) { if (wr == 0) PG8_BAR; }
        if constexpr (!Epi::AFTER_DRAIN) { E(acc, cur, wr, wc, fr, fq); S.done(cur); }
        if (!has_next) break;
#pragma unroll
        for (int a = 0; a < 2; ++a)
#pragma unroll
            for (int b = 0; b < 2; ++b)
#pragma unroll
                for (int m = 0; m < 4; ++m)
#pragma unroll
                    for (int n = 0; n < 2; ++n) acc[a][b][m][n] = (f32x4){0.f, 0.f, 0.f, 0.f};
        cur = nxt; cA = nA; cB = nB; ++ui;
        if constexpr (ALIGN_EPI) { if (wr == 1) PG8_BAR; }
    }
    PG8_WAIT_V(0);
    if constexpr (!ALIGN_EPI) { if (wr == 0) PG8_BAR; }
    PG8_BAR;
    if constexpr (Epi::AFTER_DRAIN) { E.fused(acc, cur, wr, wc, fr, fq, lds, wid, lane); S.done(cur); }
#undef PG8_SA
#undef PG8_SB
#undef PG8_STAGE
#undef PG8_LDA
#undef PG8_LDB
#undef PG8_MMA
#undef PG8_WAIT_V
#undef PG8_WAIT_L
#undef PG8_BAR
#undef PG8_SCHED
}
}

using pg8::f32x4; using pg8::u32x4; using pg8::bf16x8; using pg8::bf16_t; using pg8::Unit; using pg8::cvt_pk_bf16;
typedef unsigned u32x2 __attribute__((ext_vector_type(2)));
typedef float f32x2 __attribute__((ext_vector_type(2)));

constexpr int DM = 1024, NP = 16384, NS = 512, NTOK = NP + NS, NMODROW = 136, DFF = 2816;
constexpr float EPS = 1e-6f;
constexpr int LDS_BYTES = 147456;
constexpr size_t MiB = 1u << 20;
constexpr size_t WS_CTR = 16384;
constexpr size_t WS_MOD = 1 * MiB;
constexpr size_t WS_SP = 5 * MiB;
constexpr size_t WS_MG = 6 * MiB, WS_EG = 10 * MiB, WS_RG = 12 * MiB;
constexpr size_t WS_WIN = 16 * MiB, WS_WGLU = 22 * MiB, WS_WPOOL = 24 * MiB, WS_WOUT = 25 * MiB, WS_WFI = 27 * MiB, WS_WFO = 39 * MiB;
constexpr size_t WS_H = 48 * MiB;
constexpr size_t WS_US = 82 * MiB, WS_UP = 99 * MiB;
constexpr size_t WS_SGS = 116 * MiB, WS_SGP = 149 * MiB;
constexpr size_t WS_GY = 182 * MiB;
constexpr size_t WS_ZS = 199 * MiB;
constexpr size_t WS_XB = 82 * MiB;
constexpr size_t WS_ACT = 116 * MiB;
constexpr int SP_AR = 0, SP_AI = 2048, SP_A16R = 4096, SP_A16I = 6144, SP_BBR = 8192, SP_BBI = 8192 + 32768;

struct Params {
    const float* in[27];
    float* out;
    unsigned char* ws;
    int ph_lo, ph_hi;
};

__device__ __forceinline__ float fsigmoid(float x) { return __builtin_amdgcn_rcpf(1.0f + __builtin_amdgcn_exp2f(-1.44269504089f * x)); }
__device__ __forceinline__ float fsilu(float x) { return x * fsigmoid(x); }
__device__ __forceinline__ float fgelu_tanh(float y) { return y * fsigmoid(1.59576912161f * y * (1.0f + 0.044715f * y * y)); }
__device__ __forceinline__ float bf_lo(unsigned u) { return __builtin_bit_cast(float, u << 16); }
__device__ __forceinline__ float bf_hi(unsigned u) { return __builtin_bit_cast(float, u & 0xffff0000u); }
__device__ __forceinline__ int mrow(int r) { return r < NP ? (r >> 11) : 8 + ((r - NP) >> 2); }
__device__ __forceinline__ bf16x8 pack8(f32x4 a, f32x4 b) {
    u32x4 w; w.x = cvt_pk_bf16(a[0], a[1]); w.y = cvt_pk_bf16(a[2], a[3]); w.z = cvt_pk_bf16(b[0], b[1]); w.w = cvt_pk_bf16(b[2], b[3]);
    return __builtin_bit_cast(bf16x8, w);
}
__device__ __forceinline__ float wave_sum(float v) {
#pragma unroll
    for (int o = 1; o < 64; o <<= 1) v += __shfl_xor(v, o);
    return v;
}
#ifdef NT_STORES
#define GST(ptr, v) __builtin_nontemporal_store((v), (ptr))
#else
#define GST(ptr, v) (*(ptr) = (v))
#endif
#define MFMA16(a, b, c) __builtin_amdgcn_mfma_f32_16x16x32_bf16((a), (b), (c), 0, 0, 0)

struct EpiG1 {
    static constexpr bool PERM = true, AFTER_DRAIN = false;
    bf16_t *US, *UP, *SGS, *SGP; float* ppool; float* spool;
    __device__ __forceinline__ void emit(int r, int c, int cls, f32x4 v0, f32x4 v1) const {
        if (cls < 2) {
            u32x4 w; w.x = cvt_pk_bf16(v0[0], v0[1]); w.y = cvt_pk_bf16(v0[2], v0[3]); w.z = cvt_pk_bf16(v1[0], v1[1]); w.w = cvt_pk_bf16(v1[2], v1[3]);
            GST((u32x4*)(US + (size_t)r * 512 + c), w);
        } else if (cls < 4) {
            const int cc = c - 512;
            u32x4 w; w.x = cvt_pk_bf16(v0[0], v0[1]); w.y = cvt_pk_bf16(v0[2], v0[3]); w.z = cvt_pk_bf16(v1[0], v1[1]); w.w = cvt_pk_bf16(v1[2], v1[3]);
            GST((u32x4*)(UP + (size_t)r * 512 + cc), w);
            if (r < NP) { const int t = r & 2047; if (t >= 2033) { float* o = ppool + ((size_t)(r >> 11) * 15 + (t - 2033)) * 512 + cc; *(f32x4*)o = v0; *(f32x4*)(o + 4) = v1; } }
            else { const int s = (r - NP) >> 2, i = (r - NP) & 3; float* o = spool + ((size_t)s * 15 + 11 + i) * 512 + cc; *(f32x4*)o = v0; *(f32x4*)(o + 4) = v1; }
        } else {
#pragma unroll
            for (int j = 0; j < 4; ++j) { v0[j] = fsigmoid(v0[j]); v1[j] = fsigmoid(v1[j]); }
            u32x4 w; w.x = cvt_pk_bf16(v0[0], v0[1]); w.y = cvt_pk_bf16(v0[2], v0[3]); w.z = cvt_pk_bf16(v1[0], v1[1]); w.w = cvt_pk_bf16(v1[2], v1[3]);
            if (cls < 8) GST((u32x4*)(SGS + (size_t)r * 1024 + (c - 1024)), w); else GST((u32x4*)(SGP + (size_t)r * 1024 + (c - 2048)), w);
        }
    }
    __device__ __forceinline__ void operator()(const f32x4 (&acc)[2][2][4][2], const Unit& u, int wr, int wc, int fr, int fq) const {
        const int row0 = u.pm * 256 + wr * 64 + fr, colt = u.pn * 256 + wc * 32 + 8 * fq;
#pragma unroll
        for (int ai = 0; ai < 2; ++ai)
#pragma unroll
            for (int m = 0; m < 4; ++m)
#pragma unroll
                for (int bj = 0; bj < 2; ++bj) emit(row0 + ai * 128 + m * 16, colt + bj * 128, u.pn, acc[ai][bj][m][0], acc[ai][bj][m][1]);
    }
};
struct EpiGLU {
    static constexpr bool PERM = true, AFTER_DRAIN = false;
    const bf16_t *SGS, *ZS; bf16_t* MGD;
    __device__ __forceinline__ void operator()(const f32x4 (&acc)[2][2][4][2], const Unit& u, int wr, int wc, int fr, int fq) const {
        const int row0 = u.pm * 256 + wr * 64 + fr, j0 = u.pn * 128 + wc * 32 + 8 * fq;
        u32x4 sgv[2][4], zsv[2][4];
#pragma unroll
        for (int ai = 0; ai < 2; ++ai)
#pragma unroll
            for (int m = 0; m < 4; ++m) { const size_t off = (size_t)(row0 + ai * 128 + m * 16) * 1024 + j0; sgv[ai][m] = *(const u32x4*)(SGS + off); zsv[ai][m] = *(const u32x4*)(ZS + off); }
#pragma unroll
        for (int ai = 0; ai < 2; ++ai)
#pragma unroll
            for (int m = 0; m < 4; ++m) {
                const size_t off = (size_t)(row0 + ai * 128 + m * 16) * 1024 + j0;
                const u32x4 sg = sgv[ai][m], zs = zsv[ai][m];
                const f32x4 a0 = acc[ai][0][m][0], a1 = acc[ai][0][m][1], b0 = acc[ai][1][m][0], b1 = acc[ai][1][m][1];
                float o[8];
                o[0] = bf_lo(sg.x) * a0[0] * fsigmoid(b0[0]) + bf_lo(zs.x); o[1] = bf_hi(sg.x) * a0[1] * fsigmoid(b0[1]) + bf_hi(zs.x);
                o[2] = bf_lo(sg.y) * a0[2] * fsigmoid(b0[2]) + bf_lo(zs.y); o[3] = bf_hi(sg.y) * a0[3] * fsigmoid(b0[3]) + bf_hi(zs.y);
                o[4] = bf_lo(sg.z) * a1[0] * fsigmoid(b1[0]) + bf_lo(zs.z); o[5] = bf_hi(sg.z) * a1[1] * fsigmoid(b1[1]) + bf_hi(zs.z);
                o[6] = bf_lo(sg.w) * a1[2] * fsigmoid(b1[2]) + bf_lo(zs.w); o[7] = bf_hi(sg.w) * a1[3] * fsigmoid(b1[3]) + bf_hi(zs.w);
                u32x4 w; w.x = cvt_pk_bf16(o[0], o[1]); w.y = cvt_pk_bf16(o[2], o[3]); w.z = cvt_pk_bf16(o[4], o[5]); w.w = cvt_pk_bf16(o[6], o[7]);
                GST((u32x4*)(MGD + off), w);
            }
    }
};
struct EpiSwiGLU {
    static constexpr bool PERM = true, AFTER_DRAIN = false;
    bf16_t* ACT;
    __device__ __forceinline__ void operator()(const f32x4 (&acc)[2][2][4][2], const Unit& u, int wr, int wc, int fr, int fq) const {
        const int row0 = u.pm * 256 + wr * 64 + fr, j0 = u.pn * 128 + wc * 32 + 8 * fq;
#pragma unroll
        for (int ai = 0; ai < 2; ++ai)
#pragma unroll
            for (int m = 0; m < 4; ++m) {
                const size_t off = (size_t)(row0 + ai * 128 + m * 16) * DFF + j0;
                const f32x4 a0 = acc[ai][0][m][0], a1 = acc[ai][0][m][1], b0 = acc[ai][1][m][0], b1 = acc[ai][1][m][1];
                u32x4 w;
                w.x = cvt_pk_bf16(fsilu(a0[0]) * b0[0], fsilu(a0[1]) * b0[1]); w.y = cvt_pk_bf16(fsilu(a0[2]) * b0[2], fsilu(a0[3]) * b0[3]);
                w.z = cvt_pk_bf16(fsilu(a1[0]) * b1[0], fsilu(a1[1]) * b1[1]); w.w = cvt_pk_bf16(fsilu(a1[2]) * b1[2], fsilu(a1[3]) * b1[3]);
                GST((u32x4*)(ACT + off), w);
            }
    }
};
template <int MODE> struct EpiRes {
    static constexpr bool PERM = false, AFTER_DRAIN = false;
    const float* baseF; const bf16_t* baseB; const float* gate; bf16_t* XO;
    __device__ __forceinline__ void operator()(const f32x4 (&acc)[2][2][4][2], const Unit& u, int wr, int wc, int fr, int fq) const {
        const int row0 = u.pm * 256 + wr * 64 + fr, col0 = u.pn * 256 + wc * 32 + 4 * fq;
        const float* gp = gate + (size_t)((u.pm * 256) >> 11) * 6144 + col0;
        f32x4 gt[2][2];
#pragma unroll
        for (int bj = 0; bj < 2; ++bj)
#pragma unroll
            for (int n = 0; n < 2; ++n) gt[bj][n] = *(const f32x4*)(gp + bj * 128 + n * 16);
        if (MODE == 0) {
#pragma unroll
            for (int ai = 0; ai < 2; ++ai) {
                f32x4 x[4][2][2];
#pragma unroll
                for (int m = 0; m < 4; ++m) { const float* bp = baseF + (size_t)(row0 + ai * 128 + m * 16) * DM + col0;
#pragma unroll
                    for (int bj = 0; bj < 2; ++bj)
#pragma unroll
                        for (int n = 0; n < 2; ++n) x[m][bj][n] = *(const f32x4*)(bp + bj * 128 + n * 16); }
#pragma unroll
                for (int m = 0; m < 4; ++m) { bf16_t* xp = XO + (size_t)(row0 + ai * 128 + m * 16) * DM + col0;
#pragma unroll
                    for (int bj = 0; bj < 2; ++bj)
#pragma unroll
                        for (int n = 0; n < 2; ++n) { const f32x4 v = x[m][bj][n] + gt[bj][n] * acc[ai][bj][m][n];
                            u32x2 w; w.x = cvt_pk_bf16(v[0], v[1]); w.y = cvt_pk_bf16(v[2], v[3]); GST((u32x2*)(xp + bj * 128 + n * 16), w); } }
            }
        } else {
            u32x2 x[2][4][2][2];
#pragma unroll
            for (int ai = 0; ai < 2; ++ai)
#pragma unroll
                for (int m = 0; m < 4; ++m) { const bf16_t* bp = baseB + (size_t)(row0 + ai * 128 + m * 16) * DM + col0;
#pragma unroll
                    for (int bj = 0; bj < 2; ++bj)
#pragma unroll
                        for (int n = 0; n < 2; ++n) x[ai][m][bj][n] = *(const u32x2*)(bp + bj * 128 + n * 16); }
#pragma unroll
            for (int ai = 0; ai < 2; ++ai)
#pragma unroll
                for (int m = 0; m < 4; ++m) { bf16_t* xp = XO + (size_t)(row0 + ai * 128 + m * 16) * DM + col0;
#pragma unroll
                    for (int bj = 0; bj < 2; ++bj)
#pragma unroll
                        for (int n = 0; n < 2; ++n) { const u32x2 q = x[ai][m][bj][n]; const f32x4 xv = (f32x4){bf_lo(q.x), bf_hi(q.x), bf_lo(q.y), bf_hi(q.y)};
                            const f32x4 v = xv + gt[bj][n] * acc[ai][bj][m][n];
                            u32x2 w; w.x = cvt_pk_bf16(v[0], v[1]); w.y = cvt_pk_bf16(v[2], v[3]); GST((u32x2*)(xp + bj * 128 + n * 16), w); } }
        }
    }
};

__device__ __forceinline__ void transpose_item(const float* W, int ldw, int k0, int n0, bf16_t* WT, int ldt, int drow0, float* scr, int lane) {
    float tv[32];
#pragma unroll
    for (int i = 0; i < 32; ++i) tv[i] = W[(size_t)(k0 + 2 * i + (lane >> 5)) * ldw + n0 + (lane & 31)];
#pragma unroll
    for (int i = 0; i < 32; ++i) scr[(2 * i + (lane >> 5)) * 33 + (lane & 31)] = tv[i];
    asm volatile("s_waitcnt lgkmcnt(0)" ::: "memory");
    const int c = lane & 7;
#pragma unroll
    for (int j = 0; j < 4; ++j) { const int n = (lane >> 3) + 8 * j; const float* s = scr + (8 * c) * 33 + n;
        u32x4 o; o.x = cvt_pk_bf16(s[0 * 33], s[1 * 33]); o.y = cvt_pk_bf16(s[2 * 33], s[3 * 33]); o.z = cvt_pk_bf16(s[4 * 33], s[5 * 33]); o.w = cvt_pk_bf16(s[6 * 33], s[7 * 33]);
        *(u32x4*)(WT + (size_t)(drow0 + n) * ldt + k0 + 8 * c) = o; }
    asm volatile("s_waitcnt lgkmcnt(0)" ::: "memory");
}
__device__ __forceinline__ int glu_row(int n, int half) { return n < half ? 256 * (n >> 7) + (n & 127) : 256 * ((n - half) >> 7) + 128 + ((n - half) & 127); }

constexpr int TR_ITEMS[6] = {16 * 96, 8 * 64, 16 * 32, 16 * 176, 44 * 32, 4 * 2 * 8};
__device__ __forceinline__ void tr_item(const Params& p, int which, int r, float* scr, int lane) {
    if (which == 0) { const int kb = r / 96, nb = r % 96; transpose_item(p.in[12], 3072, 64 * kb, 32 * nb, (bf16_t*)(p.ws + WS_WIN), 1024, 32 * nb, scr, lane); }
    else if (which == 1) { const int kb = r / 64, nb = r % 64; transpose_item(p.in[21], 2048, 64 * kb, 32 * nb, (bf16_t*)(p.ws + WS_WGLU), 512, glu_row(32 * nb, 1024), scr, lane); }
    else if (which == 2) { const int kb = r / 32, nb = r % 32; transpose_item(p.in[24], 1024, 64 * kb, 32 * nb, (bf16_t*)(p.ws + WS_WOUT), 1024, 32 * nb, scr, lane); }
    else if (which == 3) { const int kb = r / 176, nb = r % 176; transpose_item(p.in[25], 5632, 64 * kb, 32 * nb, (bf16_t*)(p.ws + WS_WFI), 1024, glu_row(32 * nb, DFF), scr, lane); }
    else if (which == 4) { const int kb = r / 32, nb = r % 32; transpose_item(p.in[26], 1024, 64 * kb, 32 * nb, (bf16_t*)(p.ws + WS_WFO), DFF, 32 * nb, scr, lane); }
    else { const int gk = r / 16, q = r % 16, kb = q / 8, nb = q % 8; transpose_item(p.in[22] + (size_t)gk * 128 * 256, 256, 64 * kb, 32 * nb, (bf16_t*)(p.ws + WS_WPOOL) + (size_t)gk * 256 * 128, 128, 32 * nb, scr, lane); }
}
__device__ __forceinline__ void ada_unit(const Params& p, int unit, unsigned char* lds, int tid) {
    const int lane = tid & 63, w = tid >> 6, lr = lane & 15, lq = lane >> 4, kq = w & 3, mh = w >> 2;
    const int n0 = unit * 32, mt0 = mh ? 5 : 0, mcnt = mh ? 4 : 5;
    const float* cp = p.in[2]; const float* cs = p.in[3]; const float* wa = p.in[10]; const float* ba = p.in[11];
    float* mod = (float*)(p.ws + WS_MOD);
    float* red = (float*)lds;
    f32x4 acc[5][2];
#pragma unroll
    for (int i = 0; i < 5; ++i) { acc[i][0] = (f32x4){0.f, 0.f, 0.f, 0.f}; acc[i][1] = (f32x4){0.f, 0.f, 0.f, 0.f}; }
#pragma unroll 2
    for (int ks = 0; ks < 8; ++ks) {
        const int k0 = kq * 256 + ks * 32 + 8 * lq;
        bf16x8 bfr[2];
#pragma unroll
        for (int nt = 0; nt < 2; ++nt) {
            const float* bp = wa + (size_t)k0 * 6144 + n0 + 16 * nt + lr;
            f32x4 x0, x1;
            x0[0] = bp[0]; x0[1] = bp[6144]; x0[2] = bp[2 * 6144]; x0[3] = bp[3 * 6144]; x1[0] = bp[4 * 6144]; x1[1] = bp[5 * 6144]; x1[2] = bp[6 * 6144]; x1[3] = bp[7 * 6144];
            bfr[nt] = pack8(x0, x1);
        }
#pragma unroll
        for (int mi = 0; mi < 5; ++mi) {
            if (mi < mcnt) {
                const int row = 16 * (mt0 + mi) + lr;
                f32x4 x0 = (f32x4){0.f, 0.f, 0.f, 0.f}, x1 = x0;
                if (row < NMODROW) { const float* ap = (row < 8 ? cp + (size_t)row * DM : cs + (size_t)(row - 8) * DM) + k0; x0 = *(const f32x4*)ap; x1 = *(const f32x4*)(ap + 4); }
#pragma unroll
                for (int j = 0; j < 4; ++j) { x0[j] = fsilu(x0[j]); x1[j] = fsilu(x1[j]); }
                const bf16x8 af = pack8(x0, x1);
                acc[mi][0] = MFMA16(bfr[0], af, acc[mi][0]); acc[mi][1] = MFMA16(bfr[1], af, acc[mi][1]);
            }
        }
    }
#pragma unroll
    for (int mi = 0; mi < 5; ++mi) if (mi < mcnt) {
        const int row = 16 * (mt0 + mi) + lr;
        *(f32x4*)(red + ((size_t)(kq * 144 + row)) * 32 + 4 * lq) = acc[mi][0];
        *(f32x4*)(red + ((size_t)(kq * 144 + row)) * 32 + 16 + 4 * lq) = acc[mi][1];
    }
    __syncthreads();
    for (int o = tid; o < NMODROW * 32; o += 512) {
        const int row = o >> 5, col = o & 31;
        const float v = ((red[(0 * 144 + row) * 32 + col] + red[(1 * 144 + row) * 32 + col]) + (red[(2 * 144 + row) * 32 + col] + red[(3 * 144 + row) * 32 + col])) + ba[n0 + col];
        mod[(size_t)row * 6144 + n0 + col] = v;
    }
    __syncthreads();
}

__device__ __forceinline__ void ssm_prep_unit(const Params& p, int g, int part, unsigned char* lds, int tid) {
    float* L = (float*)lds;
    float* pwr = L;            float* pwi = L + 17 * 64;
    float* bbr = L + 2176;     float* bbi = bbr + 1024;
    float* crT = bbi + 1024;   float* ciT = crT + 1024;
    float* ktab = ciT + 1024;
    float* spf = (float*)(p.ws + WS_SP);
    bf16_t* MG = (bf16_t*)(p.ws + WS_MG) + (size_t)g * 256 * 256;
    bf16_t* EG = (bf16_t*)(p.ws + WS_EG) + (size_t)g * 256 * 128;
    bf16_t* RG = (bf16_t*)(p.ws + WS_RG) + (size_t)g * 128 * 256;
    const float dt = expf(p.in[15][g]);
    for (int i = tid; i < 17 * 64; i += 512) {
        const int pp = i & 63, d = i >> 6, gp = g * 64 + pp;
        const float lr = p.in[13][gp], li = p.in[14][gp];
        const float mag = expf(lr * dt * (float)d), ang = li * dt * (float)d; float sn, cs; sincosf(ang, &sn, &cs); pwr[d * 64 + pp] = mag * cs; pwi[d * 64 + pp] = mag * sn;
    }
    for (int i = tid; i < 1024; i += 512) {
        const int pp = i >> 4, c = i & 15, gp = g * 64 + pp;
        const float lr = p.in[13][gp], li = p.in[14][gp];
        const float mag = expf(lr * dt), ang = li * dt; float sn, cs; sincosf(ang, &sn, &cs);
        const float abr = mag * cs, abi = mag * sn, den = lr * lr + li * li, nr = abr - 1.0f, ni = abi;
        const float fr = (nr * lr + ni * li) / den, fi = (ni * lr - nr * li) / den;
        const float br = p.in[16][(size_t)gp * 16 + c], bi = p.in[17][(size_t)gp * 16 + c];
        const float xr = fr * br - fi * bi, xi = fr * bi + fi * br; bbr[pp * 16 + c] = xr; bbi[pp * 16 + c] = xi;
        if (part == 2) { spf[SP_BBR + gp * 16 + c] = xr; spf[SP_BBI + gp * 16 + c] = xi; }
    }
    for (int i = tid; i < 1024; i += 512) { const int c = i >> 6, pp = i & 63; crT[pp * 16 + c] = p.in[18][(size_t)(g * 16 + c) * 64 + pp]; ciT[pp * 16 + c] = p.in[19][(size_t)(g * 16 + c) * 64 + pp]; }
    __syncthreads();
    if (part == 0) {
        {
            const int pair = tid & 255, d = pair >> 4, c2 = pair & 15, ch = tid >> 8;
            float a8[8];
#pragma unroll
            for (int i = 0; i < 8; ++i) a8[i] = 0.f;
#pragma unroll 8
            for (int pp = 0; pp < 64; ++pp) {
                const float ar = pwr[d * 64 + pp], ai = pwi[d * 64 + pp], br = bbr[pp * 16 + c2], bi = bbi[pp * 16 + c2];
                const float tr = ar * br - ai * bi, ti = ar * bi + ai * br;
                const f32x4 cr0 = *(const f32x4*)(crT + pp * 16 + 8 * ch), cr1 = *(const f32x4*)(crT + pp * 16 + 8 * ch + 4);
                const f32x4 ci0 = *(const f32x4*)(ciT + pp * 16 + 8 * ch), ci1 = *(const f32x4*)(ciT + pp * 16 + 8 * ch + 4);
#pragma unroll
                for (int i = 0; i < 4; ++i) { a8[i] += cr0[i] * tr - ci0[i] * ti; a8[4 + i] += cr1[i] * tr - ci1[i] * ti; }
            }
#pragma unroll
            for (int i = 0; i < 8; ++i) { const int c = 8 * ch + i; float v = a8[i]; if (d == 0 && c == c2) v += p.in[20][g * 16 + c]; ktab[d * 256 + c * 16 + c2] = v; }
        }
        __syncthreads();
        for (int idx = tid; idx < 8192; idx += 512) {
            const int n = idx >> 5, kk = (idx & 31) * 8, tau = n >> 4, c = n & 15, tp = kk >> 4, c0 = kk & 15;
            f32x4 x0 = (f32x4){0.f, 0.f, 0.f, 0.f}, x1 = x0;
            if (tau >= tp) { const float* s = ktab + (tau - tp) * 256 + c * 16 + c0; x0 = *(const f32x4*)s; x1 = *(const f32x4*)(s + 4); }
            *(bf16x8*)(MG + (size_t)n * 256 + kk) = pack8(x0, x1);
        }
    } else if (part == 1) {
        for (int idx = tid; idx < 4096; idx += 512) {
            const int n = idx >> 4, q0 = (idx & 15) * 8, tau = n >> 4, c = n & 15;
            float v[8];
#pragma unroll
            for (int j = 0; j < 8; ++j) { const int q = q0 + j, pp = q & 63; const float pr = pwr[(tau + 1) * 64 + pp], pi = pwi[(tau + 1) * 64 + pp], cr = crT[pp * 16 + c], ci = ciT[pp * 16 + c];
                v[j] = q < 64 ? (cr * pr - ci * pi) : -(cr * pi + ci * pr); }
            *(bf16x8*)(EG + (size_t)n * 128 + q0) = pack8((f32x4){v[0], v[1], v[2], v[3]}, (f32x4){v[4], v[5], v[6], v[7]});
        }
    } else {
        if (tid < 64) { const int gp = g * 64 + tid; spf[SP_AR + gp] = pwr[64 + tid]; spf[SP_AI + gp] = pwi[64 + tid]; spf[SP_A16R + gp] = pwr[16 * 64 + tid]; spf[SP_A16I + gp] = pwi[16 * 64 + tid]; }
        for (int idx = tid; idx < 4096; idx += 512) {
            const int q = idx >> 5, kk = (idx & 31) * 8, tp = kk >> 4, c0 = kk & 15, pp = q & 63;
            const float pr = pwr[(15 - tp) * 64 + pp], pi = pwi[(15 - tp) * 64 + pp];
            const f32x4 br0 = *(const f32x4*)(bbr + pp * 16 + c0), br1 = *(const f32x4*)(bbr + pp * 16 + c0 + 4), bi0 = *(const f32x4*)(bbi + pp * 16 + c0), bi1 = *(const f32x4*)(bbi + pp * 16 + c0 + 4);
            const f32x4 v0 = q < 64 ? (br0 * pr - bi0 * pi) : (bi0 * pr + br0 * pi), v1 = q < 64 ? (br1 * pr - bi1 * pi) : (bi1 * pr + br1 * pi);
            *(bf16x8*)(RG + (size_t)q * 256 + kk) = pack8(v0, v1);
        }
    }
    __syncthreads();
}

template <bool BF> __device__ __forceinline__ void modnorm_rows(const float* xa, const float* xb, const float* gvec, const float* mod, int jshift, int jscale, bf16_t* H, int rbeg, int rend, int wave, int lane) {
    for (int r0 = rbeg + wave; r0 < rend; r0 += 16) {
        const int rr[2] = {r0, (r0 + 8 < rend) ? r0 + 8 : r0};
        f32x4 v[2][4], sc[2][4], sh[2][4], gg[4];
#pragma unroll
        for (int h = 0; h < 2; ++h) {
            const int r = rr[h];
            const float* xr = (r < NP ? xa + (size_t)r * DM : xb + (size_t)(r - NP) * DM) + 4 * lane;
            const bf16_t* xbr = (const bf16_t*)xa + (size_t)r * DM + 4 * lane;
#pragma unroll
            for (int j = 0; j < 4; ++j) { if (BF) { const u32x2 q = *(const u32x2*)(xbr + 256 * j); v[h][j] = (f32x4){bf_lo(q.x), bf_hi(q.x), bf_lo(q.y), bf_hi(q.y)}; } else v[h][j] = *(const f32x4*)(xr + 256 * j); }
            const float* mr = mod + (size_t)mrow(r) * 6144 + 4 * lane;
#pragma unroll
            for (int j = 0; j < 4; ++j) { sc[h][j] = *(const f32x4*)(mr + jscale * DM + 256 * j); sh[h][j] = *(const f32x4*)(mr + jshift * DM + 256 * j); }
        }
#pragma unroll
        for (int j = 0; j < 4; ++j) gg[j] = *(const f32x4*)(gvec + 4 * lane + 256 * j);
        float s[2];
#pragma unroll
        for (int h = 0; h < 2; ++h) { s[h] = 0.f;
#pragma unroll
            for (int j = 0; j < 4; ++j) s[h] += (v[h][j][0] * v[h][j][0] + v[h][j][1] * v[h][j][1]) + (v[h][j][2] * v[h][j][2] + v[h][j][3] * v[h][j][3]); }
#pragma unroll
        for (int o = 1; o < 64; o <<= 1) { s[0] += __shfl_xor(s[0], o); s[1] += __shfl_xor(s[1], o); }
#pragma unroll
        for (int h = 0; h < 2; ++h) {
            const float inv = rsqrtf(s[h] * (1.0f / DM) + EPS);
            if (h == 0 || rr[1] != rr[0]) {
#pragma unroll
                for (int j = 0; j < 4; ++j) {
                    const f32x4 hv = (v[h][j] * inv) * gg[j] * (sc[h][j] + 1.0f) + sh[h][j];
                    u32x2 w; w.x = cvt_pk_bf16(hv[0], hv[1]); w.y = cvt_pk_bf16(hv[2], hv[3]);
                    *(u32x2*)(H + (size_t)rr[h] * DM + 4 * lane + 256 * j) = w;
                }
            }
        }
    }
}

constexpr int UP_PITCH = 264;
constexpr int RS_PITCH = 132;
__device__ __forceinline__ void ssm_block(const Params& p, int b, int g, unsigned char* lds, int tid) {
    const int lane = tid & 63, w = tid >> 6, lr = lane & 15, lq = lane >> 4;
    bf16_t* U = (bf16_t*)lds;
    float* RS = (float*)(lds + 128 * UP_PITCH * 2);
    const bf16_t* US = (const bf16_t*)(p.ws + WS_US);
    bf16_t* GY = (bf16_t*)(p.ws + WS_GY);
    const float* spf = (const float*)(p.ws + WS_SP);
    u32x4 uraw[8];
#pragma unroll
    for (int i = 0; i < 8; ++i) { const int q = tid + 512 * i, tok = q >> 1, half = q & 1; uraw[i] = *(const u32x4*)(US + ((size_t)(b * 2048 + tok) * 512 + g * 16 + half * 8)); }
    const bf16_t* Rb = (const bf16_t*)(p.ws + WS_RG) + ((size_t)g * 128 + 16 * w + lr) * 256 + 8 * lq;
    bf16x8 rf[8];
#pragma unroll
    for (int ks = 0; ks < 8; ++ks) rf[ks] = *(const bf16x8*)(Rb + 32 * ks);
    const bf16_t* Mb = (const bf16_t*)(p.ws + WS_MG) + ((size_t)g * 256 + 32 * w + lr) * 256 + 8 * lq;
    bf16x8 m0[8], m1[8];
#pragma unroll
    for (int ks = 0; ks < 8; ++ks) { m0[ks] = *(const bf16x8*)(Mb + 32 * ks); m1[ks] = *(const bf16x8*)(Mb + 16 * 256 + 32 * ks); }
#pragma unroll
    for (int i = 0; i < 8; ++i) { const int q = tid + 512 * i, tok = q >> 1, half = q & 1; *(u32x4*)(U + (tok >> 4) * UP_PITCH + (tok & 15) * 16 + half * 8) = uraw[i]; }
    __syncthreads();
    f32x4 acc[8][2];
    {
        f32x4 acc1[8];
#pragma unroll
        for (int i = 0; i < 8; ++i) acc1[i] = (f32x4){0.f, 0.f, 0.f, 0.f};
#pragma unroll
        for (int ks = 0; ks < 8; ++ks) {
#pragma unroll
            for (int mt = 0; mt < 8; ++mt) { const bf16x8 af = *(const bf16x8*)(U + (16 * mt + lr) * UP_PITCH + 32 * ks + 8 * lq); acc1[mt] = MFMA16(rf[ks], af, acc1[mt]); }
            __builtin_amdgcn_sched_barrier(0);
        }
#pragma unroll
        for (int mt = 0; mt < 8; ++mt) *(f32x4*)(RS + (16 * mt + lr) * RS_PITCH + 16 * w + 4 * lq) = acc1[mt];
    }
    {
#pragma unroll
        for (int i = 0; i < 8; ++i) { acc[i][0] = (f32x4){0.f, 0.f, 0.f, 0.f}; acc[i][1] = (f32x4){0.f, 0.f, 0.f, 0.f}; }
#pragma unroll
        for (int ks = 0; ks < 8; ++ks) if (ks <= w) {
#pragma unroll
            for (int mt = 0; mt < 8; ++mt) { const bf16x8 af = *(const bf16x8*)(U + (16 * mt + lr) * UP_PITCH + 32 * ks + 8 * lq);
                acc[mt][0] = MFMA16(m0[ks], af, acc[mt][0]); acc[mt][1] = MFMA16(m1[ks], af, acc[mt][1]); }
            __builtin_amdgcn_sched_barrier(0);
        }
    }
    const bf16_t* Eb = (const bf16_t*)(p.ws + WS_EG) + ((size_t)g * 256 + 32 * w + lr) * 128 + 8 * lq;
    bf16x8 e0[4], e1[4];
#pragma unroll
    for (int ks = 0; ks < 4; ++ks) { e0[ks] = *(const bf16x8*)(Eb + 32 * ks); e1[ks] = *(const bf16x8*)(Eb + 16 * 128 + 32 * ks); }
    __syncthreads();
    {
        float* TT = RS + 128 * RS_PITCH;
        const int gp = g * 64 + lane; const float ar = spf[SP_A16R + gp], ai = spf[SP_A16I + gp];
        float sr = 0.f, si = 0.f;
#pragma unroll
        for (int jj = 0; jj < 16; ++jj) {
            const int j = 16 * w + jj;
            const float rr = RS[j * RS_PITCH + lane], ri = RS[j * RS_PITCH + 64 + lane];
            RS[j * RS_PITCH + lane] = sr; RS[j * RS_PITCH + 64 + lane] = si;
            const float nr = ar * sr - ai * si + rr, ni = ar * si + ai * sr + ri; sr = nr; si = ni;
        }
        TT[w * 128 + lane] = sr; TT[w * 128 + 64 + lane] = si;
        float br = ar, bi = ai;
#pragma unroll
        for (int i = 0; i < 4; ++i) { const float xr = br * br - bi * bi, xi = 2.0f * br * bi; br = xr; bi = xi; }
        __syncthreads();
        float cr = 0.f, ci = 0.f;
        for (int v = 0; v < w; ++v) { const float tr = TT[v * 128 + lane], ti = TT[v * 128 + 64 + lane]; const float nr = br * cr - bi * ci + tr, ni = br * ci + bi * cr + ti; cr = nr; ci = ni; }
        float pr = 1.f, pi = 0.f;
#pragma unroll
        for (int jj = 0; jj < 16; ++jj) {
            const int j = 16 * w + jj;
            RS[j * RS_PITCH + lane] += pr * cr - pi * ci; RS[j * RS_PITCH + 64 + lane] += pr * ci + pi * cr;
            const float nr = pr * ar - pi * ai, ni = pr * ai + pi * ar; pr = nr; pi = ni;
        }
        if (w == 7) {
            float* ore = p.out + (size_t)NTOK * DM; float* oim = ore + 16384;
            ore[(size_t)(b * 32 + g) * 64 + lane] = br * cr - bi * ci + sr; oim[(size_t)(b * 32 + g) * 64 + lane] = br * ci + bi * cr + si;
        }
    }
    __syncthreads();
    {
#pragma unroll
        for (int ks = 0; ks < 4; ++ks) {
#pragma unroll
            for (int mt = 0; mt < 8; ++mt) { const float* f = RS + (16 * mt + lr) * RS_PITCH + 32 * ks + 8 * lq;
                const bf16x8 af = pack8(*(const f32x4*)f, *(const f32x4*)(f + 4));
                acc[mt][0] = MFMA16(e0[ks], af, acc[mt][0]); acc[mt][1] = MFMA16(e1[ks], af, acc[mt][1]); }
            __builtin_amdgcn_sched_barrier(0);
        }
#pragma unroll
        for (int mt = 0; mt < 8; ++mt)
#pragma unroll
            for (int nt = 0; nt < 2; ++nt) {
                const int j = 16 * mt + lr, tau = 2 * w + nt; const size_t row = (size_t)b * 2048 + 16 * j + tau;
                const f32x4 y = acc[mt][nt];
                u32x2 o; o.x = cvt_pk_bf16(fgelu_tanh(y[0]), fgelu_tanh(y[1])); o.y = cvt_pk_bf16(fgelu_tanh(y[2]), fgelu_tanh(y[3]));
                *(u32x2*)(GY + row * 512 + g * 16 + 4 * lq) = o;
            }
    }
    __syncthreads();
}

__device__ __forceinline__ void ssm_sample_item(const Params& p, int s, int g, int lane) {
    const bf16_t* US = (const bf16_t*)(p.ws + WS_US);
    bf16_t* GY = (bf16_t*)(p.ws + WS_GY);
    const float* spf = (const float*)(p.ws + WS_SP);
    const int gp = g * 64 + lane;
    const float ar = spf[SP_AR + gp], ai = spf[SP_AI + gp];
    float bbr[16], bbi[16];
#pragma unroll
    for (int i = 0; i < 4; ++i) { const f32x4 x = *(const f32x4*)(spf + SP_BBR + (size_t)gp * 16 + 4 * i), y = *(const f32x4*)(spf + SP_BBI + (size_t)gp * 16 + 4 * i);
#pragma unroll
        for (int j = 0; j < 4; ++j) { bbr[4 * i + j] = x[j]; bbi[4 * i + j] = y[j]; } }
    float hr = p.in[4][(size_t)(s * 32 + g) * 64 + lane], hi = p.in[5][(size_t)(s * 32 + g) * 64 + lane];
    float sr[4], si[4];
#pragma unroll
    for (int t = 0; t < 4; ++t) {
        const bf16_t* up = US + (size_t)(NP + 4 * s + t) * 512 + g * 16;
        const u32x4 u0 = *(const u32x4*)up, u1 = *(const u32x4*)(up + 8);
        float uu[16];
        uu[0] = bf_lo(u0.x); uu[1] = bf_hi(u0.x); uu[2] = bf_lo(u0.y); uu[3] = bf_hi(u0.y); uu[4] = bf_lo(u0.z); uu[5] = bf_hi(u0.z); uu[6] = bf_lo(u0.w); uu[7] = bf_hi(u0.w);
        uu[8] = bf_lo(u1.x); uu[9] = bf_hi(u1.x); uu[10] = bf_lo(u1.y); uu[11] = bf_hi(u1.y); uu[12] = bf_lo(u1.z); uu[13] = bf_hi(u1.z); uu[14] = bf_lo(u1.w); uu[15] = bf_hi(u1.w);
        float br = 0.f, bi = 0.f;
#pragma unroll
        for (int c = 0; c < 16; ++c) { br += bbr[c] * uu[c]; bi += bbi[c] * uu[c]; }
        const float nr = ar * hr - ai * hi + br, ni = ar * hi + ai * hr + bi; hr = nr; hi = ni; sr[t] = hr; si[t] = hi;
    }
    float* ore = p.out + (size_t)NTOK * DM + 16384 + 16384 + 61440; float* oim = ore + 262144;
    ore[(size_t)(s * 32 + g) * 64 + lane] = hr; oim[(size_t)(s * 32 + g) * 64 + lane] = hi;
    float v[64];
#pragma unroll
    for (int c = 0; c < 16; ++c) { const float cr = p.in[18][(size_t)(g * 16 + c) * 64 + lane], ci = p.in[19][(size_t)(g * 16 + c) * 64 + lane];
#pragma unroll
        for (int t = 0; t < 4; ++t) v[t * 16 + c] = sr[t] * cr - si[t] * ci; }
#define TR_STEP(OFF) { const bool up = (lane & OFF) != 0; _Pragma("unroll") for (int i = 0; i < OFF; ++i) { const float snd = up ? v[i] : v[i + OFF], kp = up ? v[i + OFF] : v[i]; v[i] = kp + __shfl_xor(snd, OFF); } }
    TR_STEP(32) TR_STEP(16) TR_STEP(8) TR_STEP(4) TR_STEP(2) TR_STEP(1)
#undef TR_STEP
    const int t = lane >> 4, c = lane & 15; const size_t row = (size_t)NP + 4 * s + t;
    const float uval = __builtin_bit_cast(float, ((unsigned)US[row * 512 + g * 16 + c]) << 16);
    const float y = v[0] + p.in[20][g * 16 + c] * uval;
    GY[row * 512 + g * 16 + c] = (bf16_t)(cvt_pk_bf16(fgelu_tanh(y), 0.f) & 0xffffu);
}

constexpr int PA_PITCH = 136;
template <int KG> __device__ __forceinline__ void pool_fill(const Params& p, int r0, bf16_t* A, int tid, int nseg) {
    if ((tid >> 6) >= nseg) return;
    constexpr int WIN = 2 << KG;
    const bf16_t* UPb = (const bf16_t*)(p.ws + WS_UP);
    const int cp = tid & 63, seg = tid >> 6, ch = 128 * KG + 2 * cp, base = r0 + 16 * seg;
    constexpr float rw = 1.0f / (float)WIN;
    if (r0 < NP) {
        const int t0 = base & 2047;
        unsigned raw[WIN - 1 + 16];
#pragma unroll
        for (int e = 0; e < WIN - 1 + 16; ++e) { const int rel = e - (WIN - 1); raw[e] = (t0 + rel >= 0) ? *(const unsigned*)(UPb + (size_t)(base + rel) * 512 + ch) : 0u; }
        float s0 = 0.f, s1 = 0.f;
#pragma unroll
        for (int e = 0; e < WIN - 1; ++e) { s0 += bf_lo(raw[e]); s1 += bf_hi(raw[e]); }
#pragma unroll
        for (int i = 0; i < 16; ++i) {
            const int t = t0 + i; const float c0 = bf_lo(raw[WIN - 1 + i]), c1 = bf_hi(raw[WIN - 1 + i]);
            s0 += c0; s1 += c1;
            const float rc = (t + 1 < WIN) ? 1.0f / (float)(t + 1) : rw;
            *(unsigned*)(A + (16 * seg + i) * PA_PITCH + 2 * cp) = cvt_pk_bf16(s0 * rc - c0, s1 * rc - c1);
            s0 -= bf_lo(raw[i]); s1 -= bf_hi(raw[i]);
        }
    } else {
        const float* sp = p.in[6];
#pragma unroll
        for (int q = 0; q < 4; ++q) {
            const int r = base + 4 * q, sidx = (r - NP) >> 2;
            float e0[WIN - 1 + 4], e1[WIN - 1 + 4];
#pragma unroll
            for (int e = 0; e < WIN - 1; ++e) { const f32x2 v = *(const f32x2*)(sp + ((size_t)sidx * 15 + (15 - (WIN - 1)) + e) * 512 + ch); e0[e] = v[0]; e1[e] = v[1]; }
#pragma unroll
            for (int i = 0; i < 4; ++i) { const unsigned v = *(const unsigned*)(UPb + (size_t)(r + i) * 512 + ch); e0[WIN - 1 + i] = bf_lo(v); e1[WIN - 1 + i] = bf_hi(v); }
            float s0 = 0.f, s1 = 0.f;
#pragma unroll
            for (int e = 0; e < WIN - 1; ++e) { s0 += e0[e]; s1 += e1[e]; }
#pragma unroll
            for (int i = 0; i < 4; ++i) {
                const float c0 = e0[WIN - 1 + i], c1 = e1[WIN - 1 + i];
                s0 += c0; s1 += c1;
                *(unsigned*)(A + (16 * seg + 4 * q + i) * PA_PITCH + 2 * cp) = cvt_pk_bf16(s0 * rw - c0, s1 * rw - c1);
                s0 -= e0[i]; s1 -= e1[i];
            }
        }
    }
}
template <int KG> __device__ __forceinline__ void pool_fill2(const Params& p, int r0a, int r0b, bf16_t* A, int tid) {
    constexpr int WIN = 2 << KG, NR = WIN - 1 + 16;
    const bf16_t* UPb = (const bf16_t*)(p.ws + WS_UP);
    const int cp = tid & 63, seg = tid >> 6, ch = 128 * KG + 2 * cp;
    constexpr float rw = 1.0f / (float)WIN;
    unsigned raw[2][NR];
#pragma unroll
    for (int h = 0; h < 2; ++h) { const int base = (h ? r0b : r0a) + 16 * seg, t0 = base & 2047;
#pragma unroll
        for (int e = 0; e < NR; ++e) { const int rel = e - (WIN - 1); raw[h][e] = (t0 + rel >= 0) ? *(const unsigned*)(UPb + (size_t)(base + rel) * 512 + ch) : 0u; } }
#pragma unroll
    for (int h = 0; h < 2; ++h) { const int base = (h ? r0b : r0a) + 16 * seg, t0 = base & 2047;
        float s0 = 0.f, s1 = 0.f;
#pragma unroll
        for (int e = 0; e < WIN - 1; ++e) { s0 += bf_lo(raw[h][e]); s1 += bf_hi(raw[h][e]); }
#pragma unroll
        for (int i = 0; i < 16; ++i) {
            const int t = t0 + i; const float c0 = bf_lo(raw[h][WIN - 1 + i]), c1 = bf_hi(raw[h][WIN - 1 + i]);
            s0 += c0; s1 += c1;
            const float rc = (t + 1 < WIN) ? 1.0f / (float)(t + 1) : rw;
            *(unsigned*)(A + (h * 128 + 16 * seg + i) * PA_PITCH + 2 * cp) = cvt_pk_bf16(s0 * rc - c0, s1 * rc - c1);
            s0 -= bf_lo(raw[h][i]); s1 -= bf_hi(raw[h][i]);
        }
    }
}
__device__ __forceinline__ void pool_pair(const Params& p, int rt, int k, unsigned char* lds, int tid) {
    const int lane = tid & 63, w8 = tid >> 6, lr = lane & 15, lq = lane >> 4;
    bf16_t* A = (bf16_t*)lds;
    const bf16_t* Wb = (const bf16_t*)(p.ws + WS_WPOOL) + ((size_t)k * 256 + 32 * w8 + lr) * 128 + 8 * lq;
    bf16x8 b0[4], b1[4];
#pragma unroll
    for (int ks = 0; ks < 4; ++ks) { b0[ks] = *(const bf16x8*)(Wb + 32 * ks); b1[ks] = *(const bf16x8*)(Wb + 16 * 128 + 32 * ks); }
    const int colb = k * 256 + 32 * w8 + 4 * lq;
    const f32x4 ps0 = *(const f32x4*)(p.in[23] + colb), ps1 = *(const f32x4*)(p.in[23] + colb + 16);
    const int r0a = rt * 128, r0b = (rt + 64) * 128;
    if (k == 0) pool_fill2<0>(p, r0a, r0b, A, tid); else if (k == 1) pool_fill2<1>(p, r0a, r0b, A, tid); else if (k == 2) pool_fill2<2>(p, r0a, r0b, A, tid); else pool_fill2<3>(p, r0a, r0b, A, tid);
    const bf16_t* SGP = (const bf16_t*)(p.ws + WS_SGP); bf16_t* ZS = (bf16_t*)(p.ws + WS_ZS);
    __syncthreads();
#pragma unroll 1
    for (int h = 0; h < 2; ++h) {
        const int r0 = h ? r0b : r0a;
        u32x2 sg[8][2];
#pragma unroll
        for (int mt = 0; mt < 8; ++mt) { const size_t off = (size_t)(r0 + 16 * mt + lr) * 1024 + colb; sg[mt][0] = *(const u32x2*)(SGP + off); sg[mt][1] = *(const u32x2*)(SGP + off + 16); }
        f32x4 acc[8][2];
#pragma unroll
        for (int i = 0; i < 8; ++i) { acc[i][0] = (f32x4){0.f, 0.f, 0.f, 0.f}; acc[i][1] = (f32x4){0.f, 0.f, 0.f, 0.f}; }
#pragma unroll
        for (int ks = 0; ks < 4; ++ks) {
#pragma unroll
            for (int mt = 0; mt < 8; ++mt) { const bf16x8 af = *(const bf16x8*)(A + (h * 128 + 16 * mt + lr) * PA_PITCH + 32 * ks + 8 * lq);
                acc[mt][0] = MFMA16(b0[ks], af, acc[mt][0]); acc[mt][1] = MFMA16(b1[ks], af, acc[mt][1]); }
            __builtin_amdgcn_sched_barrier(0);
        }
#pragma unroll
        for (int mt = 0; mt < 8; ++mt) {
            const size_t off = (size_t)(r0 + 16 * mt + lr) * 1024 + colb;
            const f32x4 z0 = acc[mt][0], z1 = acc[mt][1];
            u32x2 o; o.x = cvt_pk_bf16(z0[0] * ps0[0] * bf_lo(sg[mt][0].x), z0[1] * ps0[1] * bf_hi(sg[mt][0].x)); o.y = cvt_pk_bf16(z0[2] * ps0[2] * bf_lo(sg[mt][0].y), z0[3] * ps0[3] * bf_hi(sg[mt][0].y));
            *(u32x2*)(ZS + off) = o;
            o.x = cvt_pk_bf16(z1[0] * ps1[0] * bf_lo(sg[mt][1].x), z1[1] * ps1[1] * bf_hi(sg[mt][1].x)); o.y = cvt_pk_bf16(z1[2] * ps1[2] * bf_lo(sg[mt][1].y), z1[3] * ps1[3] * bf_hi(sg[mt][1].y));
            *(u32x2*)(ZS + off + 16) = o;
        }
    }
    __syncthreads();
}
template <int MT> __device__ __forceinline__ void pool_unit(const Params& p, int r0, int k, unsigned char* lds, int tid) {
    const int lane = tid & 63, w8 = tid >> 6, lr = lane & 15, lq = lane >> 4;
    bf16_t* A = (bf16_t*)lds;
    const bf16_t* Wb = (const bf16_t*)(p.ws + WS_WPOOL) + ((size_t)k * 256 + 32 * w8 + lr) * 128 + 8 * lq;
    bf16x8 b0[4], b1[4];
#pragma unroll
    for (int ks = 0; ks < 4; ++ks) { b0[ks] = *(const bf16x8*)(Wb + 32 * ks); b1[ks] = *(const bf16x8*)(Wb + 16 * 128 + 32 * ks); }
    if (k == 0) pool_fill<0>(p, r0, A, tid, MT); else if (k == 1) pool_fill<1>(p, r0, A, tid, MT); else if (k == 2) pool_fill<2>(p, r0, A, tid, MT); else pool_fill<3>(p, r0, A, tid, MT);
    __syncthreads();
    f32x4 acc[MT][2];
#pragma unroll
    for (int i = 0; i < MT; ++i) { acc[i][0] = (f32x4){0.f, 0.f, 0.f, 0.f}; acc[i][1] = (f32x4){0.f, 0.f, 0.f, 0.f}; }
#pragma unroll
    for (int ks = 0; ks < 4; ++ks) {
#pragma unroll
        for (int mt = 0; mt < MT; ++mt) { const bf16x8 af = *(const bf16x8*)(A + (16 * mt + lr) * PA_PITCH + 32 * ks + 8 * lq);
            acc[mt][0] = MFMA16(b0[ks], af, acc[mt][0]); acc[mt][1] = MFMA16(b1[ks], af, acc[mt][1]); }
    }
    const bf16_t* SGP = (const bf16_t*)(p.ws + WS_SGP); bf16_t* ZS = (bf16_t*)(p.ws + WS_ZS);
#pragma unroll
    for (int nt = 0; nt < 2; ++nt) {
        const int col = k * 256 + 32 * w8 + 16 * nt + 4 * lq;
        const f32x4 ps = *(const f32x4*)(p.in[23] + col);
#pragma unroll
        for (int mt = 0; mt < MT; ++mt) {
            const size_t off = (size_t)(r0 + 16 * mt + lr) * 1024 + col;
            const u32x2 sg = *(const u32x2*)(SGP + off); const f32x4 z = acc[mt][nt];
            u32x2 o; o.x = cvt_pk_bf16(z[0] * ps[0] * bf_lo(sg.x), z[1] * ps[1] * bf_hi(sg.x)); o.y = cvt_pk_bf16(z[2] * ps[2] * bf_lo(sg.y), z[3] * ps[3] * bf_hi(sg.y));
            *(u32x2*)(ZS + off) = o;
        }
    }
    __syncthreads();
}

template <int NT> __device__ __forceinline__ void skinny_unit(const bf16_t* A, int lda, const bf16_t* Bt, int ldb, int K, int arow0, const int (&brow)[NT], unsigned char* lds, int tid) {
    const int lane = tid & 63, w = tid >> 6, lr = lane & 15, lq = lane >> 4, kper = K >> 3, k0 = w * kper;
    constexpr int TW = 16 * NT;
    float* red = (float*)lds;
    f32x4 acc[4][NT];
#pragma unroll
    for (int i = 0; i < 4; ++i)
#pragma unroll
        for (int n = 0; n < NT; ++n) acc[i][n] = (f32x4){0.f, 0.f, 0.f, 0.f};
    const bf16_t* Ap = A + (size_t)(arow0 + lr) * lda + k0 + 8 * lq;
    const bf16_t* Bp[NT];
#pragma unroll
    for (int n = 0; n < NT; ++n) Bp[n] = Bt + (size_t)(brow[n] + lr) * ldb + k0 + 8 * lq;
    const int nks = kper >> 5;
    int ks = 0;
    for (; ks + 2 <= nks; ks += 2) {
        bf16x8 bf[2][NT], af[2][4];
#pragma unroll
        for (int u = 0; u < 2; ++u) {
#pragma unroll
            for (int n = 0; n < NT; ++n) bf[u][n] = *(const bf16x8*)(Bp[n] + 32 * (ks + u));
#pragma unroll
            for (int mt = 0; mt < 4; ++mt) af[u][mt] = *(const bf16x8*)(Ap + (size_t)(16 * mt) * lda + 32 * (ks + u)); }
#pragma unroll
        for (int u = 0; u < 2; ++u)
#pragma unroll
            for (int mt = 0; mt < 4; ++mt)
#pragma unroll
                for (int n = 0; n < NT; ++n) acc[mt][n] = MFMA16(bf[u][n], af[u][mt], acc[mt][n]);
    }
    for (; ks < nks; ++ks) {
        bf16x8 bf[NT];
#pragma unroll
        for (int n = 0; n < NT; ++n) bf[n] = *(const bf16x8*)(Bp[n] + 32 * ks);
#pragma unroll
        for (int mt = 0; mt < 4; ++mt) { const bf16x8 af = *(const bf16x8*)(Ap + (size_t)(16 * mt) * lda + 32 * ks);
#pragma unroll
            for (int n = 0; n < NT; ++n) acc[mt][n] = MFMA16(bf[n], af, acc[mt][n]); }
    }
#pragma unroll
    for (int mt = 0; mt < 4; ++mt)
#pragma unroll
        for (int n = 0; n < NT; ++n) *(f32x4*)(red + ((size_t)(w * 64 + 16 * mt + lr)) * TW + 16 * n + 4 * lq) = acc[mt][n];
    __syncthreads();
#pragma unroll
    for (int q = 0; q < NT / 2; ++q) {
        const int o = (q * 512 + tid) * 4;
        f32x4 s = *(const f32x4*)(red + o);
#pragma unroll
        for (int v = 1; v < 8; ++v) s += *(const f32x4*)(red + v * 64 * TW + o);
        *(f32x4*)(red + o) = s;
    }
    __syncthreads();
}
#define LAS __attribute__((address_space(3)))
#define XB_TMO      128
#define XB_XCNT(j)  (256  + 64 * (j))
#define XB_XSUB(j)  (1280 + 64 * (j))
#define XB_XGEN(j)  (2304 + 64 * (j))
#define XB_TOP      3328
#define XB_TOPGEN   3392
#define XCD_BAR_WORDS 3456
#define XB_SPIN_CAP (1u << 18)

__device__ __forceinline__ unsigned xb_ld(unsigned* p)              { return __hip_atomic_load(p, __ATOMIC_RELAXED, __HIP_MEMORY_SCOPE_AGENT); }
__device__ __forceinline__ unsigned xb_add(unsigned* p, unsigned v) { return __hip_atomic_fetch_add(p, v, __ATOMIC_RELAXED, __HIP_MEMORY_SCOPE_AGENT); }
__device__ __forceinline__ unsigned xb_xcc_id() { return (unsigned)__builtin_amdgcn_s_getreg((3 << 11) | 20) & 0xFu; }
#define XB_SPIN(cond, bar) do { unsigned _sp = 0; while (cond) { __builtin_amdgcn_s_sleep(1); \
    if ((++_sp & 255u) == 0u) { if (xb_ld(&(bar)[XB_TMO])) break; if (_sp > XB_SPIN_CAP) { atomicAdd(&(bar)[XB_TMO], 1u); break; } } } } while (0)

struct XcdBarrier {
    unsigned* bar; unsigned x;
    volatile LAS unsigned* st;
};

__device__ __forceinline__ XcdBarrier xcd_barrier_post(unsigned* bar, volatile LAS unsigned* st) {
    XcdBarrier b; b.bar = bar; b.x = xb_xcc_id(); b.st = st;
    if (threadIdx.x == 0) (void)xb_add(&bar[XB_XCNT(b.x)], 1u);
    return b;
}
__device__ __forceinline__ void xcd_barrier_complete(unsigned* bar, unsigned x, unsigned& nloc, unsigned& nx) {
    const unsigned G = gridDim.x * gridDim.y * gridDim.z;
    unsigned sum, cnt, mine, sp = 0u;
    for (;;) {
        sum = 0u; cnt = 0u; mine = 0u;
#pragma unroll
        for (unsigned j = 0; j < 16; ++j) { const unsigned c = xb_ld(&bar[XB_XCNT(j)]); sum += c; cnt += (c > 0u) ? 1u : 0u; mine = (j == x) ? c : mine; }
        if (sum == G) break;
        __builtin_amdgcn_s_sleep(1);
        if ((++sp & 255u) == 0u) { if (xb_ld(&bar[XB_TMO])) break; if (sp > XB_SPIN_CAP) { atomicAdd(&bar[XB_TMO], 1u); break; } }
    }
    nloc = mine > 0u ? mine : 1u; nx = cnt > 0u ? cnt : 1u;
}

__device__ __forceinline__ void xcd_barrier(const XcdBarrier& b) {
    asm volatile("s_waitcnt vmcnt(0)" ::: "memory");
    __syncthreads();
    if (threadIdx.x == 0) {
        unsigned* bar = b.bar;
        __builtin_amdgcn_s_waitcnt(0);
        unsigned nloc = b.st[0], nx = b.st[1];
        if (nloc == 0u) { xcd_barrier_complete(bar, b.x, nloc, nx); b.st[0] = nloc; b.st[1] = nx; }
        const unsigned old = xb_add(&bar[XB_XSUB(b.x)], 1u);
        const unsigned gen = old / nloc;
        if (old + 1u == (gen + 1u) * nloc) {
            __builtin_amdgcn_fence(__ATOMIC_RELEASE, "agent");
            asm volatile("s_waitcnt vmcnt(0)" ::: "memory");
            const unsigned og = xb_add(&bar[XB_TOP], 1u);
            const unsigned tg = og / nx;
            if (og + 1u == (tg + 1u) * nx) xb_add(&bar[XB_TOPGEN], 1u);
            else XB_SPIN(xb_ld(&bar[XB_TOPGEN]) == tg, bar);
            __builtin_amdgcn_fence(__ATOMIC_ACQUIRE, "agent");
            xb_add(&bar[XB_XGEN(b.x)], 1u);
            asm volatile("s_waitcnt vmcnt(0)" ::: "memory");
        } else {
            XB_SPIN(xb_ld(&bar[XB_XGEN(b.x)]) == gen, bar);
            __builtin_amdgcn_fence(__ATOMIC_ACQUIRE, "agent");
            asm volatile("s_waitcnt vmcnt(0)" ::: "memory");
        }
    }
    __syncthreads();
}

constexpr int MISC_OFF = LDS_BYTES - 64;
constexpr size_t WS_BAR = 0;
#ifndef PG_ALIGN
#define PG_ALIGN true
#endif
#ifndef PG_SP2
#define PG_SP2 true
#endif
#ifndef REP3A
#define REP3A 1
#endif
#ifndef REP3B
#define REP3B 1
#endif
#ifndef REP3C
#define REP3C 1
#endif
#ifndef REP0
#define REP0 1
#endif
#ifndef REP1
#define REP1 1
#endif
#ifndef REP2
#define REP2 1
#endif
#ifndef REP3
#define REP3 1
#endif
#ifndef REP4
#define REP4 1
#endif
#ifndef REP5
#define REP5 1
#endif
#ifndef REP6
#define REP6 1
#endif
#ifndef REP7
#define REP7 1
#endif
#ifndef REP8
#define REP8 1
#endif
#ifndef REP9
#define REP9 1
#endif
__global__ void __launch_bounds__(512, 2) mk_fwd(Params p) {
    extern __shared__ __attribute__((aligned(16))) unsigned char lds[];
    cg::grid_group grid = cg::this_grid();
    const int tid = threadIdx.x, lane = tid & 63, wave = __builtin_amdgcn_readfirstlane(tid >> 6), G = gridDim.x, bid = blockIdx.x;
    const int gw = bid * 8 + wave, NGW = G * 8;
    PG8_LAS unsigned char* ldsg = (PG8_LAS unsigned char*)lds;
    float* mod = (float*)(p.ws + WS_MOD);
    float* out = p.out;
    if (tid < 16) ((volatile LAS unsigned*)(ldsg + MISC_OFF))[tid] = 0u;
    __syncthreads();
    XcdBarrier xbar = xcd_barrier_post((unsigned*)(p.ws + WS_BAR), (volatile LAS unsigned*)(ldsg + MISC_OFF));
    if (p.ph_hi > 1000) grid.sync();
#define IN(k) (p.ph_lo <= (k) && (k) < p.ph_hi)
#define GSYNC() xcd_barrier(xbar)
#define SEAM(k) do { if (IN(k) && IN((k) + 1)) GSYNC(); } while (0)

#ifdef EXTRA_SYNCS
    for (int i_ = 0; i_ < EXTRA_SYNCS; ++i_) GSYNC();
#endif
    if (IN(0)) for (int rep_ = 0; rep_ < REP0; ++rep_) { if (rep_) GSYNC();
        for (int u = bid; u < 192; u += G) ada_unit(p, u, lds, tid);
        float* scr = (float*)lds + wave * (64 * 33);
        {
            const bool freeblk = bid >= 192;
            for (int i = 0; i < (freeblk ? 2 : 1); ++i) {
                int r = freeblk ? i * 512 + (gw - 1536) : 1024 + gw;
                if (r < TR_ITEMS[0]) tr_item(p, 0, r, scr, lane);
                else if ((r -= TR_ITEMS[0]) < TR_ITEMS[1]) tr_item(p, 1, r, scr, lane);
                else if ((r -= TR_ITEMS[1]) < TR_ITEMS[5]) tr_item(p, 5, r, scr, lane);
            }
        }
        {
            float* spool = out + (size_t)NTOK * DM + 16384 + 16384 + 61440 + 262144 + 262144;
            const float* sp = p.in[6];
            for (int i = bid * 512 + tid; i < 128 * 11 * 128; i += G * 512) { const int s = i / (11 * 128), q = i % (11 * 128);
                *(f32x4*)(spool + (size_t)s * 15 * 512 + 4 * q) = *(const f32x4*)(sp + (size_t)s * 15 * 512 + 4 * 512 + 4 * q); }
        }
    }
    SEAM(0);
    if (IN(1)) for (int rep_ = 0; rep_ < REP1; ++rep_) { if (rep_) GSYNC(); for (int u = bid; u < 96; u += G) ssm_prep_unit(p, u / 3, u % 3, lds, tid); modnorm_rows<false>(p.in[0], p.in[1], p.in[7], mod, 0, 1, (bf16_t*)(p.ws + WS_H), bid < 96 ? 44 * bid : 4224 + 80 * (bid - 96), bid < 96 ? 44 * bid + 44 : (4224 + 80 * (bid - 95) < NTOK ? 4224 + 80 * (bid - 95) : NTOK), wave, lane); }
    SEAM(1);
    if (IN(2)) for (int rep_ = 0; rep_ < REP2; ++rep_) { if (rep_) GSYNC();
        pg8::Gemm g{(const bf16_t*)(p.ws + WS_H), (const bf16_t*)(p.ws + WS_WIN), NP, 3072, 1024}; pg8::StaticOrder S; S.init(NP, 3072, G, bid);
        EpiG1 E{(bf16_t*)(p.ws + WS_US), (bf16_t*)(p.ws + WS_UP), (bf16_t*)(p.ws + WS_SGS), (bf16_t*)(p.ws + WS_SGP),
                out + (size_t)NTOK * DM + 32768, out + (size_t)NTOK * DM + 32768 + 61440 + 524288};
        pg8::gemm_phase<EpiG1, pg8::StaticOrder, PG_ALIGN, PG_SP2>(ldsg, g, S, E);
#ifdef DUP2
        GSYNC(); pg8::gemm_phase<EpiG1, pg8::StaticOrder, PG_ALIGN, PG_SP2>(ldsg, g, S, E);
#endif
        for (int u = bid; u < 8 * 48; u += G) {
            const int rt = u / 48, ct = u % 48;
            const int br_[4] = {64 * ct, 64 * ct + 16, 64 * ct + 32, 64 * ct + 48};
            skinny_unit<4>((const bf16_t*)(p.ws + WS_H), 1024, (const bf16_t*)(p.ws + WS_WIN), 1024, 1024, NP + 64 * rt, br_, lds, tid);
            const float* tp = (const float*)lds + (tid >> 3) * 64 + (tid & 7) * 8;
            E.emit(NP + 64 * rt + (tid >> 3), 64 * ct + (tid & 7) * 8, ct >> 2, *(const f32x4*)tp, *(const f32x4*)(tp + 4));
            __syncthreads();
        }
    }
    SEAM(2);
    if (IN(3)) for (int rep_ = 0; rep_ < REP3; ++rep_) { if (rep_) GSYNC();
        for (int ra_ = 0; ra_ < REP3A; ++ra_) for (int u = bid; u < 256; u += G) {
            int ub = u >> 5, ug = u & 31;
            if (G == 256) { const int x = u & 7, y = u >> 3, quad = x + 8 * (y >> 2); ub = quad >> 3; ug = 4 * (quad & 7) + (y & 3); }
            ssm_block(p, ub, ug, lds, tid); }
        for (int rb_ = 0; rb_ < REP3B; ++rb_) { for (int u = bid; u < 256; u += G) pool_pair(p, u >> 2, u & 3, lds, tid); for (int u = G - 1 - bid; u < 64; u += G) pool_unit<2>(p, NP + 32 * (u >> 2), u & 3, lds, tid); }
        for (int rc_ = 0; rc_ < REP3C; ++rc_) for (int it = gw; it < 128 * 32; it += NGW) ssm_sample_item(p, it >> 5, it & 31, lane);
        {
            float* scr = (float*)lds + wave * (64 * 33);
            for (int it = gw; it < TR_ITEMS[2] + TR_ITEMS[3]; it += NGW) { if (it < TR_ITEMS[2]) tr_item(p, 2, it, scr, lane); else tr_item(p, 3, it - TR_ITEMS[2], scr, lane); }
        }
    }
    SEAM(3);
    if (IN(4)) for (int rep_ = 0; rep_ < REP4; ++rep_) { if (rep_) GSYNC();
        pg8::Gemm g{(const bf16_t*)(p.ws + WS_GY), (const bf16_t*)(p.ws + WS_WGLU), NP, 2048, 512}; pg8::StaticOrder S; S.init(NP, 2048, G, bid);
        EpiGLU E{(const bf16_t*)(p.ws + WS_SGS), (const bf16_t*)(p.ws + WS_ZS), (bf16_t*)(p.ws + WS_H)};
        pg8::gemm_phase<EpiGLU, pg8::StaticOrder, PG_ALIGN, PG_SP2>(ldsg, g, S, E);
        for (int u = bid; u < 256; u += G) {
            const int rt = u >> 5, jt = u & 31, j0 = 32 * jt, ra = 256 * (j0 >> 7) + (j0 & 127);
            const int br_[4] = {ra, ra + 16, ra + 128, ra + 144};
            skinny_unit<4>((const bf16_t*)(p.ws + WS_GY), 512, (const bf16_t*)(p.ws + WS_WGLU), 512, 512, NP + 64 * rt, br_, lds, tid);
            const float* tp = (const float*)lds + (tid >> 3) * 64 + (tid & 7) * 4;
            const f32x4 a = *(const f32x4*)tp, b = *(const f32x4*)(tp + 32);
            const size_t off = (size_t)(NP + 64 * rt + (tid >> 3)) * 1024 + j0 + (tid & 7) * 4;
            const u32x2 sg = *(const u32x2*)(E.SGS + off), zs = *(const u32x2*)(E.ZS + off);
            u32x2 o;
            o.x = cvt_pk_bf16(bf_lo(sg.x) * a[0] * fsigmoid(b[0]) + bf_lo(zs.x), bf_hi(sg.x) * a[1] * fsigmoid(b[1]) + bf_hi(zs.x));
            o.y = cvt_pk_bf16(bf_lo(sg.y) * a[2] * fsigmoid(b[2]) + bf_lo(zs.y), bf_hi(sg.y) * a[3] * fsigmoid(b[3]) + bf_hi(zs.y));
            *(u32x2*)(E.MGD + off) = o;
            __syncthreads();
        }
    }
    SEAM(4);
    if (IN(5)) for (int rep_ = 0; rep_ < REP5; ++rep_) { if (rep_) GSYNC();
        pg8::Gemm g{(const bf16_t*)(p.ws + WS_H), (const bf16_t*)(p.ws + WS_WOUT), NP, 1024, 1024}; pg8::StaticOrder S; S.init(NP, 1024, G, bid);
        EpiRes<0> E{p.in[0], nullptr, mod + 2 * DM, (bf16_t*)(p.ws + WS_XB)};
        pg8::gemm_phase<EpiRes<0>, pg8::StaticOrder, PG_ALIGN, PG_SP2>(ldsg, g, S, E);
        for (int u = bid; u < 256; u += G) {
            const int rt = u >> 5, ct = u & 31;
            const int br_[2] = {32 * ct, 32 * ct + 16};
            skinny_unit<2>((const bf16_t*)(p.ws + WS_H), 1024, (const bf16_t*)(p.ws + WS_WOUT), 1024, 1024, NP + 64 * rt, br_, lds, tid);
            const int row = 64 * rt + (tid >> 3), col = 32 * ct + 4 * (tid & 7), r = NP + row;
            const f32x4 a = *(const f32x4*)((const float*)lds + tid * 4);
            const f32x4 x = *(const f32x4*)(p.in[1] + (size_t)row * DM + col), gt = *(const f32x4*)(mod + (size_t)mrow(r) * 6144 + 2 * DM + col);
            { const f32x4 v = x + gt * a; u32x2 wv; wv.x = cvt_pk_bf16(v[0], v[1]); wv.y = cvt_pk_bf16(v[2], v[3]); *(u32x2*)((bf16_t*)(p.ws + WS_XB) + (size_t)r * DM + col) = wv; }
            __syncthreads();
        }
    }
    SEAM(5);
    if (IN(6)) for (int rep_ = 0; rep_ < REP6; ++rep_) { if (rep_) GSYNC(); modnorm_rows<true>((const float*)(p.ws + WS_XB), nullptr, p.in[8], mod, 3, 4, (bf16_t*)(p.ws + WS_H), 66 * bid, 66 * bid + 66, wave, lane); }
    SEAM(6);
    if (IN(7)) for (int rep_ = 0; rep_ < REP7; ++rep_) { if (rep_) GSYNC();
        pg8::Gemm g{(const bf16_t*)(p.ws + WS_H), (const bf16_t*)(p.ws + WS_WFI), NTOK, 2 * DFF, 1024}; pg8::StaticOrder S; S.init(NTOK, 2 * DFF, G, bid);
        EpiSwiGLU E{(bf16_t*)(p.ws + WS_ACT)};
        pg8::gemm_phase<EpiSwiGLU, pg8::StaticOrder, PG_ALIGN, PG_SP2>(ldsg, g, S, E);
#ifdef DUP7
        GSYNC(); pg8::gemm_phase<EpiSwiGLU, pg8::StaticOrder, PG_ALIGN, PG_SP2>(ldsg, g, S, E);
#endif
        {
            const int nun = (NTOK / 256) * (2 * DFF / 256), full = nun / G, rem = nun % G;
            if (rem != 0 && bid >= rem) { float* scr = (float*)lds + wave * (64 * 33); const int nidle = (G - rem) * 8;
                for (int it = (bid - rem) * 8 + wave; it < TR_ITEMS[4]; it += nidle) tr_item(p, 4, it, scr, lane); }
            else if (rem == 0) { float* scr = (float*)lds + wave * (64 * 33); for (int it = gw; it < TR_ITEMS[4]; it += NGW) tr_item(p, 4, it, scr, lane); }
            (void)full;
        }
    }
    SEAM(7);
    if (IN(8)) for (int rep_ = 0; rep_ < REP8; ++rep_) { if (rep_) GSYNC();
        pg8::Gemm g{(const bf16_t*)(p.ws + WS_ACT), (const bf16_t*)(p.ws + WS_WFO), NP, 1024, DFF}; pg8::StaticOrder S; S.init(NP, 1024, G, bid);
        EpiRes<1> E{nullptr, (const bf16_t*)(p.ws + WS_XB), mod + 5 * DM, (bf16_t*)(p.ws + WS_H)};
        pg8::gemm_phase<EpiRes<1>, pg8::StaticOrder, PG_ALIGN, PG_SP2>(ldsg, g, S, E);
#ifdef DUP8
        GSYNC(); pg8::gemm_phase<EpiRes<1>, pg8::StaticOrder, PG_ALIGN, PG_SP2>(ldsg, g, S, E);
#endif
        for (int u = bid; u < 256; u += G) {
            const int rt = u >> 5, ct = u & 31;
            const int br_[2] = {32 * ct, 32 * ct + 16};
            skinny_unit<2>((const bf16_t*)(p.ws + WS_ACT), DFF, (const bf16_t*)(p.ws + WS_WFO), DFF, DFF, NP + 64 * rt, br_, lds, tid);
            const int row = 64 * rt + (tid >> 3), col = 32 * ct + 4 * (tid & 7), r = NP + row;
            const f32x4 a = *(const f32x4*)((const float*)lds + tid * 4);
            const u32x2 xq = *(const u32x2*)((const bf16_t*)(p.ws + WS_XB) + (size_t)r * DM + col);
            const f32x4 x = (f32x4){bf_lo(xq.x), bf_hi(xq.x), bf_lo(xq.y), bf_hi(xq.y)}, gt = *(const f32x4*)(mod + (size_t)mrow(r) * 6144 + 5 * DM + col);
            { const f32x4 v = x + gt * a; u32x2 wv; wv.x = cvt_pk_bf16(v[0], v[1]); wv.y = cvt_pk_bf16(v[2], v[3]); *(u32x2*)((bf16_t*)(p.ws + WS_H) + (size_t)r * DM + col) = wv; }
            __syncthreads();
        }
    }
    SEAM(8);
    if (IN(9)) for (int rep_ = 0; rep_ < REP9; ++rep_) { if (rep_) GSYNC();
        const float* gf = p.in[9];
        f32x4 gg[4];
#pragma unroll
        for (int j = 0; j < 4; ++j) gg[j] = *(const f32x4*)(gf + 4 * lane + 256 * j);
        for (int r0 = gw; r0 < NTOK; r0 += 2 * NGW) {
            const int rr[2] = {r0, (r0 + NGW < NTOK) ? r0 + NGW : r0};
            f32x4 v[2][4]; float s[2];
#pragma unroll
            for (int h = 0; h < 2; ++h) { const bf16_t* xbr = (const bf16_t*)(p.ws + WS_H) + (size_t)rr[h] * DM + 4 * lane;
#pragma unroll
                for (int j = 0; j < 4; ++j) { const u32x2 q = *(const u32x2*)(xbr + 256 * j); v[h][j] = (f32x4){bf_lo(q.x), bf_hi(q.x), bf_lo(q.y), bf_hi(q.y)}; } }
#pragma unroll
            for (int h = 0; h < 2; ++h) { s[h] = 0.f;
#pragma unroll
                for (int j = 0; j < 4; ++j) s[h] += (v[h][j][0] * v[h][j][0] + v[h][j][1] * v[h][j][1]) + (v[h][j][2] * v[h][j][2] + v[h][j][3] * v[h][j][3]); }
#pragma unroll
            for (int o = 1; o < 64; o <<= 1) { s[0] += __shfl_xor(s[0], o); s[1] += __shfl_xor(s[1], o); }
#pragma unroll
            for (int h = 0; h < 2; ++h) if (h == 0 || rr[1] != rr[0]) {
                const float inv = rsqrtf(s[h] * (1.0f / DM) + EPS); float* xr = out + (size_t)rr[h] * DM + 4 * lane;
#pragma unroll
                for (int j = 0; j < 4; ++j) *(f32x4*)(xr + 256 * j) = (v[h][j] * inv) * gg[j];
            }
        }
    }
#undef IN
#undef SEAM
}

#ifndef MK_N_LAUNCHES
#define MK_N_LAUNCHES 1
#endif
extern "C" void kernel_launch(void* const* d_in, const int* in_sizes, int n_in, void* d_out, int out_size, void* d_ws, size_t ws_size, hipStream_t stream) {
    static int grid = 0;
    if (grid == 0) {
        int dev = 0, cus = 0, per_cu = 0;
        if (hipGetDevice(&dev) != hipSuccess || hipDeviceGetAttribute(&cus, hipDeviceAttributeMultiprocessorCount, dev) != hipSuccess) { fprintf(stderr, "kernel_launch: device query failed\n"); grid = -1; return; }
        if (hipFuncSetAttribute((const void*)mk_fwd, hipFuncAttributeMaxDynamicSharedMemorySize, LDS_BYTES) != hipSuccess) { fprintf(stderr, "kernel_launch: hipFuncSetAttribute failed\n"); grid = -1; return; }
        if (hipOccupancyMaxActiveBlocksPerMultiprocessor(&per_cu, (const void*)mk_fwd, 512, LDS_BYTES) != hipSuccess || per_cu < 1) { fprintf(stderr, "kernel_launch: occupancy query says %d blocks/CU\n", per_cu); (void)hipGetLastError(); grid = -1; return; }
        grid = cus * per_cu;
        if (n_in != 27 || ws_size < 232 * MiB) { fprintf(stderr, "kernel_launch: unexpected n_in %d / ws %zu\n", n_in, ws_size); grid = -1; return; }
    }
    if (grid < 0) return;
    if (hipMemsetAsync((char*)d_ws + WS_BAR, 0, 32768, stream) != hipSuccess) { fprintf(stderr, "kernel_launch: memset failed\n"); return; }
    Params p{};
    for (int i = 0; i < 27; ++i) p.in[i] = (const float*)d_in[i];
    p.out = (float*)d_out; p.ws = (unsigned char*)d_ws;
#if MK_N_LAUNCHES == 1
    p.ph_lo = 0; p.ph_hi = 10;
    void* args[] = {&p};
    hipError_t e = hipLaunchCooperativeKernel((const void*)mk_fwd, dim3(grid), dim3(512), args, LDS_BYTES, stream);
    if (e != hipSuccess) fprintf(stderr, "kernel_launch: cooperative launch failed: %s (grid %d)\n", hipGetErrorString(e), grid);
#else
    for (int ph = 0; ph < 10; ++ph) { p.ph_lo = ph; p.ph_hi = ph + 1; hipLaunchKernelGGL(mk_fwd, dim3(grid), dim3(512), LDS_BYTES, stream, p); }
#endif
}
```

```cpp
#include <hip/hip_runtime.h>
#include <hip/hip_cooperative_groups.h>
#include <cstdio>
#include <cstdint>
namespace cg = cooperative_groups;
namespace pg8 {
#define PG8_LAS __attribute__((address_space(3)))
typedef unsigned short bf16_t;
typedef short bf16x8 __attribute__((ext_vector_type(8)));
typedef float f32x4 __attribute__((ext_vector_type(4)));
typedef unsigned u32x4 __attribute__((ext_vector_type(4)));
constexpr int BM = 256, BK = 64, HALF = 128, HTB = HALF * BK * 2  , STAGE_BYTES = 8 * HTB, NXCD = 8, WGM = 8;

__host__ __device__ __forceinline__ int lds_byte(int r, int c) { const int st = (r >> 4) * 2 + (c >> 5), rr = r & 15, cc = c & 31, ob = rr * 64 + cc * 2; return st * 1024 + (ob ^ (((ob >> 9) & 1) << 5)); }
__host__ __device__ __forceinline__ void stage_rc(int b, int& R, int& C) { const int st = b / 1024, sb = b % 1024, swz = sb ^ (((sb >> 9) & 1) << 5); R = (st >> 1) * 16 + swz / 64; C = (st & 1) * 32 + (swz % 64) / 2; }
__host__ __device__ __forceinline__ int perm32(int rho) { const int n = rho >> 4, i = rho & 15; return 8 * (i >> 2) + 4 * n + (i & 3); }

struct Unit { int pm, pn; };
struct Gemm { const bf16_t* A; const bf16_t* Bt; int M, N, K; };

struct StaticOrder {
    int nM, nN, nwg, G, c;
    __host__ __device__ void init(int M, int N, int G_, int c_) { nM = M / BM; nN = N / BM; nwg = nM * nN; G = G_; c = c_; }
    __host__ __device__ bool next(int i, Unit& u) const {
        const long L = (long)i * G + c; if (L >= nwg) return false;
        int wgid = (int)L; { const int q = nwg / NXCD, r = nwg % NXCD, xcd = wgid % NXCD, off = wgid / NXCD; wgid = (xcd < r ? xcd * (q + 1) : r * (q + 1) + (xcd - r) * q) + off; }
        const int nig = WGM * nN, gid = wgid / nig, fm = gid * WGM, gsz = (nM - fm) < WGM ? (nM - fm) : WGM;
        u.pm = fm + ((wgid % nig) % gsz); u.pn = (wgid % nig) / gsz; return true;
    }
    __device__ __forceinline__ void a_ready(const Unit&) const {}
    __device__ __forceinline__ void done(const Unit&) const {}
};
__device__ __forceinline__ unsigned cvt_pk_bf16(float lo, float hi) { unsigned r; asm volatile("v_cvt_pk_bf16_f32 %0, %1, %2" : "=v"(r) : "v"(lo), "v"(hi)); return r; }
template <class Epi, class Sched, bool ALIGN_EPI = false, bool SP2 = false>
__device__ __forceinline__ void gemm_phase(PG8_LAS unsigned char* lds, const Gemm g, const Sched& S, const Epi& E) {
    const int tid = threadIdx.x, wid = __builtin_amdgcn_readfirstlane(tid >> 6), lane = tid & 63, wr = wid >> 2, wc = wid & 3, fr = lane & 15, fq = lane >> 4;
    const int K = g.K, nt = K / BK;
    unsigned voffA[2], voffB[2];
#pragma unroll
    for (int i = 0; i < 2; ++i) { int R, C; stage_rc(tid * 16 + i * 8192, R, C); const int Rb = Epi::PERM ? ((R & ~31) + perm32(R & 31)) : R;
        voffA[i] = (unsigned)(R * K + C) * 2u; voffB[i] = (unsigned)(Rb * K + C) * 2u; }
    const size_t kstep = (size_t)(BK * 2);
    const size_t hstep = (size_t)HALF * K * 2;
    const size_t tstep = 2 * hstep;
    const unsigned ldsw = (unsigned)wid * 1024u;
    const int aoff = lds_byte(wr * 64 + fr, fq * 8), boff = lds_byte(wc * 32 + fr, fq * 8);
#define PG8_SA(b, h) (((b) * 2 + (h)) * HTB)
#define PG8_SB(b, h) ((4 + (b) * 2 + (h)) * HTB)
#define PG8_STAGE(bufoff, gbase, voff) do { _Pragma("unroll") for (int _i = 0; _i < 2; ++_i) \
        __builtin_amdgcn_global_load_lds((const unsigned*)((const char*)(gbase) + (voff)[_i]), (PG8_LAS unsigned*)(lds + (bufoff) + ldsw + _i * 8192), 16, 0, 0); } while (0)
#define PG8_LDA(dst, b, h) do { _Pragma("unroll") for (int m = 0; m < 4; ++m) _Pragma("unroll") for (int k = 0; k < 2; ++k) dst[m][k] = *(const PG8_LAS bf16x8*)(lds + PG8_SA(b, h) + aoff + m * 2048 + k * 1024); } while (0)
#define PG8_LDB(dst, b, h) do { _Pragma("unroll") for (int n = 0; n < 2; ++n) _Pragma("unroll") for (int k = 0; k < 2; ++k) dst[n][k] = *(const PG8_LAS bf16x8*)(lds + PG8_SB(b, h) + boff + n * 2048 + k * 1024); } while (0)
#define PG8_MMA(ai, bj, At, Bt) do { __builtin_amdgcn_s_setprio(1); _Pragma("unroll") for (int m = 0; m < 4; ++m) _Pragma("unroll") for (int n = 0; n < 2; ++n) _Pragma("unroll") for (int k = 0; k < 2; ++k) \
        acc[ai][bj][m][n] = __builtin_amdgcn_mfma_f32_16x16x32_bf16(Bt[n][k], At[m][k], acc[ai][bj][m][n], 0, 0, 0); __builtin_amdgcn_s_setprio(0); } while (0)
#define PG8_WAIT_V(n) asm volatile("s_waitcnt vmcnt(" #n ")" ::: "memory")
#define PG8_WAIT_L(n) asm volatile("s_waitcnt lgkmcnt(" #n ")" ::: "memory")
#define PG8_BAR __builtin_amdgcn_s_barrier()
#define PG8_SCHED __builtin_amdgcn_sched_barrier(0)
    Unit cur, nxt; int ui = 0;
    if (!S.next(0, cur)) return;
    f32x4 acc[2][2][4][2];
#pragma unroll
    for (int a = 0; a < 2; ++a)
#pragma unroll
        for (int b = 0; b < 2; ++b)
#pragma unroll
            for (int m = 0; m < 4; ++m)
#pragma unroll
                for (int n = 0; n < 2; ++n) acc[a][b][m][n] = (f32x4){0.f, 0.f, 0.f, 0.f};
    bf16x8 At[4][2], B0[2][2], B1[2][2];
    const char* cA = (const char*)g.A + (size_t)cur.pm * tstep; const char* cB = (const char*)g.Bt + (size_t)cur.pn * tstep;
    S.a_ready(cur);
    if constexpr (SP2) {
        PG8_STAGE(PG8_SB(0, 0), cB, voffB); PG8_STAGE(PG8_SB(0, 1), cB + hstep, voffB); PG8_STAGE(PG8_SA(0, 0), cA, voffA); PG8_STAGE(PG8_SA(0, 1), cA + hstep, voffA);
        if (wr == 1) PG8_BAR;
        PG8_WAIT_V(2); PG8_BAR;
        PG8_STAGE(PG8_SB(1, 0), cB + kstep, voffB); PG8_STAGE(PG8_SA(1, 0), cA + kstep, voffA); PG8_STAGE(PG8_SB(1, 1), cB + hstep + kstep, voffB);
        PG8_WAIT_V(6); PG8_BAR;
    } else {
        PG8_STAGE(PG8_SB(0, 0), cB, voffB); PG8_STAGE(PG8_SA(0, 0), cA, voffA); PG8_STAGE(PG8_SB(0, 1), cB + hstep, voffB); PG8_STAGE(PG8_SA(0, 1), cA + hstep, voffA);
        if (wr == 1) PG8_BAR;
        PG8_WAIT_V(4); PG8_BAR;
        PG8_STAGE(PG8_SB(1, 0), cB + kstep, voffB); PG8_STAGE(PG8_SA(1, 0), cA + kstep, voffA); PG8_STAGE(PG8_SB(1, 1), cB + hstep + kstep, voffB);
        PG8_WAIT_V(6); PG8_BAR;
    }
    for (;;) {
        const bool has_next = S.next(ui + 1, nxt);
        const char* nA = has_next ? (const char*)g.A + (size_t)nxt.pm * tstep : cA; const char* nB = has_next ? (const char*)g.Bt + (size_t)nxt.pn * tstep : cB;
        for (int t = 0; t < nt; t += 2) {
            const bool last = (t == nt - 2);
            const char* a1 = cA + (size_t)(t + 1) * kstep;
            const char* a2 = last ? nA : cA + (size_t)(t + 2) * kstep; const char* b2 = last ? nB : cB + (size_t)(t + 2) * kstep;
            const char* a3 = a2 + kstep; const char* b3 = b2 + kstep;
            if (last && has_next) S.a_ready(nxt);
            if constexpr (SP2) {
            PG8_LDB(B0, 0, 0); PG8_LDB(B1, 0, 1); PG8_SCHED; PG8_LDA(At, 0, 0); PG8_STAGE(PG8_SA(1, 1), a1 + hstep, voffA);
            PG8_WAIT_V(8); PG8_WAIT_L(0); PG8_BAR; PG8_MMA(0, 0, At, B0); PG8_MMA(0, 1, At, B1); PG8_BAR; PG8_SCHED;
            PG8_LDA(At, 0, 1); PG8_STAGE(PG8_SB(0, 0), b2, voffB); PG8_STAGE(PG8_SB(0, 1), b2 + hstep, voffB); PG8_STAGE(PG8_SA(0, 0), a2, voffA);
            PG8_WAIT_V(8); PG8_WAIT_L(0); PG8_BAR; PG8_MMA(1, 0, At, B0); PG8_MMA(1, 1, At, B1); PG8_BAR; PG8_SCHED;
            PG8_LDB(B0, 1, 0); PG8_LDB(B1, 1, 1); PG8_SCHED; PG8_LDA(At, 1, 0); PG8_STAGE(PG8_SA(0, 1), a2 + hstep, voffA);
            PG8_WAIT_V(8); PG8_WAIT_L(0); PG8_BAR; PG8_MMA(0, 0, At, B0); PG8_MMA(0, 1, At, B1); PG8_BAR; PG8_SCHED;
            PG8_LDA(At, 1, 1); PG8_STAGE(PG8_SB(1, 0), b3, voffB); PG8_STAGE(PG8_SB(1, 1), b3 + hstep, voffB); PG8_STAGE(PG8_SA(1, 0), a3, voffA);
            PG8_WAIT_V(8); PG8_WAIT_L(0); PG8_BAR; PG8_MMA(1, 0, At, B0); PG8_MMA(1, 1, At, B1); PG8_BAR; PG8_SCHED;
            } else {
            PG8_LDB(B0, 0, 0); PG8_SCHED; PG8_LDA(At, 0, 0); PG8_STAGE(PG8_SA(1, 1), a1 + hstep, voffA);
            PG8_WAIT_L(8); PG8_BAR; PG8_WAIT_L(0); PG8_MMA(0, 0, At, B0); PG8_BAR; PG8_SCHED;
            PG8_LDB(B1, 0, 1); PG8_STAGE(PG8_SB(0, 0), b2, voffB);
            PG8_BAR; PG8_WAIT_L(0); PG8_MMA(0, 1, At, B1); PG8_BAR;
            PG8_LDA(At, 0, 1); PG8_STAGE(PG8_SA(0, 0), a2, voffA);
            PG8_BAR; PG8_WAIT_L(0); PG8_MMA(1, 0, At, B0); PG8_BAR; PG8_SCHED;
            PG8_STAGE(PG8_SB(0, 1), b2 + hstep, voffB);
            PG8_WAIT_V(6); PG8_BAR; PG8_MMA(1, 1, At, B1); PG8_BAR;
            PG8_LDB(B0, 1, 0); PG8_SCHED; PG8_LDA(At, 1, 0); PG8_STAGE(PG8_SA(0, 1), a2 + hstep, voffA);
            PG8_WAIT_L(8); PG8_BAR; PG8_WAIT_L(0); PG8_MMA(0, 0, At, B0); PG8_BAR; PG8_SCHED;
            PG8_LDB(B1, 1, 1); PG8_STAGE(PG8_SB(1, 0), b3, voffB);
            PG8_BAR; PG8_WAIT_L(0); PG8_MMA(0, 1, At, B1); PG8_BAR;
            PG8_LDA(At, 1, 1); PG8_STAGE(PG8_SA(1, 0), a3, voffA);
            PG8_BAR; PG8_WAIT_L(0); PG8_MMA(1, 0, At, B0); PG8_BAR; PG8_SCHED;
            PG8_STAGE(PG8_SB(1, 1), b3 + hstep, voffB);
            PG8_WAIT_V(6); PG8_BAR; PG8_MMA(1, 1, At, B1); PG8_BAR;
            }
        }
        if constexpr (ALIGN_EPI) { if (wr == 0) PG8_BAR; }
        if constexpr (!Epi::AFTER_DRAIN) { E(acc, cur, wr, wc, fr, fq); S.done(cur); }
        if (!has_next) break;
#pragma unroll
        for (int a = 0; a < 2; ++a)
#pragma unroll
            for (int b = 0; b < 2; ++b)
#pragma unroll
                for (int m = 0; m < 4; ++m)
#pragma unroll
                    for (int n = 0; n < 2; ++n) acc[a][b][m][n] = (f32x4){0.f, 0.f, 0.f, 0.f};
        cur = nxt; cA = nA; cB = nB; ++ui;
        if constexpr (ALIGN_EPI) { if (wr == 1) PG8_BAR; }
    }
    PG8_WAIT_V(0);
    if constexpr (!ALIGN_EPI) { if (wr == 0) PG8_BAR; }
    PG8_BAR;
    if constexpr (Epi::AFTER_DRAIN) { E.fused(acc, cur, wr, wc, fr, fq, lds, wid, lane); S.done(cur); }
#undef PG8_SA
#undef PG8_SB
#undef PG8_STAGE
#undef PG8_LDA
#undef PG8_LDB
#undef PG8_MMA
#undef PG8_WAIT_V
#undef PG8_WAIT_L
#undef PG8_BAR
#undef PG8_SCHED
}
}

using pg8::f32x4; using pg8::u32x4; using pg8::bf16x8; using pg8::bf16_t; using pg8::Unit; using pg8::cvt_pk_bf16;
typedef unsigned u32x2 __attribute__((ext_vector_type(2)));
typedef float f32x2 __attribute__((ext_vector_type(2)));

constexpr int DM = 1024, NP = 16384, NS = 512, NTOK = NP + NS, NMODROW = 136, DFF = 2816;
constexpr float EPS = 1e-6f;
constexpr int LDS_BYTES = 147456;
constexpr size_t MiB = 1u << 20;
constexpr size_t WS_CTR = 16384;
constexpr size_t WS_MOD = 1 * MiB;
constexpr size_t WS_SP = 5 * MiB;
constexpr size_t WS_MG = 6 * MiB, WS_EG = 10 * MiB, WS_RG = 12 * MiB;
constexpr size_t WS_WIN = 16 * MiB, WS_WGLU = 22 * MiB, WS_WPOOL = 24 * MiB, WS_WOUT = 25 * MiB, WS_WFI = 27 * MiB, WS_WFO = 39 * MiB;
constexpr size_t WS_H = 48 * MiB;
constexpr size_t WS_US = 82 * MiB, WS_UP = 99 * MiB;
constexpr size_t WS_SGS = 116 * MiB, WS_SGP = 149 * MiB;
constexpr size_t WS_GY = 182 * MiB;
constexpr size_t WS_ZS = 199 * MiB;
constexpr size_t WS_XB = 82 * MiB;
constexpr size_t WS_ACT = 116 * MiB;
constexpr int SP_AR = 0, SP_AI = 2048, SP_A16R = 4096, SP_A16I = 6144, SP_BBR = 8192, SP_BBI = 8192 + 32768;

struct Params {
    const float* in[27];
    float* out;
    unsigned char* ws;
    int ph_lo, ph_hi;
};

__device__ __forceinline__ float fsigmoid(float x) { return __builtin_amdgcn_rcpf(1.0f + __builtin_amdgcn_exp2f(-1.44269504089f * x)); }
__device__ __forceinline__ float fsilu(float x) { return x * fsigmoid(x); }
__device__ __forceinline__ float fgelu_tanh(float y) { return y * fsigmoid(1.59576912161f * y * (1.0f + 0.044715f * y * y)); }
__device__ __forceinline__ float bf_lo(unsigned u) { return __builtin_bit_cast(float, u << 16); }
__device__ __forceinline__ float bf_hi(unsigned u) { return __builtin_bit_cast(float, u & 0xffff0000u); }
__device__ __forceinline__ int mrow(int r) { return r < NP ? (r >> 11) : 8 + ((r - NP) >> 2); }
__device__ __forceinline__ bf16x8 pack8(f32x4 a, f32x4 b) {
    u32x4 w; w.x = cvt_pk_bf16(a[0], a[1]); w.y = cvt_pk_bf16(a[2], a[3]); w.z = cvt_pk_bf16(b[0], b[1]); w.w = cvt_pk_bf16(b[2], b[3]);
    return __builtin_bit_cast(bf16x8, w);
}
__device__ __forceinline__ float wave_sum(float v) {
#pragma unroll
    for (int o = 1; o < 64; o <<= 1) v += __shfl_xor(v, o);
    return v;
}
#ifdef NT_STORES
#define GST(ptr, v) __builtin_nontemporal_store((v), (ptr))
#else
#define GST(ptr, v) (*(ptr) = (v))
#endif
#define MFMA16(a, b, c) __builtin_amdgcn_mfma_f32_16x16x32_bf16((a), (b), (c), 0, 0, 0)

struct EpiG1 {
    static constexpr bool PERM = true, AFTER_DRAIN = false;
    bf16_t *US, *UP, *SGS, *SGP; float* ppool; float* spool;
    __device__ __forceinline__ void emit(int r, int c, int cls, f32x4 v0, f32x4 v1) const {
        if (cls < 2) {
            u32x4 w; w.x = cvt_pk_bf16(v0[0], v0[1]); w.y = cvt_pk_bf16(v0[2], v0[3]); w.z = cvt_pk_bf16(v1[0], v1[1]); w.w = cvt_pk_bf16(v1[2], v1[3]);
            GST((u32x4*)(US + (size_t)r * 512 + c), w);
        } else if (cls < 4) {
            const int cc = c - 512;
            u32x4 w; w.x = cvt_pk_bf16(v0[0], v0[1]); w.y = cvt_pk_bf16(v0[2], v0[3]); w.z = cvt_pk_bf16(v1[0], v1[1]); w.w = cvt_pk_bf16(v1[2], v1[3]);
            GST((u32x4*)(UP + (size_t)r * 512 + cc), w);
            if (r < NP) { const int t = r & 2047; if (t >= 2033) { float* o = ppool + ((size_t)(r >> 11) * 15 + (t - 2033)) * 512 + cc; *(f32x4*)o = v0; *(f32x4*)(o + 4) = v1; } }
            else { const int s = (r - NP) >> 2, i = (r - NP) & 3; float* o = spool + ((size_t)s * 15 + 11 + i) * 512 + cc; *(f32x4*)o = v0; *(f32x4*)(o + 4) = v1; }
        } else {
#pragma unroll
            for (int j = 0; j < 4; ++j) { v0[j] = fsigmoid(v0[j]); v1[j] = fsigmoid(v1[j]); }
            u32x4 w; w.x = cvt_pk_bf16(v0[0], v0[1]); w.y = cvt_pk_bf16(v0[2], v0[3]); w.z = cvt_pk_bf16(v1[0], v1[1]); w.w = cvt_pk_bf16(v1[2], v1[3]);
            if (cls < 8) GST((u32x4*)(SGS + (size_t)r * 1024 + (c - 1024)), w); else GST((u32x4*)(SGP + (size_t)r * 1024 + (c - 2048)), w);
        }
    }
    __device__ __forceinline__ void operator()(const f32x4 (&acc)[2][2][4][2], const Unit& u, int wr, int wc, int fr, int fq) const {
        const int row0 = u.pm * 256 + wr * 64 + fr, colt = u.pn * 256 + wc * 32 + 8 * fq;
#pragma unroll
        for (int ai = 0; ai < 2; ++ai)
#pragma unroll
            for (int m = 0; m < 4; ++m)
#pragma unroll
                for (int bj = 0; bj < 2; ++bj) emit(row0 + ai * 128 + m * 16, colt + bj * 128, u.pn, acc[ai][bj][m][0], acc[ai][bj][m][1]);
    }
};
struct EpiGLU {
    static constexpr bool PERM = true, AFTER_DRAIN = false;
    const bf16_t *SGS, *ZS; bf16_t* MGD;
    __device__ __forceinline__ void operator()(const f32x4 (&acc)[2][2][4][2], const Unit& u, int wr, int wc, int fr, int fq) const {
        const int row0 = u.pm * 256 + wr * 64 + fr, j0 = u.pn * 128 + wc * 32 + 8 * fq;
        u32x4 sgv[2][4], zsv[2][4];
#pragma unroll
        for (int ai = 0; ai < 2; ++ai)
#pragma unroll
            for (int m = 0; m < 4; ++m) { const size_t off = (size_t)(row0 + ai * 128 + m * 16) * 1024 + j0; sgv[ai][m] = *(const u32x4*)(SGS + off); zsv[ai][m] = *(const u32x4*)(ZS + off); }
#pragma unroll
        for (int ai = 0; ai < 2; ++ai)
#pragma unroll
            for (int m = 0; m < 4; ++m) {
                const size_t off = (size_t)(row0 + ai * 128 + m * 16) * 1024 + j0;
                const u32x4 sg = sgv[ai][m], zs = zsv[ai][m];
                const f32x4 a0 = acc[ai][0][m][0], a1 = acc[ai][0][m][1], b0 = acc[ai][1][m][0], b1 = acc[ai][1][m][1];
                float o[8];
                o[0] = bf_lo(sg.x) * a0[0] * fsigmoid(b0[0]) + bf_lo(zs.x); o[1] = bf_hi(sg.x) * a0[1] * fsigmoid(b0[1]) + bf_hi(zs.x);
                o[2] = bf_lo(sg.y) * a0[2] * fsigmoid(b0[2]) + bf_lo(zs.y); o[3] = bf_hi(sg.y) * a0[3] * fsigmoid(b0[3]) + bf_hi(zs.y);
                o[4] = bf_lo(sg.z) * a1[0] * fsigmoid(b1[0]) + bf_lo(zs.z); o[5] = bf_hi(sg.z) * a1[1] * fsigmoid(b1[1]) + bf_hi(zs.z);
                o[6] = bf_lo(sg.w) * a1[2] * fsigmoid(b1[2]) + bf_lo(zs.w); o[7] = bf_hi(sg.w) * a1[3] * fsigmoid(b1[3]) + bf_hi(zs.w);
                u32x4 w; w.x = cvt_pk_bf16(o[0], o[1]); w.y = cvt_pk_bf16(o[2], o[3]); w.z = cvt_pk_bf16(o[4], o[5]); w.w = cvt_pk_bf16(o[6], o[7]);
                GST((u32x4*)(MGD + off), w);
            }
    }
};
struct EpiSwiGLU {
    static constexpr bool PERM = true, AFTER_DRAIN = false;
    bf16_t* ACT;
    __device__ __forceinline__ void operator()(const f32x4 (&acc)[2][2][4][2], const Unit& u, int wr, int wc, int fr, int fq) const {
        const int row0 = u.pm * 256 + wr * 64 + fr, j0 = u.pn * 128 + wc * 32 + 8 * fq;
#pragma unroll
        for (int ai = 0; ai < 2; ++ai)
#pragma unroll
            for (int m = 0; m < 4; ++m) {
                const size_t off = (size_t)(row0 + ai * 128 + m * 16) * DFF + j0;
                const f32x4 a0 = acc[ai][0][m][0], a1 = acc[ai][0][m][1], b0 = acc[ai][1][m][0], b1 = acc[ai][1][m][1];
                u32x4 w;
                w.x = cvt_pk_bf16(fsilu(a0[0]) * b0[0], fsilu(a0[1]) * b0[1]); w.y = cvt_pk_bf16(fsilu(a0[2]) * b0[2], fsilu(a0[3]) * b0[3]);
                w.z = cvt_pk_bf16(fsilu(a1[0]) * b1[0], fsilu(a1[1]) * b1[1]); w.w = cvt_pk_bf16(fsilu(a1[2]) * b1[2], fsilu(a1[3]) * b1[3]);
                GST((u32x4*)(ACT + off), w);
            }
    }
};
template <int MODE> struct EpiRes {
    static constexpr bool PERM = false, AFTER_DRAIN = false;
    const float* baseF; const bf16_t* baseB; const float* gate; bf16_t* XO;
    __device__ __forceinline__ void operator()(const f32x4 (&acc)[2][2][4][2], const Unit& u, int wr, int wc, int fr, int fq) const {
        const int row0 = u.pm * 256 + wr * 64 + fr, col0 = u.pn * 256 + wc * 32 + 4 * fq;
        const float* gp = gate + (size_t)((u.pm * 256) >> 11) * 6144 + col0;
        f32x4 gt[2][2];
#pragma unroll
        for (int bj = 0; bj < 2; ++bj)
#pragma unroll
            for (int n = 0; n < 2; ++n) gt[bj][n] = *(const f32x4*)(gp + bj * 128 + n * 16);
        if (MODE == 0) {
#pragma unroll
            for (int ai = 0; ai < 2; ++ai) {
                f32x4 x[4][2][2];
#pragma unroll
                for (int m = 0; m < 4; ++m) { const float* bp = baseF + (size_t)(row0 + ai * 128 + m * 16) * DM + col0;
#pragma unroll
                    for (int bj = 0; bj < 2; ++bj)
#pragma unroll
                        for (int n = 0; n < 2; ++n) x[m][bj][n] = *(const f32x4*)(bp + bj * 128 + n * 16); }
#pragma unroll
                for (int m = 0; m < 4; ++m) { bf16_t* xp = XO + (size_t)(row0 + ai * 128 + m * 16) * DM + col0;
#pragma unroll
                    for (int bj = 0; bj < 2; ++bj)
#pragma unroll
                        for (int n = 0; n < 2; ++n) { const f32x4 v = x[m][bj][n] + gt[bj][n] * acc[ai][bj][m][n];
                            u32x2 w; w.x = cvt_pk_bf16(v[0], v[1]); w.y = cvt_pk_bf16(v[2], v[3]); GST((u32x2*)(xp + bj * 128 + n * 16), w); } }
            }
        } else {
            u32x2 x[2][4][2][2];
#pragma unroll
            for (int ai = 0; ai < 2; ++ai)
#pragma unroll
                for (int m = 0; m < 4; ++m) { const bf16_t* bp = baseB + (size_t)(row0 + ai * 128 + m * 16) * DM + col0;
#pragma unroll
                    for (int bj = 0; bj < 2; ++bj)
#pragma unroll
                        for (int n = 0; n < 2; ++n) x[ai][m][bj][n] = *(const u32x2*)(bp + bj * 128 + n * 16); }
#pragma unroll
            for (int ai = 0; ai < 2; ++ai)
#pragma unroll
                for (int m = 0; m < 4; ++m) { bf16_t* xp = XO + (size_t)(row0 + ai * 128 + m * 16) * DM + col0;
#pragma unroll
                    for (int bj = 0; bj < 2; ++bj)
#pragma unroll
                        for (int n = 0; n < 2; ++n) { const u32x2 q = x[ai][m][bj][n]; const f32x4 xv = (f32x4){bf_lo(q.x), bf_hi(q.x), bf_lo(q.y), bf_hi(q.y)};
                            const f32x4 v = xv + gt[bj][n] * acc[ai][bj][m][n];
                            u32x2 w; w.x = cvt_pk_bf16(v[0], v[1]); w.y = cvt_pk_bf16(v[2], v[3]); GST((u32x2*)(xp + bj * 128 + n * 16), w); } }
        }
    }
};

__device__ __forceinline__ void transpose_item(const float* W, int ldw, int k0, int n0, bf16_t* WT, int ldt, int drow0, float* scr, int lane) {
    float tv[32];
#pragma unroll
    for (int i = 0; i < 32; ++i) tv[i] = W[(size_t)(k0 + 2 * i + (lane >> 5)) * ldw + n0 + (lane & 31)];
#pragma unroll
    for (int i = 0; i < 32; ++i) scr[(2 * i + (lane >> 5)) * 33 + (lane & 31)] = tv[i];
    asm volatile("s_waitcnt lgkmcnt(0)" ::: "memory");
    const int c = lane & 7;
#pragma unroll
    for (int j = 0; j < 4; ++j) { const int n = (lane >> 3) + 8 * j; const float* s = scr + (8 * c) * 33 + n;
        u32x4 o; o.x = cvt_pk_bf16(s[0 * 33], s[1 * 33]); o.y = cvt_pk_bf16(s[2 * 33], s[3 * 33]); o.z = cvt_pk_bf16(s[4 * 33], s[5 * 33]); o.w = cvt_pk_bf16(s[6 * 33], s[7 * 33]);
        *(u32x4*)(WT + (size_t)(drow0 + n) * ldt + k0 + 8 * c) = o; }
    asm volatile("s_waitcnt lgkmcnt(0)" ::: "memory");
}
__device__ __forceinline__ int glu_row(int n, int half) { return n < half ? 256 * (n >> 7) + (n & 127) : 256 * ((n - half) >> 7) + 128 + ((n - half) & 127); }

constexpr int TR_ITEMS[6] = {16 * 96, 8 * 64, 16 * 32, 16 * 176, 44 * 32, 4 * 2 * 8};
__device__ __forceinline__ void tr_item(const Params& p, int which, int r, float* scr, int lane) {
    if (which == 0) { const int kb = r / 96, nb = r % 96; transpose_item(p.in[12], 3072, 64 * kb, 32 * nb, (bf16_t*)(p.ws + WS_WIN), 1024, 32 * nb, scr, lane); }
    else if (which == 1) { const int kb = r / 64, nb = r % 64; transpose_item(p.in[21], 2048, 64 * kb, 32 * nb, (bf16_t*)(p.ws + WS_WGLU), 512, glu_row(32 * nb, 1024), scr, lane); }
    else if (which == 2) { const int kb = r / 32, nb = r % 32; transpose_item(p.in[24], 1024, 64 * kb, 32 * nb, (bf16_t*)(p.ws + WS_WOUT), 1024, 32 * nb, scr, lane); }
    else if (which == 3) { const int kb = r / 176, nb = r % 176; transpose_item(p.in[25], 5632, 64 * kb, 32 * nb, (bf16_t*)(p.ws + WS_WFI), 1024, glu_row(32 * nb, DFF), scr, lane); }
    else if (which == 4) { const int kb = r / 32, nb = r % 32; transpose_item(p.in[26], 1024, 64 * kb, 32 * nb, (bf16_t*)(p.ws + WS_WFO), DFF, 32 * nb, scr, lane); }
    else { const int gk = r / 16, q = r % 16, kb = q / 8, nb = q % 8; transpose_item(p.in[22] + (size_t)gk * 128 * 256, 256, 64 * kb, 32 * nb, (bf16_t*)(p.ws + WS_WPOOL) + (size_t)gk * 256 * 128, 128, 32 * nb, scr, lane); }
}
__device__ __forceinline__ void ada_unit(const Params& p, int unit, unsigned char* lds, int tid) {
    const int lane = tid & 63, w = tid >> 6, lr = lane & 15, lq = lane >> 4, kq = w & 3, mh = w >> 2;
    const int n0 = unit * 32, mt0 = mh ? 5 : 0, mcnt = mh ? 4 : 5;
    const float* cp = p.in[2]; const float* cs = p.in[3]; const float* wa = p.in[10]; const float* ba = p.in[11];
    float* mod = (float*)(p.ws + WS_MOD);
    float* red = (float*)lds;
    f32x4 acc[5][2];
#pragma unroll
    for (int i = 0; i < 5; ++i) { acc[i][0] = (f32x4){0.f, 0.f, 0.f, 0.f}; acc[i][1] = (f32x4){0.f, 0.f, 0.f, 0.f}; }
#pragma unroll 2
    for (int ks = 0; ks < 8; ++ks) {
        const int k0 = kq * 256 + ks * 32 + 8 * lq;
        bf16x8 bfr[2];
#pragma unroll
        for (int nt = 0; nt < 2; ++nt) {
            const float* bp = wa + (size_t)k0 * 6144 + n0 + 16 * nt + lr;
            f32x4 x0, x1;
            x0[0] = bp[0]; x0[1] = bp[6144]; x0[2] = bp[2 * 6144]; x0[3] = bp[3 * 6144]; x1[0] = bp[4 * 6144]; x1[1] = bp[5 * 6144]; x1[2] = bp[6 * 6144]; x1[3] = bp[7 * 6144];
            bfr[nt] = pack8(x0, x1);
        }
#pragma unroll
        for (int mi = 0; mi < 5; ++mi) {
            if (mi < mcnt) {
                const int row = 16 * (mt0 + mi) + lr;
                f32x4 x0 = (f32x4){0.f, 0.f, 0.f, 0.f}, x1 = x0;
                if (row < NMODROW) { const float* ap = (row < 8 ? cp + (size_t)row * DM : cs + (size_t)(row - 8) * DM) + k0; x0 = *(const f32x4*)ap; x1 = *(const f32x4*)(ap + 4); }
#pragma unroll
                for (int j = 0; j < 4; ++j) { x0[j] = fsilu(x0[j]); x1[j] = fsilu(x1[j]); }
                const bf16x8 af = pack8(x0, x1);
                acc[mi][0] = MFMA16(bfr[0], af, acc[mi][0]); acc[mi][1] = MFMA16(bfr[1], af, acc[mi][1]);
            }
        }
    }
#pragma unroll
    for (int mi = 0; mi < 5; ++mi) if (mi < mcnt) {
        const int row = 16 * (mt0 + mi) + lr;
        *(f32x4*)(red + ((size_t)(kq * 144 + row)) * 32 + 4 * lq) = acc[mi][0];
        *(f32x4*)(red + ((size_t)(kq * 144 + row)) * 32 + 16 + 4 * lq) = acc[mi][1];
    }
    __syncthreads();
    for (int o = tid; o < NMODROW * 32; o += 512) {
        const int row = o >> 5, col = o & 31;
        const float v = ((red[(0 * 144 + row) * 32 + col] + red[(1 * 144 + row) * 32 + col]) + (red[(2 * 144 + row) * 32 + col] + red[(3 * 144 + row) * 32 + col])) + ba[n0 + col];
        mod[(size_t)row * 6144 + n0 + col] = v;
    }
    __syncthreads();
}

__device__ __forceinline__ void ssm_prep_unit(const Params& p, int g, int part, unsigned char* lds, int tid) {
    float* L = (float*)lds;
    float* pwr = L;            float* pwi = L + 17 * 64;
    float* bbr = L + 2176;     float* bbi = bbr + 1024;
    float* crT = bbi + 1024;   float* ciT = crT + 1024;
    float* ktab = ciT + 1024;
    float* spf = (float*)(p.ws + WS_SP);
    bf16_t* MG = (bf16_t*)(p.ws + WS_MG) + (size_t)g * 256 * 256;
    bf16_t* EG = (bf16_t*)(p.ws + WS_EG) + (size_t)g * 256 * 128;
    bf16_t* RG = (bf16_t*)(p.ws + WS_RG) + (size_t)g * 128 * 256;
    const float dt = expf(p.in[15][g]);
    for (int i = tid; i < 17 * 64; i += 512) {
        const int pp = i & 63, d = i >> 6, gp = g * 64 + pp;
        const float lr = p.in[13][gp], li = p.in[14][gp];
        const float mag = expf(lr * dt * (float)d), ang = li * dt * (float)d; float sn, cs; sincosf(ang, &sn, &cs); pwr[d * 64 + pp] = mag * cs; pwi[d * 64 + pp] = mag * sn;
    }
    for (int i = tid; i < 1024; i += 512) {
        const int pp = i >> 4, c = i & 15, gp = g * 64 + pp;
        const float lr = p.in[13][gp], li = p.in[14][gp];
        const float mag = expf(lr * dt), ang = li * dt; float sn, cs; sincosf(ang, &sn, &cs);
        const float abr = mag * cs, abi = mag * sn, den = lr * lr + li * li, nr = abr - 1.0f, ni = abi;
        const float fr = (nr * lr + ni * li) / den, fi = (ni * lr - nr * li) / den;
        const float br = p.in[16][(size_t)gp * 16 + c], bi = p.in[17][(size_t)gp * 16 + c];
        const float xr = fr * br - fi * bi, xi = fr * bi + fi * br; bbr[pp * 16 + c] = xr; bbi[pp * 16 + c] = xi;
        if (part == 2) { spf[SP_BBR + gp * 16 + c] = xr; spf[SP_BBI + gp * 16 + c] = xi; }
    }
    for (int i = tid; i < 1024; i += 512) { const int c = i >> 6, pp = i & 63; crT[pp * 16 + c] = p.in[18][(size_t)(g * 16 + c) * 64 + pp]; ciT[pp * 16 + c] = p.in[19][(size_t)(g * 16 + c) * 64 + pp]; }
    __syncthreads();
    if (part == 0) {
        {
            const int pair = tid & 255, d = pair >> 4, c2 = pair & 15, ch = tid >> 8;
            float a8[8];
#pragma unroll
            for (int i = 0; i < 8; ++i) a8[i] = 0.f;
#pragma unroll 8
            for (int pp = 0; pp < 64; ++pp) {
                const float ar = pwr[d * 64 + pp], ai = pwi[d * 64 + pp], br = bbr[pp * 16 + c2], bi = bbi[pp * 16 + c2];
                const float tr = ar * br - ai * bi, ti = ar * bi + ai * br;
                const f32x4 cr0 = *(const f32x4*)(crT + pp * 16 + 8 * ch), cr1 = *(const f32x4*)(crT + pp * 16 + 8 * ch + 4);
                const f32x4 ci0 = *(const f32x4*)(ciT + pp * 16 + 8 * ch), ci1 = *(const f32x4*)(ciT + pp * 16 + 8 * ch + 4);
#pragma unroll
                for (int i = 0; i < 4; ++i) { a8[i] += cr0[i] * tr - ci0[i] * ti; a8[4 + i] += cr1[i] * tr - ci1[i] * ti; }
            }
#pragma unroll
            for (int i = 0; i < 8; ++i) { const int c = 8 * ch + i; float v = a8[i]; if (d == 0 && c == c2) v += p.in[20][g * 16 + c]; ktab[d * 256 + c * 16 + c2] = v; }
        }
        __syncthreads();
        for (int idx = tid; idx < 8192; idx += 512) {
            const int n = idx >> 5, kk = (idx & 31) * 8, tau = n >> 4, c = n & 15, tp = kk >> 4, c0 = kk & 15;
            f32x4 x0 = (f32x4){0.f, 0.f, 0.f, 0.f}, x1 = x0;
            if (tau >= tp) { const float* s = ktab + (tau - tp) * 256 + c * 16 + c0; x0 = *(const f32x4*)s; x1 = *(const f32x4*)(s + 4); }
            *(bf16x8*)(MG + (size_t)n * 256 + kk) = pack8(x0, x1);
        }
    } else if (part == 1) {
        for (int idx = tid; idx < 4096; idx += 512) {
            const int n = idx >> 4, q0 = (idx & 15) * 8, tau = n >> 4, c = n & 15;
            float v[8];
#pragma unroll
            for (int j = 0; j < 8; ++j) { const int q = q0 + j, pp = q & 63; const float pr = pwr[(tau + 1) * 64 + pp], pi = pwi[(tau + 1) * 64 + pp], cr = crT[pp * 16 + c], ci = ciT[pp * 16 + c];
                v[j] = q < 64 ? (cr * pr - ci * pi) : -(cr * pi + ci * pr); }
            *(bf16x8*)(EG + (size_t)n * 128 + q0) = pack8((f32x4){v[0], v[1], v[2], v[3]}, (f32x4){v[4], v[5], v[6], v[7]});
        }
    } else {
        if (tid < 64) { const int gp = g * 64 + tid; spf[SP_AR + gp] = pwr[64 + tid]; spf[SP_AI + gp] = pwi[64 + tid]; spf[SP_A16R + gp] = pwr[16 * 64 + tid]; spf[SP_A16I + gp] = pwi[16 * 64 + tid]; }
        for (int idx = tid; idx < 4096; idx += 512) {
            const int q = idx >> 5, kk = (idx & 31) * 8, tp = kk >> 4, c0 = kk & 15, pp = q & 63;
            const float pr = pwr[(15 - tp) * 64 + pp], pi = pwi[(15 - tp) * 64 + pp];
            const f32x4 br0 = *(const f32x4*)(bbr + pp * 16 + c0), br1 = *(const f32x4*)(bbr + pp * 16 + c0 + 4), bi0 = *(const f32x4*)(bbi + pp * 16 + c0), bi1 = *(const f32x4*)(bbi + pp * 16 + c0 + 4);
            const f32x4 v0 = q < 64 ? (br0 * pr - bi0 * pi) : (bi0 * pr + br0 * pi), v1 = q < 64 ? (br1 * pr - bi1 * pi) : (bi1 * pr + br1 * pi);
            *(bf16x8*)(RG + (size_t)q * 256 + kk) = pack8(v0, v1);
        }
    }
    __syncthreads();
}

template <bool BF> __device__ __forceinline__ void modnorm_rows(const float* xa, const float* xb, const float* gvec, const float* mod, int jshift, int jscale, bf16_t* H, int rbeg, int rend, int wave, int lane) {
    for (int r0 = rbeg + wave; r0 < rend; r0 += 16) {
        const int rr[2] = {r0, (r0 + 8 < rend) ? r0 + 8 : r0};
        f32x4 v[2][4], sc[2][4], sh[2][4], gg[4];
#pragma unroll
        for (int h = 0; h < 2; ++h) {
            const int r = rr[h];
            const float* xr = (r < NP ? xa + (size_t)r * DM : xb + (size_t)(r - NP) * DM) + 4 * lane;
            const bf16_t* xbr = (const bf16_t*)xa + (size_t)r * DM + 4 * lane;
#pragma unroll
            for (int j = 0; j < 4; ++j) { if (BF) { const u32x2 q = *(const u32x2*)(xbr + 256 * j); v[h][j] = (f32x4){bf_lo(q.x), bf_hi(q.x), bf_lo(q.y), bf_hi(q.y)}; } else v[h][j] = *(const f32x4*)(xr + 256 * j); }
            const float* mr = mod + (size_t)mrow(r) * 6144 + 4 * lane;
#pragma unroll
            for (int j = 0; j < 4; ++j) { sc[h][j] = *(const f32x4*)(mr + jscale * DM + 256 * j); sh[h][j] = *(const f32x4*)(mr + jshift * DM + 256 * j); }
        }
#pragma unroll
        for (int j = 0; j < 4; ++j) gg[j] = *(const f32x4*)(gvec + 4 * lane + 256 * j);
        float s[2];
#pragma unroll
        for (int h = 0; h < 2; ++h) { s[h] = 0.f;
#pragma unroll
            for (int j = 0; j < 4; ++j) s[h] += (v[h][j][0] * v[h][j][0] + v[h][j][1] * v[h][j][1]) + (v[h][j][2] * v[h][j][2] + v[h][j][3] * v[h][j][3]); }
#pragma unroll
        for (int o = 1; o < 64; o <<= 1) { s[0] += __shfl_xor(s[0], o); s[1] += __shfl_xor(s[1], o); }
#pragma unroll
        for (int h = 0; h < 2; ++h) {
            const float inv = rsqrtf(s[h] * (1.0f / DM) + EPS);
            if (h == 0 || rr[1] != rr[0]) {
#pragma unroll
                for (int j = 0; j < 4; ++j) {
                    const f32x4 hv = (v[h][j] * inv) * gg[j] * (sc[h][j] + 1.0f) + sh[h][j];
                    u32x2 w; w.x = cvt_pk_bf16(hv[0], hv[1]); w.y = cvt_pk_bf16(hv[2], hv[3]);
                    *(u32x2*)(H + (size_t)rr[h] * DM + 4 * lane + 256 * j) = w;
                }
            }
        }
    }
}

constexpr int UP_PITCH = 264;
constexpr int RS_PITCH = 132;
__device__ __forceinline__ void ssm_block(const Params& p, int b, int g, unsigned char* lds, int tid) {
    const int lane = tid & 63, w = tid >> 6, lr = lane & 15, lq = lane >> 4;
    bf16_t* U = (bf16_t*)lds;
    float* RS = (float*)(lds + 128 * UP_PITCH * 2);
    const bf16_t* US = (const bf16_t*)(p.ws + WS_US);
    bf16_t* GY = (bf16_t*)(p.ws + WS_GY);
    const float* spf = (const float*)(p.ws + WS_SP);
    u32x4 uraw[8];
#pragma unroll
    for (int i = 0; i < 8; ++i) { const int q = tid + 512 * i, tok = q >> 1, half = q & 1; uraw[i] = *(const u32x4*)(US + ((size_t)(b * 2048 + tok) * 512 + g * 16 + half * 8)); }
    const bf16_t* Rb = (const bf16_t*)(p.ws + WS_RG) + ((size_t)g * 128 + 16 * w + lr) * 256 + 8 * lq;
    bf16x8 rf[8];
#pragma unroll
    for (int ks = 0; ks < 8; ++ks) rf[ks] = *(const bf16x8*)(Rb + 32 * ks);
    const bf16_t* Mb = (const bf16_t*)(p.ws + WS_MG) + ((size_t)g * 256 + 32 * w + lr) * 256 + 8 * lq;
    bf16x8 m0[8], m1[8];
#pragma unroll
    for (int ks = 0; ks < 8; ++ks) { m0[ks] = *(const bf16x8*)(Mb + 32 * ks); m1[ks] = *(const bf16x8*)(Mb + 16 * 256 + 32 * ks); }
#pragma unroll
    for (int i = 0; i < 8; ++i) { const int q = tid + 512 * i, tok = q >> 1, half = q & 1; *(u32x4*)(U + (tok >> 4) * UP_PITCH + (tok & 15) * 16 + half * 8) = uraw[i]; }
    __syncthreads();
    f32x4 acc[8][2];
    {
        f32x4 acc1[8];
#pragma unroll
        for (int i = 0; i < 8; ++i) acc1[i] = (f32x4){0.f, 0.f, 0.f, 0.f};
#pragma unroll
        for (int ks = 0; ks < 8; ++ks) {
#pragma unroll
            for (int mt = 0; mt < 8; ++mt) { const bf16x8 af = *(const bf16x8*)(U + (16 * mt + lr) * UP_PITCH + 32 * ks + 8 * lq); acc1[mt] = MFMA16(rf[ks], af, acc1[mt]); }
            __builtin_amdgcn_sched_barrier(0);
        }
#pragma unroll
        for (int mt = 0; mt < 8; ++mt) *(f32x4*)(RS + (16 * mt + lr) * RS_PITCH + 16 * w + 4 * lq) = acc1[mt];
    }
    {
#pragma unroll
        for (int i = 0; i < 8; ++i) { acc[i][0] = (f32x4){0.f, 0.f, 0.f, 0.f}; acc[i][1] = (f32x4){0.f, 0.f, 0.f, 0.f}; }
#pragma unroll
        for (int ks = 0; ks < 8; ++ks) if (ks <= w) {
#pragma unroll
            for (int mt = 0; mt < 8; ++mt) { const bf16x8 af = *(const bf16x8*)(U + (16 * mt + lr) * UP_PITCH + 32 * ks + 8 * lq);
                acc[mt][0] = MFMA16(m0[ks], af, acc[mt][0]); acc[mt][1] = MFMA16(m1[ks], af, acc[mt][1]); }
            __builtin_amdgcn_sched_barrier(0);
        }
    }
    const bf16_t* Eb = (const bf16_t*)(p.ws + WS_EG) + ((size_t)g * 256 + 32 * w + lr) * 128 + 8 * lq;
    bf16x8 e0[4], e1[4];
#pragma unroll
    for (int ks = 0; ks < 4; ++ks) { e0[ks] = *(const bf16x8*)(Eb + 32 * ks); e1[ks] = *(const bf16x8*)(Eb + 16 * 128 + 32 * ks); }
    __syncthreads();
    {
        float* TT = RS + 128 * RS_PITCH;
        const int gp = g * 64 + lane; const float ar = spf[SP_A16R + gp], ai = spf[SP_A16I + gp];
        float sr = 0.f, si = 0.f;
#pragma unroll
        for (int jj = 0; jj < 16; ++jj) {
            const int j = 16 * w + jj;
            const float rr = RS[j * RS_PITCH + lane], ri = RS[j * RS_PITCH + 64 + lane];
            RS[j * RS_PITCH + lane] = sr; RS[j * RS_PITCH + 64 + lane] = si;
            const float nr = ar * sr - ai * si + rr, ni = ar * si + ai * sr + ri; sr = nr; si = ni;
        }
        TT[w * 128 + lane] = sr; TT[w * 128 + 64 + lane] = si;
        float br = ar, bi = ai;
#pragma unroll
        for (int i = 0; i < 4; ++i) { const float xr = br * br - bi * bi, xi = 2.0f * br * bi; br = xr; bi = xi; }
        __syncthreads();
        float cr = 0.f, ci = 0.f;
        for (int v = 0; v < w; ++v) { const float tr = TT[v * 128 + lane], ti = TT[v * 128 + 64 + lane]; const float nr = br * cr - bi * ci + tr, ni = br * ci + bi * cr + ti; cr = nr; ci = ni; }
        float pr = 1.f, pi = 0.f;
#pragma unroll
        for (int jj = 0; jj < 16; ++jj) {
            const int j = 16 * w + jj;
            RS[j * RS_PITCH + lane] += pr * cr - pi * ci; RS[j * RS_PITCH + 64 + lane] += pr * ci + pi * cr;
            const float nr = pr * ar - pi * ai, ni = pr * ai + pi * ar; pr = nr; pi = ni;
        }
        if (w == 7) {
            float* ore = p.out + (size_t)NTOK * DM; float* oim = ore + 16384;
            ore[(size_t)(b * 32 + g) * 64 + lane] = br * cr - bi * ci + sr; oim[(size_t)(b * 32 + g) * 64 + lane] = br * ci + bi * cr + si;
        }
    }
    __syncthreads();
    {
#pragma unroll
        for (int ks = 0; ks < 4; ++ks) {
#pragma unroll
            for (int mt = 0; mt < 8; ++mt) { const float* f = RS + (16 * mt + lr) * RS_PITCH + 32 * ks + 8 * lq;
                const bf16x8 af = pack8(*(const f32x4*)f, *(const f32x4*)(f + 4));
                acc[mt][0] = MFMA16(e0[ks], af, acc[mt][0]); acc[mt][1] = MFMA16(e1[ks], af, acc[mt][1]); }
            __builtin_amdgcn_sched_barrier(0);
        }
#pragma unroll
        for (int mt = 0; mt < 8; ++mt)
#pragma unroll
            for (int nt = 0; nt < 2; ++nt) {
                const int j = 16 * mt + lr, tau = 2 * w + nt; const size_t row = (size_t)b * 2048 + 16 * j + tau;
                const f32x4 y = acc[mt][nt];
                u32x2 o; o.x = cvt_pk_bf16(fgelu_tanh(y[0]), fgelu_tanh(y[1])); o.y = cvt_pk_bf16(fgelu_tanh(y[2]), fgelu_tanh(y[3]));
                *(u32x2*)(GY + row * 512 + g * 16 + 4 * lq) = o;
            }
    }
    __syncthreads();
}

__device__ __forceinline__ void ssm_sample_item(const Params& p, int s, int g, int lane) {
    const bf16_t* US = (const bf16_t*)(p.ws + WS_US);
    bf16_t* GY = (bf16_t*)(p.ws + WS_GY);
    const float* spf = (const float*)(p.ws + WS_SP);
    const int gp = g * 64 + lane;
    const float ar = spf[SP_AR + gp], ai = spf[SP_AI + gp];
    float bbr[16], bbi[16];
#pragma unroll
    for (int i = 0; i < 4; ++i) { const f32x4 x = *(const f32x4*)(spf + SP_BBR + (size_t)gp * 16 + 4 * i), y = *(const f32x4*)(spf + SP_BBI + (size_t)gp * 16 + 4 * i);
#pragma unroll
        for (int j = 0; j < 4; ++j) { bbr[4 * i + j] = x[j]; bbi[4 * i + j] = y[j]; } }
    float hr = p.in[4][(size_t)(s * 32 + g) * 64 + lane], hi = p.in[5][(size_t)(s * 32 + g) * 64 + lane];
    float sr[4], si[4];
#pragma unroll
    for (int t = 0; t < 4; ++t) {
        const bf16_t* up = US + (size_t)(NP + 4 * s + t) * 512 + g * 16;
        const u32x4 u0 = *(const u32x4*)up, u1 = *(const u32x4*)(up + 8);
        float uu[16];
        uu[0] = bf_lo(u0.x); uu[1] = bf_hi(u0.x); uu[2] = bf_lo(u0.y); uu[3] = bf_hi(u0.y); uu[4] = bf_lo(u0.z); uu[5] = bf_hi(u0.z); uu[6] = bf_lo(u0.w); uu[7] = bf_hi(u0.w);
        uu[8] = bf_lo(u1.x); uu[9] = bf_hi(u1.x); uu[10] = bf_lo(u1.y); uu[11] = bf_hi(u1.y); uu[12] = bf_lo(u1.z); uu[13] = bf_hi(u1.z); uu[14] = bf_lo(u1.w); uu[15] = bf_hi(u1.w);
        float br = 0.f, bi = 0.f;
#pragma unroll
        for (int c = 0; c < 16; ++c) { br += bbr[c] * uu[c]; bi += bbi[c] * uu[c]; }
        const float nr = ar * hr - ai * hi + br, ni = ar * hi + ai * hr + bi; hr = nr; hi = ni; sr[t] = hr; si[t] = hi;
    }
    float* ore = p.out + (size_t)NTOK * DM + 16384 + 16384 + 61440; float* oim = ore + 262144;
    ore[(size_t)(s * 32 + g) * 64 + lane] = hr; oim[(size_t)(s * 32 + g) * 64 + lane] = hi;
    float v[64];
#pragma unroll
    for (int c = 0; c < 16; ++c) { const float cr = p.in[18][(size_t)(g * 16 + c) * 64 + lane], ci = p.in[19][(size_t)(g * 16 + c) * 64 + lane];
#pragma unroll
        for (int t = 0; t < 4; ++t) v[t * 16 + c] = sr[t] * cr - si[t] * ci; }
#define TR_STEP(OFF) { const bool up = (lane & OFF) != 0; _Pragma("unroll") for (int i = 0; i < OFF; ++i) { const float snd = up ? v[i] : v[i + OFF], kp = up ? v[i + OFF] : v[i]; v[i] = kp + __shfl_xor(snd, OFF); } }
    TR_STEP(32) TR_STEP(16) TR_STEP(8) TR_STEP(4) TR_STEP(2) TR_STEP(1)
#undef TR_STEP
    const int t = lane >> 4, c = lane & 15; const size_t row = (size_t)NP + 4 * s + t;
    const float uval = __builtin_bit_cast(float, ((unsigned)US[row * 512 + g * 16 + c]) << 16);
    const float y = v[0] + p.in[20][g * 16 + c] * uval;
    GY[row * 512 + g * 16 + c] = (bf16_t)(cvt_pk_bf16(fgelu_tanh(y), 0.f) & 0xffffu);
}

constexpr int PA_PITCH = 136;
template <int KG> __device__ __forceinline__ void pool_fill(const Params& p, int r0, bf16_t* A, int tid, int nseg) {
    if ((tid >> 6) >= nseg) return;
    constexpr int WIN = 2 << KG;
    const bf16_t* UPb = (const bf16_t*)(p.ws + WS_UP);
    const int cp = tid & 63, seg = tid >> 6, ch = 128 * KG + 2 * cp, base = r0 + 16 * seg;
    constexpr float rw = 1.0f / (float)WIN;
    if (r0 < NP) {
        const int t0 = base & 2047;
        unsigned raw[WIN - 1 + 16];
#pragma unroll
        for (int e = 0; e < WIN - 1 + 16; ++e) { const int rel = e - (WIN - 1); raw[e] = (t0 + rel >= 0) ? *(const unsigned*)(UPb + (size_t)(base + rel) * 512 + ch) : 0u; }
        float s0 = 0.f, s1 = 0.f;
#pragma unroll
        for (int e = 0; e < WIN - 1; ++e) { s0 += bf_lo(raw[e]); s1 += bf_hi(raw[e]); }
#pragma unroll
        for (int i = 0; i < 16; ++i) {
            const int t = t0 + i; const float c0 = bf_lo(raw[WIN - 1 + i]), c1 = bf_hi(raw[WIN - 1 + i]);
            s0 += c0; s1 += c1;
            const float rc = (t + 1 < WIN) ? 1.0f / (float)(t + 1) : rw;
            *(unsigned*)(A + (16 * seg + i) * PA_PITCH + 2 * cp) = cvt_pk_bf16(s0 * rc - c0, s1 * rc - c1);
            s0 -= bf_lo(raw[i]); s1 -= bf_hi(raw[i]);
        }
    } else {
        const float* sp = p.in[6];
#pragma unroll
        for (int q = 0; q < 4; ++q) {
            const int r = base + 4 * q, sidx = (r - NP) >> 2;
            float e0[WIN - 1 + 4], e1[WIN - 1 + 4];
#pragma unroll
            for (int e = 0; e < WIN - 1; ++e) { const f32x2 v = *(const f32x2*)(sp + ((size_t)sidx * 15 + (15 - (WIN - 1)) + e) * 512 + ch); e0[e] = v[0]; e1[e] = v[1]; }
#pragma unroll
            for (int i = 0; i < 4; ++i) { const unsigned v = *(const unsigned*)(UPb + (size_t)(r + i) * 512 + ch); e0[WIN - 1 + i] = bf_lo(v); e1[WIN - 1 + i] = bf_hi(v); }
            float s0 = 0.f, s1 = 0.f;
#pragma unroll
            for (int e = 0; e < WIN - 1; ++e) { s0 += e0[e]; s1 += e1[e]; }
#pragma unroll
            for (int i = 0; i < 4; ++i) {
                const float c0 = e0[WIN - 1 + i], c1 = e1[WIN - 1 + i];
                s0 += c0; s1 += c1;
                *(unsigned*)(A + (16 * seg + 4 * q + i) * PA_PITCH + 2 * cp) = cvt_pk_bf16(s0 * rw - c0, s1 * rw - c1);
                s0 -= e0[i]; s1 -= e1[i];
            }
        }
    }
}
template <int KG> __device__ __forceinline__ void pool_fill2(const Params& p, int r0a, int r0b, bf16_t* A, int tid) {
    constexpr int WIN = 2 << KG, NR = WIN - 1 + 16;
    const bf16_t* UPb = (const bf16_t*)(p.ws + WS_UP);
    const int cp = tid & 63, seg = tid >> 6, ch = 128 * KG + 2 * cp;
    constexpr float rw = 1.0f / (float)WIN;
    unsigned raw[2][NR];
#pragma unroll
    for (int h = 0; h < 2; ++h) { const int base = (h ? r0b : r0a) + 16 * seg, t0 = base & 2047;
#pragma unroll
        for (int e = 0; e < NR; ++e) { const int rel = e - (WIN - 1); raw[h][e] = (t0 + rel >= 0) ? *(const unsigned*)(UPb + (size_t)(base + rel) * 512 + ch) : 0u; } }
#pragma unroll
    for (int h = 0; h < 2; ++h) { const int base = (h ? r0b : r0a) + 16 * seg, t0 = base & 2047;
        float s0 = 0.f, s1 = 0.f;
#pragma unroll
        for (int e = 0; e < WIN - 1; ++e) { s0 += bf_lo(raw[h][e]); s1 += bf_hi(raw[h][e]); }
#pragma unroll
        for (int i = 0; i < 16; ++i) {
            const int t = t0 + i; const float c0 = bf_lo(raw[h][WIN - 1 + i]), c1 = bf_hi(raw[h][WIN - 1 + i]);
            s0 += c0; s1 += c1;
            const float rc = (t + 1 < WIN) ? 1.0f / (float)(t + 1) : rw;
            *(unsigned*)(A + (h * 128 + 16 * seg + i) * PA_PITCH + 2 * cp) = cvt_pk_bf16(s0 * rc - c0, s1 * rc - c1);
            s0 -= bf_lo(raw[h][i]); s1 -= bf_hi(raw[h][i]);
        }
    }
}
__device__ __forceinline__ void pool_pair(const Params& p, int rt, int k, unsigned char* lds, int tid) {
    const int lane = tid & 63, w8 = tid >> 6, lr = lane & 15, lq = lane >> 4;
    bf16_t* A = (bf16_t*)lds;
    const bf16_t* Wb = (const bf16_t*)(p.ws + WS_WPOOL) + ((size_t)k * 256 + 32 * w8 + lr) * 128 + 8 * lq;
    bf16x8 b0[4], b1[4];
#pragma unroll
    for (int ks = 0; ks < 4; ++ks) { b0[ks] = *(const bf16x8*)(Wb + 32 * ks); b1[ks] = *(const bf16x8*)(Wb + 16 * 128 + 32 * ks); }
    const int colb = k * 256 + 32 * w8 + 4 * lq;
    const f32x4 ps0 = *(const f32x4*)(p.in[23] + colb), ps1 = *(const f32x4*)(p.in[23] + colb + 16);
    const int r0a = rt * 128, r0b = (rt + 64) * 128;
    if (k == 0) pool_fill2<0>(p, r0a, r0b, A, tid); else if (k == 1) pool_fill2<1>(p, r0a, r0b, A, tid); else if (k == 2) pool_fill2<2>(p, r0a, r0b, A, tid); else pool_fill2<3>(p, r0a, r0b, A, tid);
    const bf16_t* SGP = (const bf16_t*)(p.ws + WS_SGP); bf16_t* ZS = (bf16_t*)(p.ws + WS_ZS);
    __syncthreads();
#pragma unroll 1
    for (int h = 0; h < 2; ++h) {
        const int r0 = h ? r0b : r0a;
        u32x2 sg[8][2];
#pragma unroll
        for (int mt = 0; mt < 8; ++mt) { const size_t off = (size_t)(r0 + 16 * mt + lr) * 1024 + colb; sg[mt][0] = *(const u32x2*)(SGP + off); sg[mt][1] = *(const u32x2*)(SGP + off + 16); }
        f32x4 acc[8][2];
#pragma unroll
        for (int i = 0; i < 8; ++i) { acc[i][0] = (f32x4){0.f, 0.f, 0.f, 0.f}; acc[i][1] = (f32x4){0.f, 0.f, 0.f, 0.f}; }
#pragma unroll
        for (int ks = 0; ks < 4; ++ks) {
#pragma unroll
            for (int mt = 0; mt < 8; ++mt) { const bf16x8 af = *(const bf16x8*)(A + (h * 128 + 16 * mt + lr) * PA_PITCH + 32 * ks + 8 * lq);
                acc[mt][0] = MFMA16(b0[ks], af, acc[mt][0]); acc[mt][1] = MFMA16(b1[ks], af, acc[mt][1]); }
            __builtin_amdgcn_sched_barrier(0);
        }
#pragma unroll
        for (int mt = 0; mt < 8; ++mt) {
            const size_t off = (size_t)(r0 + 16 * mt + lr) * 1024 + colb;
            const f32x4 z0 = acc[mt][0], z1 = acc[mt][1];
            u32x2 o; o.x = cvt_pk_bf16(z0[0] * ps0[0] * bf_lo(sg[mt][0].x), z0[1] * ps0[1] * bf_hi(sg[mt][0].x)); o.y = cvt_pk_bf16(z0[2] * ps0[2] * bf_lo(sg[mt][0].y), z0[3] * ps0[3] * bf_hi(sg[mt][0].y));
            *(u32x2*)(ZS + off) = o;
            o.x = cvt_pk_bf16(z1[0] * ps1[0] * bf_lo(sg[mt][1].x), z1[1] * ps1[1] * bf_hi(sg[mt][1].x)); o.y = cvt_pk_bf16(z1[2] * ps1[2] * bf_lo(sg[mt][1].y), z1[3] * ps1[3] * bf_hi(sg[mt][1].y));
            *(u32x2*)(ZS + off + 16) = o;
        }
    }
    __syncthreads();
}
template <int MT> __device__ __forceinline__ void pool_unit(const Params& p, int r0, int k, unsigned char* lds, int tid) {
    const int lane = tid & 63, w8 = tid >> 6, lr = lane & 15, lq = lane >> 4;
    bf16_t* A = (bf16_t*)lds;
    const bf16_t* Wb = (const bf16_t*)(p.ws + WS_WPOOL) + ((size_t)k * 256 + 32 * w8 + lr) * 128 + 8 * lq;
    bf16x8 b0[4], b1[4];
#pragma unroll
    for (int ks = 0; ks < 4; ++ks) { b0[ks] = *(const bf16x8*)(Wb + 32 * ks); b1[ks] = *(const bf16x8*)(Wb + 16 * 128 + 32 * ks); }
    if (k == 0) pool_fill<0>(p, r0, A, tid, MT); else if (k == 1) pool_fill<1>(p, r0, A, tid, MT); else if (k == 2) pool_fill<2>(p, r0, A, tid, MT); else pool_fill<3>(p, r0, A, tid, MT);
    __syncthreads();
    f32x4 acc[MT][2];
#pragma unroll
    for (int i = 0; i < MT; ++i) { acc[i][0] = (f32x4){0.f, 0.f, 0.f, 0.f}; acc[i][1] = (f32x4){0.f, 0.f, 0.f, 0.f}; }
#pragma unroll
    for (int ks = 0; ks < 4; ++ks) {
#pragma unroll
        for (int mt = 0; mt < MT; ++mt) { const bf16x8 af = *(const bf16x8*)(A + (16 * mt + lr) * PA_PITCH + 32 * ks + 8 * lq);
            acc[mt][0] = MFMA16(b0[ks], af, acc[mt][0]); acc[mt][1] = MFMA16(b1[ks], af, acc[mt][1]); }
    }
    const bf16_t* SGP = (const bf16_t*)(p.ws + WS_SGP); bf16_t* ZS = (bf16_t*)(p.ws + WS_ZS);
#pragma unroll
    for (int nt = 0; nt < 2; ++nt) {
        const int col = k * 256 + 32 * w8 + 16 * nt + 4 * lq;
        const f32x4 ps = *(const f32x4*)(p.in[23] + col);
#pragma unroll
        for (int mt = 0; mt < MT; ++mt) {
            const size_t off = (size_t)(r0 + 16 * mt + lr) * 1024 + col;
            const u32x2 sg = *(const u32x2*)(SGP + off); const f32x4 z = acc[mt][nt];
            u32x2 o; o.x = cvt_pk_bf16(z[0] * ps[0] * bf_lo(sg.x), z[1] * ps[1] * bf_hi(sg.x)); o.y = cvt_pk_bf16(z[2] * ps[2] * bf_lo(sg.y), z[3] * ps[3] * bf_hi(sg.y));
            *(u32x2*)(ZS + off) = o;
        }
    }
    __syncthreads();
}

template <int NT> __device__ __forceinline__ void skinny_unit(const bf16_t* A, int lda, const bf16_t* Bt, int ldb, int K, int arow0, const int (&brow)[NT], unsigned char* lds, int tid) {
    const int lane = tid & 63, w = tid >> 6, lr = lane & 15, lq = lane >> 4, kper = K >> 3, k0 = w * kper;
    constexpr int TW = 16 * NT;
    float* red = (float*)lds;
    f32x4 acc[4][NT];
#pragma unroll
    for (int i = 0; i < 4; ++i)
#pragma unroll
        for (int n = 0; n < NT; ++n) acc[i][n] = (f32x4){0.f, 0.f, 0.f, 0.f};
    const bf16_t* Ap = A + (size_t)(arow0 + lr) * lda + k0 + 8 * lq;
    const bf16_t* Bp[NT];
#pragma unroll
    for (int n = 0; n < NT; ++n) Bp[n] = Bt + (size_t)(brow[n] + lr) * ldb + k0 + 8 * lq;
    const int nks = kper >> 5;
    int ks = 0;
    for (; ks + 2 <= nks; ks += 2) {
        bf16x8 bf[2][NT], af[2][4];
#pragma unroll
        for (int u = 0; u < 2; ++u) {
#pragma unroll
            for (int n = 0; n < NT; ++n) bf[u][n] = *(const bf16x8*)(Bp[n] + 32 * (ks + u));
#pragma unroll
            for (int mt = 0; mt < 4; ++mt) af[u][mt] = *(const bf16x8*)(Ap + (size_t)(16 * mt) * lda + 32 * (ks + u)); }
#pragma unroll
        for (int u = 0; u < 2; ++u)
#pragma unroll
            for (int mt = 0; mt < 4; ++mt)
#pragma unroll
                for (int n = 0; n < NT; ++n) acc[mt][n] = MFMA16(bf[u][n], af[u][mt], acc[mt][n]);
    }
    for (; ks < nks; ++ks) {
        bf16x8 bf[NT];
#pragma unroll
        for (int n = 0; n < NT; ++n) bf[n] = *(const bf16x8*)(Bp[n] + 32 * ks);
#pragma unroll
        for (int mt = 0; mt < 4; ++mt) { const bf16x8 af = *(const bf16x8*)(Ap + (size_t)(16 * mt) * lda + 32 * ks);
#pragma unroll
            for (int n = 0; n < NT; ++n) acc[mt][n] = MFMA16(bf[n], af, acc[mt][n]); }
    }
#pragma unroll
    for (int mt = 0; mt < 4; ++mt)
#pragma unroll
        for (int n = 0; n < NT; ++n) *(f32x4*)(red + ((size_t)(w * 64 + 16 * mt + lr)) * TW + 16 * n + 4 * lq) = acc[mt][n];
    __syncthreads();
#pragma unroll
    for (int q = 0; q < NT / 2; ++q) {
        const int o = (q * 512 + tid) * 4;
        f32x4 s = *(const f32x4*)(red + o);
#pragma unroll
        for (int v = 1; v < 8; ++v) s += *(const f32x4*)(red + v * 64 * TW + o);
        *(f32x4*)(red + o) = s;
    }
    __syncthreads();
}
__device__ __forceinline__ void skinny_wide96(const bf16_t* A, const bf16_t* Bt, int arow0, int bcol0, unsigned char* lds, int tid) {
    const int lane = tid & 63, w = tid >> 6, lr = lane & 15, lq = lane >> 4, kq = w & 3, mh = w >> 2, k0 = kq * 256;
    float* red = (float*)lds;
    f32x4 acc[2][6];
#pragma unroll
    for (int i = 0; i < 2; ++i)
#pragma unroll
        for (int n = 0; n < 6; ++n) acc[i][n] = (f32x4){0.f, 0.f, 0.f, 0.f};
    const bf16_t* Ap = A + (size_t)(arow0 + 32 * mh + lr) * 1024 + k0 + 8 * lq;
    const bf16_t* Bp = Bt + (size_t)(bcol0 + lr) * 1024 + k0 + 8 * lq;
#pragma unroll 1
    for (int ks = 0; ks < 8; ks += 2) {
        bf16x8 bf[2][6], af[2][2];
#pragma unroll
        for (int u = 0; u < 2; ++u) {
#pragma unroll
            for (int n = 0; n < 6; ++n) bf[u][n] = *(const bf16x8*)(Bp + (size_t)(16 * n) * 1024 + 32 * (ks + u));
#pragma unroll
            for (int mt = 0; mt < 2; ++mt) af[u][mt] = *(const bf16x8*)(Ap + (size_t)(16 * mt) * 1024 + 32 * (ks + u)); }
#pragma unroll
        for (int u = 0; u < 2; ++u)
#pragma unroll
            for (int mt = 0; mt < 2; ++mt)
#pragma unroll
                for (int n = 0; n < 6; ++n) acc[mt][n] = MFMA16(bf[u][n], af[u][mt], acc[mt][n]);
    }
#pragma unroll
    for (int mt = 0; mt < 2; ++mt)
#pragma unroll
        for (int n = 0; n < 6; ++n) *(f32x4*)(red + ((size_t)(kq * 64 + 32 * mh + 16 * mt + lr)) * 96 + 16 * n + 4 * lq) = acc[mt][n];
    __syncthreads();
#pragma unroll
    for (int q = 0; q < 3; ++q) {
        const int o = (q * 512 + tid) * 4;
        const f32x4 s = (*(const f32x4*)(red + o) + *(const f32x4*)(red + 6144 + o)) + (*(const f32x4*)(red + 2 * 6144 + o) + *(const f32x4*)(red + 3 * 6144 + o));
        *(f32x4*)(red + o) = s;
    }
    __syncthreads();
}
#define LAS __attribute__((address_space(3)))
#define XB_TMO      128
#define XB_XCNT(j)  (256  + 64 * (j))
#define XB_XSUB(j)  (1280 + 64 * (j))
#define XB_XGEN(j)  (2304 + 64 * (j))
#define XB_TOP      3328
#define XB_TOPGEN   3392
#define XCD_BAR_WORDS 3456
#define XB_SPIN_CAP (1u << 18)

__device__ __forceinline__ unsigned xb_ld(unsigned* p)              { return __hip_atomic_load(p, __ATOMIC_RELAXED, __HIP_MEMORY_SCOPE_AGENT); }
__device__ __forceinline__ unsigned xb_add(unsigned* p, unsigned v) { return __hip_atomic_fetch_add(p, v, __ATOMIC_RELAXED, __HIP_MEMORY_SCOPE_AGENT); }
__device__ __forceinline__ unsigned xb_xcc_id() { return (unsigned)__builtin_amdgcn_s_getreg((3 << 11) | 20) & 0xFu; }
#define XB_SPIN(cond, bar) do { unsigned _sp = 0; while (cond) { __builtin_amdgcn_s_sleep(1); \
    if ((++_sp & 255u) == 0u) { if (xb_ld(&(bar)[XB_TMO])) break; if (_sp > XB_SPIN_CAP) { atomicAdd(&(bar)[XB_TMO], 1u); break; } } } } while (0)

struct XcdBarrier {
    unsigned* bar; unsigned x;
    volatile LAS unsigned* st;
};

__device__ __forceinline__ XcdBarrier xcd_barrier_post(unsigned* bar, volatile LAS unsigned* st) {
    XcdBarrier b; b.bar = bar; b.x = xb_xcc_id(); b.st = st;
    if (threadIdx.x == 0) (void)xb_add(&bar[XB_XCNT(b.x)], 1u);
    return b;
}
__device__ __forceinline__ void xcd_barrier_complete(unsigned* bar, unsigned x, unsigned& nloc, unsigned& nx) {
    const unsigned G = gridDim.x * gridDim.y * gridDim.z;
    unsigned sum, cnt, mine, sp = 0u;
    for (;;) {
        sum = 0u; cnt = 0u; mine = 0u;
#pragma unroll
        for (unsigned j = 0; j < 16; ++j) { const unsigned c = xb_ld(&bar[XB_XCNT(j)]); sum += c; cnt += (c > 0u) ? 1u : 0u; mine = (j == x) ? c : mine; }
        if (sum == G) break;
        __builtin_amdgcn_s_sleep(1);
        if ((++sp & 255u) == 0u) { if (xb_ld(&bar[XB_TMO])) break; if (sp > XB_SPIN_CAP) { atomicAdd(&bar[XB_TMO], 1u); break; } }
    }
    nloc = mine > 0u ? mine : 1u; nx = cnt > 0u ? cnt : 1u;
}

__device__ __forceinline__ void xcd_barrier(const XcdBarrier& b) {
    asm volatile("s_waitcnt vmcnt(0)" ::: "memory");
    __syncthreads();
    if (threadIdx.x == 0) {
        unsigned* bar = b.bar;
        __builtin_amdgcn_s_waitcnt(0);
        unsigned nloc = b.st[0], nx = b.st[1];
        if (nloc == 0u) { xcd_barrier_complete(bar, b.x, nloc, nx); b.st[0] = nloc; b.st[1] = nx; }
        const unsigned old = xb_add(&bar[XB_XSUB(b.x)], 1u);
        const unsigned gen = old / nloc;
        if (old + 1u == (gen + 1u) * nloc) {
            __builtin_amdgcn_fence(__ATOMIC_RELEASE, "agent");
            asm volatile("s_waitcnt vmcnt(0)" ::: "memory");
            const unsigned og = xb_add(&bar[XB_TOP], 1u);
            const unsigned tg = og / nx;
            if (og + 1u == (tg + 1u) * nx) xb_add(&bar[XB_TOPGEN], 1u);
            else XB_SPIN(xb_ld(&bar[XB_TOPGEN]) == tg, bar);
            __builtin_amdgcn_fence(__ATOMIC_ACQUIRE, "agent");
            xb_add(&bar[XB_XGEN(b.x)], 1u);
            asm volatile("s_waitcnt vmcnt(0)" ::: "memory");
        } else {
            XB_SPIN(xb_ld(&bar[XB_XGEN(b.x)]) == gen, bar);
            __builtin_amdgcn_fence(__ATOMIC_ACQUIRE, "agent");
            asm volatile("s_waitcnt vmcnt(0)" ::: "memory");
        }
    }
    __syncthreads();
}

constexpr int MISC_OFF = LDS_BYTES - 64;
constexpr size_t WS_BAR = 0;
#ifndef PG_ALIGN
#define PG_ALIGN true
#endif
#ifndef PG_SP2
#define PG_SP2 true
#endif
#ifndef REP3A
#define REP3A 1
#endif
#ifndef REP3B
#define REP3B 1
#endif
#ifndef REP3C
#define REP3C 1
#endif
#ifndef REP0
#define REP0 1
#endif
#ifndef REP1
#define REP1 1
#endif
#ifndef REP2
#define REP2 1
#endif
#ifndef REP3
#define REP3 1
#endif
#ifndef REP4
#define REP4 1
#endif
#ifndef REP5
#define REP5 1
#endif
#ifndef REP6
#define REP6 1
#endif
#ifndef REP7
#define REP7 1
#endif
#ifndef REP8
#define REP8 1
#endif
#ifndef REP9
#define REP9 1
#endif
__global__ void __launch_bounds__(512, 2) mk_fwd(Params p) {
    extern __shared__ __attribute__((aligned(16))) unsigned char lds[];
    cg::grid_group grid = cg::this_grid();
    const int tid = threadIdx.x, lane = tid & 63, wave = __builtin_amdgcn_readfirstlane(tid >> 6), G = gridDim.x, bid = blockIdx.x;
    const int gw = bid * 8 + wave, NGW = G * 8;
    PG8_LAS unsigned char* ldsg = (PG8_LAS unsigned char*)lds;
    float* mod = (float*)(p.ws + WS_MOD);
    float* out = p.out;
    if (tid < 16) ((volatile LAS unsigned*)(ldsg + MISC_OFF))[tid] = 0u;
    __syncthreads();
    XcdBarrier xbar = xcd_barrier_post((unsigned*)(p.ws + WS_BAR), (volatile LAS unsigned*)(ldsg + MISC_OFF));
    if (p.ph_hi > 1000) grid.sync();
#define IN(k) (p.ph_lo <= (k) && (k) < p.ph_hi)
#define GSYNC() xcd_barrier(xbar)
#define SEAM(k) do { if (IN(k) && IN((k) + 1)) GSYNC(); } while (0)

#ifdef EXTRA_SYNCS
    for (int i_ = 0; i_ < EXTRA_SYNCS; ++i_) GSYNC();
#endif
    if (IN(0)) for (int rep_ = 0; rep_ < REP0; ++rep_) { if (rep_) GSYNC();
        for (int u = bid; u < 192; u += G) ada_unit(p, u, lds, tid);
        float* scr = (float*)lds + wave * (64 * 33);
        {
            const bool freeblk = bid >= 192;
            for (int i = 0; i < (freeblk ? 2 : 1); ++i) {
                int r = freeblk ? i * 512 + (gw - 1536) : 1024 + gw;
                if (r < TR_ITEMS[0]) tr_item(p, 0, r, scr, lane);
                else if ((r -= TR_ITEMS[0]) < TR_ITEMS[1]) tr_item(p, 1, r, scr, lane);
                else if ((r -= TR_ITEMS[1]) < TR_ITEMS[5]) tr_item(p, 5, r, scr, lane);
            }
        }
        {
            float* spool = out + (size_t)NTOK * DM + 16384 + 16384 + 61440 + 262144 + 262144;
            const float* sp = p.in[6];
            for (int i = bid * 512 + tid; i < 128 * 11 * 128; i += G * 512) { const int s = i / (11 * 128), q = i % (11 * 128);
                *(f32x4*)(spool + (size_t)s * 15 * 512 + 4 * q) = *(const f32x4*)(sp + (size_t)s * 15 * 512 + 4 * 512 + 4 * q); }
        }
    }
    SEAM(0);
    if (IN(1)) for (int rep_ = 0; rep_ < REP1; ++rep_) { if (rep_) GSYNC(); for (int u = bid; u < 96; u += G) ssm_prep_unit(p, u / 3, u % 3, lds, tid); modnorm_rows<false>(p.in[0], p.in[1], p.in[7], mod, 0, 1, (bf16_t*)(p.ws + WS_H), bid < 96 ? 44 * bid : 4224 + 80 * (bid - 96), bid < 96 ? 44 * bid + 44 : (4224 + 80 * (bid - 95) < NTOK ? 4224 + 80 * (bid - 95) : NTOK), wave, lane); }
    SEAM(1);
    if (IN(2)) for (int rep_ = 0; rep_ < REP2; ++rep_) { if (rep_) GSYNC();
        pg8::Gemm g{(const bf16_t*)(p.ws + WS_H), (const bf16_t*)(p.ws + WS_WIN), NP, 3072, 1024}; pg8::StaticOrder S; S.init(NP, 3072, G, bid);
        EpiG1 E{(bf16_t*)(p.ws + WS_US), (bf16_t*)(p.ws + WS_UP), (bf16_t*)(p.ws + WS_SGS), (bf16_t*)(p.ws + WS_SGP),
                out + (size_t)NTOK * DM + 32768, out + (size_t)NTOK * DM + 32768 + 61440 + 524288};
        pg8::gemm_phase<EpiG1, pg8::StaticOrder, PG_ALIGN, PG_SP2>(ldsg, g, S, E);
#ifdef DUP2
        GSYNC(); pg8::gemm_phase<EpiG1, pg8::StaticOrder, PG_ALIGN, PG_SP2>(ldsg, g, S, E);
#endif
        for (int u = bid; u < 256; u += G) {
            const int rt = u >> 5, ct = u & 31;
            skinny_wide96((const bf16_t*)(p.ws + WS_H), (const bf16_t*)(p.ws + WS_WIN), NP + 64 * rt, 96 * ct, lds, tid);
            for (int e8 = tid; e8 < 768; e8 += 512) {
                const int row = e8 / 12, c8 = (e8 % 12) * 8, col = 96 * ct + c8;
                const float* tp = (const float*)lds + row * 96 + c8;
                E.emit(NP + 64 * rt + row, col, col >> 8, *(const f32x4*)tp, *(const f32x4*)(tp + 4));
            }
            __syncthreads();
        }
    }
    SEAM(2);
    if (IN(3)) for (int rep_ = 0; rep_ < REP3; ++rep_) { if (rep_) GSYNC();
        for (int ra_ = 0; ra_ < REP3A; ++ra_) for (int u = bid; u < 256; u += G) {
            int ub = u >> 5, ug = u & 31;
            if (G == 256) { const int x = u & 7, y = u >> 3, quad = x + 8 * (y >> 2); ub = quad >> 3; ug = 4 * (quad & 7) + (y & 3); }
            ssm_block(p, ub, ug, lds, tid); }
        for (int rb_ = 0; rb_ < REP3B; ++rb_) { for (int u = bid; u < 256; u += G) pool_pair(p, u >> 2, u & 3, lds, tid); for (int u = G - 1 - bid; u < 64; u += G) pool_unit<2>(p, NP + 32 * (u >> 2), u & 3, lds, tid); }
        for (int rc_ = 0; rc_ < REP3C; ++rc_) for (int it = gw; it < 128 * 32; it += NGW) ssm_sample_item(p, it >> 5, it & 31, lane);
        {
            float* scr = (float*)lds + wave * (64 * 33);
            for (int it = gw; it < TR_ITEMS[2] + TR_ITEMS[3]; it += NGW) { if (it < TR_ITEMS[2]) tr_item(p, 2, it, scr, lane); else tr_item(p, 3, it - TR_ITEMS[2], scr, lane); }
        }
    }
    SEAM(3);
    if (IN(4)) for (int rep_ = 0; rep_ < REP4; ++rep_) { if (rep_) GSYNC();
        pg8::Gemm g{(const bf16_t*)(p.ws + WS_GY), (const bf16_t*)(p.ws + WS_WGLU), NP, 2048, 512}; pg8::StaticOrder S; S.init(NP, 2048, G, bid);
        EpiGLU E{(const bf16_t*)(p.ws + WS_SGS), (const bf16_t*)(p.ws + WS_ZS), (bf16_t*)(p.ws + WS_H)};
        pg8::gemm_phase<EpiGLU, pg8::StaticOrder, PG_ALIGN, PG_SP2>(ldsg, g, S, E);
        for (int u = bid; u < 256; u += G) {
            const int rt = u >> 5, jt = u & 31, j0 = 32 * jt, ra = 256 * (j0 >> 7) + (j0 & 127);
            const int br_[4] = {ra, ra + 16, ra + 128, ra + 144};
            skinny_unit<4>((const bf16_t*)(p.ws + WS_GY), 512, (const bf16_t*)(p.ws + WS_WGLU), 512, 512, NP + 64 * rt, br_, lds, tid);
            const float* tp = (const float*)lds + (tid >> 3) * 64 + (tid & 7) * 4;
            const f32x4 a = *(const f32x4*)tp, b = *(const f32x4*)(tp + 32);
            const size_t off = (size_t)(NP + 64 * rt + (tid >> 3)) * 1024 + j0 + (tid & 7) * 4;
            const u32x2 sg = *(const u32x2*)(E.SGS + off), zs = *(const u32x2*)(E.ZS + off);
            u32x2 o;
            o.x = cvt_pk_bf16(bf_lo(sg.x) * a[0] * fsigmoid(b[0]) + bf_lo(zs.x), bf_hi(sg.x) * a[1] * fsigmoid(b[1]) + bf_hi(zs.x));
            o.y = cvt_pk_bf16(bf_lo(sg.y) * a[2] * fsigmoid(b[2]) + bf_lo(zs.y), bf_hi(sg.y) * a[3] * fsigmoid(b[3]) + bf_hi(zs.y));
            *(u32x2*)(E.MGD + off) = o;
            __syncthreads();
        }
    }
    SEAM(4);
    if (IN(5)) for (int rep_ = 0; rep_ < REP5; ++rep_) { if (rep_) GSYNC();
        pg8::Gemm g{(const bf16_t*)(p.ws + WS_H), (const bf16_t*)(p.ws + WS_WOUT), NP, 1024, 1024}; pg8::StaticOrder S; S.init(NP, 1024, G, bid);
        EpiRes<0> E{p.in[0], nullptr, mod + 2 * DM, (bf16_t*)(p.ws + WS_XB)};
        pg8::gemm_phase<EpiRes<0>, pg8::StaticOrder, PG_ALIGN, PG_SP2>(ldsg, g, S, E);
        for (int u = bid; u < 256; u += G) {
            const int rt = u >> 5, ct = u & 31;
            const int br_[2] = {32 * ct, 32 * ct + 16};
            skinny_unit<2>((const bf16_t*)(p.ws + WS_H), 1024, (const bf16_t*)(p.ws + WS_WOUT), 1024, 1024, NP + 64 * rt, br_, lds, tid);
            const int row = 64 * rt + (tid >> 3), col = 32 * ct + 4 * (tid & 7), r = NP + row;
            const f32x4 a = *(const f32x4*)((const float*)lds + tid * 4);
            const f32x4 x = *(const f32x4*)(p.in[1] + (size_t)row * DM + col), gt = *(const f32x4*)(mod + (size_t)mrow(r) * 6144 + 2 * DM + col);
            { const f32x4 v = x + gt * a; u32x2 wv; wv.x = cvt_pk_bf16(v[0], v[1]); wv.y = cvt_pk_bf16(v[2], v[3]); *(u32x2*)((bf16_t*)(p.ws + WS_XB) + (size_t)r * DM + col) = wv; }
            __syncthreads();
        }
    }
    SEAM(5);
    if (IN(6)) for (int rep_ = 0; rep_ < REP6; ++rep_) { if (rep_) GSYNC(); modnorm_rows<true>((const float*)(p.ws + WS_XB), nullptr, p.in[8], mod, 3, 4, (bf16_t*)(p.ws + WS_H), 66 * bid, 66 * bid + 66, wave, lane); }
    SEAM(6);
    if (IN(7)) for (int rep_ = 0; rep_ < REP7; ++rep_) { if (rep_) GSYNC();
        pg8::Gemm g{(const bf16_t*)(p.ws + WS_H), (const bf16_t*)(p.ws + WS_WFI), NTOK, 2 * DFF, 1024}; pg8::StaticOrder S; S.init(NTOK, 2 * DFF, G, bid);
        EpiSwiGLU E{(bf16_t*)(p.ws + WS_ACT)};
        pg8::gemm_phase<EpiSwiGLU, pg8::StaticOrder, PG_ALIGN, PG_SP2>(ldsg, g, S, E);
#ifdef DUP7
        GSYNC(); pg8::gemm_phase<EpiSwiGLU, pg8::StaticOrder, PG_ALIGN, PG_SP2>(ldsg, g, S, E);
#endif
        {
            const int nun = (NTOK / 256) * (2 * DFF / 256), full = nun / G, rem = nun % G;
            if (rem != 0 && bid >= rem) { float* scr = (float*)lds + wave * (64 * 33); const int nidle = (G - rem) * 8;
                for (int it = (bid - rem) * 8 + wave; it < TR_ITEMS[4]; it += nidle) tr_item(p, 4, it, scr, lane); }
            else if (rem == 0) { float* scr = (float*)lds + wave * (64 * 33); for (int it = gw; it < TR_ITEMS[4]; it += NGW) tr_item(p, 4, it, scr, lane); }
            (void)full;
        }
    }
    SEAM(7);
    if (IN(8)) for (int rep_ = 0; rep_ < REP8; ++rep_) { if (rep_) GSYNC();
        pg8::Gemm g{(const bf16_t*)(p.ws + WS_ACT), (const bf16_t*)(p.ws + WS_WFO), NP, 1024, DFF}; pg8::StaticOrder S; S.init(NP, 1024, G, bid);
        EpiRes<1> E{nullptr, (const bf16_t*)(p.ws + WS_XB), mod + 5 * DM, (bf16_t*)(p.ws + WS_H)};
        pg8::gemm_phase<EpiRes<1>, pg8::StaticOrder, PG_ALIGN, PG_SP2>(ldsg, g, S, E);
#ifdef DUP8
        GSYNC(); pg8::gemm_phase<EpiRes<1>, pg8::StaticOrder, PG_ALIGN, PG_SP2>(ldsg, g, S, E);
#endif
        for (int u = bid; u < 256; u += G) {
            const int rt = u >> 5, ct = u & 31;
            const int br_[2] = {32 * ct, 32 * ct + 16};
            skinny_unit<2>((const bf16_t*)(p.ws + WS_ACT), DFF, (const bf16_t*)(p.ws + WS_WFO), DFF, DFF, NP + 64 * rt, br_, lds, tid);
            const int row = 64 * rt + (tid >> 3), col = 32 * ct + 4 * (tid & 7), r = NP + row;
            const f32x4 a = *(const f32x4*)((const float*)lds + tid * 4);
            const u32x2 xq = *(const u32x2*)((const bf16_t*)(p.ws + WS_XB) + (size_t)r * DM + col);
            const f32x4 x = (f32x4){bf_lo(xq.x), bf_hi(xq.x), bf_lo(xq.y), bf_hi(xq.y)}, gt = *(const f32x4*)(mod + (size_t)mrow(r) * 6144 + 5 * DM + col);
            { const f32x4 v = x + gt * a; u32x2 wv; wv.x = cvt_pk_bf16(v[0], v[1]); wv.y = cvt_pk_bf16(v[2], v[3]); *(u32x2*)((bf16_t*)(p.ws + WS_H) + (size_t)r * DM + col) = wv; }
            __syncthreads();
        }
    }
    SEAM(8);
    if (IN(9)) for (int rep_ = 0; rep_ < REP9; ++rep_) { if (rep_) GSYNC();
        const float* gf = p.in[9];
        f32x4 gg[4];
#pragma unroll
        for (int j = 0; j < 4; ++j) gg[j] = *(const f32x4*)(gf + 4 * lane + 256 * j);
        for (int r0 = gw; r0 < NTOK; r0 += 2 * NGW) {
            const int rr[2] = {r0, (r0 + NGW < NTOK) ? r0 + NGW : r0};
            f32x4 v[2][4]; float s[2];
#pragma unroll
            for (int h = 0; h < 2; ++h) { const bf16_t* xbr = (const bf16_t*)(p.ws + WS_H) + (size_t)rr[h] * DM + 4 * lane;
#pragma unroll
                for (int j = 0; j < 4; ++j) { const u32x2 q = *(const u32x2*)(xbr + 256 * j); v[h][j] = (f32x4){bf_lo(q.x), bf_hi(q.x), bf_lo(q.y), bf_hi(q.y)}; } }
#pragma unroll
            for (int h = 0; h < 2; ++h) { s[h] = 0.f;
#pragma unroll
                for (int j = 0; j < 4; ++j) s[h] += (v[h][j][0] * v[h][j][0] + v[h][j][1] * v[h][j][1]) + (v[h][j][2] * v[h][j][2] + v[h][j][3] * v[h][j][3]); }
#pragma unroll
            for (int o = 1; o < 64; o <<= 1) { s[0] += __shfl_xor(s[0], o); s[1] += __shfl_xor(s[1], o); }
#pragma unroll
            for (int h = 0; h < 2; ++h) if (h == 0 || rr[1] != rr[0]) {
                const float inv = rsqrtf(s[h] * (1.0f / DM) + EPS); float* xr = out + (size_t)rr[h] * DM + 4 * lane;
#pragma unroll
                for (int j = 0; j < 4; ++j) *(f32x4*)(xr + 256 * j) = (v[h][j] * inv) * gg[j];
            }
        }
    }
#undef IN
#undef SEAM
}

#ifndef MK_N_LAUNCHES
#define MK_N_LAUNCHES 1
#endif
extern "C" void kernel_launch(void* const* d_in, const int* in_sizes, int n_in, void* d_out, int out_size, void* d_ws, size_t ws_size, hipStream_t stream) {
    static int grid = 0;
    if (grid == 0) {
        int dev = 0, cus = 0, per_cu = 0;
        if (hipGetDevice(&dev) != hipSuccess || hipDeviceGetAttribute(&cus, hipDeviceAttributeMultiprocessorCount, dev) != hipSuccess) { fprintf(stderr, "kernel_launch: device query failed\n"); grid = -1; return; }
        if (hipFuncSetAttribute((const void*)mk_fwd, hipFuncAttributeMaxDynamicSharedMemorySize, LDS_BYTES) != hipSuccess) { fprintf(stderr, "kernel_launch: hipFuncSetAttribute failed\n"); grid = -1; return; }
        if (hipOccupancyMaxActiveBlocksPerMultiprocessor(&per_cu, (const void*)mk_fwd, 512, LDS_BYTES) != hipSuccess || per_cu < 1) { fprintf(stderr, "kernel_launch: occupancy query says %d blocks/CU\n", per_cu); (void)hipGetLastError(); grid = -1; return; }
        grid = cus * per_cu;
        if (n_in != 27 || ws_size < 232 * MiB) { fprintf(stderr, "kernel_launch: unexpected n_in %d / ws %zu\n", n_in, ws_size); grid = -1; return; }
    }
    if (grid < 0) return;
    if (hipMemsetAsync((char*)d_ws + WS_BAR, 0, 32768, stream) != hipSuccess) { fprintf(stderr, "kernel_launch: memset failed\n"); return; }
    Params p{};
    for (int i = 0; i < 27; ++i) p.in[i] = (const float*)d_in[i];
    p.out = (float*)d_out; p.ws = (unsigned char*)d_ws;
#if MK_N_LAUNCHES == 1
    p.ph_lo = 0; p.ph_hi = 10;
    void* args[] = {&p};
    hipError_t e = hipLaunchCooperativeKernel((const void*)mk_fwd, dim3(grid), dim3(512), args, LDS_BYTES, stream);
    if (e != hipSuccess) fprintf(stderr, "kernel_launch: cooperative launch failed: %s (grid %d)\n", hipGetErrorString(e), grid);
#else
    for (int ph = 0; ph < 10; ++ph) { p.ph_lo = ph; p.ph_hi = ph + 1; hipLaunchKernelGGL(mk_fwd, dim3(grid), dim3(512), LDS_BYTES, stream, p); }
#endif
}
```

```cpp
#include <hip/hip_runtime.h>
#include <hip/hip_cooperative_groups.h>
#include <cstdio>
#include <cstdint>
namespace cg = cooperative_groups;
namespace pg8 {
#define PG8_LAS __attribute__((address_space(3)))
typedef unsigned short bf16_t;
typedef short bf16x8 __attribute__((ext_vector_type(8)));
typedef float f32x4 __attribute__((ext_vector_type(4)));
typedef unsigned u32x4 __attribute__((ext_vector_type(4)));
constexpr int BM = 256, BK = 64, HALF = 128, HTB = HALF * BK * 2  , STAGE_BYTES = 8 * HTB, NXCD = 8, WGM = 8;

__host__ __device__ __forceinline__ int lds_byte(int r, int c) { const int st = (r >> 4) * 2 + (c >> 5), rr = r & 15, cc = c & 31, ob = rr * 64 + cc * 2; return st * 1024 + (ob ^ (((ob >> 9) & 1) << 5)); }
__host__ __device__ __forceinline__ void stage_rc(int b, int& R, int& C) { const int st = b / 1024, sb = b % 1024, swz = sb ^ (((sb >> 9) & 1) << 5); R = (st >> 1) * 16 + swz / 64; C = (st & 1) * 32 + (swz % 64) / 2; }
__host__ __device__ __forceinline__ int perm32(int rho) { const int n = rho >> 4, i = rho & 15; return 8 * (i >> 2) + 4 * n + (i & 3); }

struct Unit { int pm, pn; };
struct Gemm { const bf16_t* A; const bf16_t* Bt; int M, N, K; };

struct StaticOrder {
    int nM, nN, nwg, G, c;
    __host__ __device__ void init(int M, int N, int G_, int c_) { nM = M / BM; nN = N / BM; nwg = nM * nN; G = G_; c = c_; }
    __host__ __device__ bool next(int i, Unit& u) const {
        const long L = (long)i * G + c; if (L >= nwg) return false;
        int wgid = (int)L; { const int q = nwg / NXCD, r = nwg % NXCD, xcd = wgid % NXCD, off = wgid / NXCD; wgid = (xcd < r ? xcd * (q + 1) : r * (q + 1) + (xcd - r) * q) + off; }
        const int nig = WGM * nN, gid = wgid / nig, fm = gid * WGM, gsz = (nM - fm) < WGM ? (nM - fm) : WGM;
        u.pm = fm + ((wgid % nig) % gsz); u.pn = (wgid % nig) / gsz; return true;
    }
    __device__ __forceinline__ void a_ready(const Unit&) const {}
    __device__ __forceinline__ void done(const Unit&) const {}
};
__device__ __forceinline__ unsigned cvt_pk_bf16(float lo, float hi) { unsigned r; asm volatile("v_cvt_pk_bf16_f32 %0, %1, %2" : "=v"(r) : "v"(lo), "v"(hi)); return r; }
template <class Epi, class Sched, bool ALIGN_EPI = false, bool SP2 = false>
__device__ __forceinline__ void gemm_phase(PG8_LAS unsigned char* lds, const Gemm g, const Sched& S, const Epi& E) {
    const int tid = threadIdx.x, wid = __builtin_amdgcn_readfirstlane(tid >> 6), lane = tid & 63, wr = wid >> 2, wc = wid & 3, fr = lane & 15, fq = lane >> 4;
    const int K = g.K, nt = K / BK;
    unsigned voffA[2], voffB[2];
#pragma unroll
    for (int i = 0; i < 2; ++i) { int R, C; stage_rc(tid * 16 + i * 8192, R, C); const int Rb = Epi::PERM ? ((R & ~31) + perm32(R & 31)) : R;
        voffA[i] = (unsigned)(R * K + C) * 2u; voffB[i] = (unsigned)(Rb * K + C) * 2u; }
    const size_t kstep = (size_t)(BK * 2);
    const size_t hstep = (size_t)HALF * K * 2;
    const size_t tstep = 2 * hstep;
    const unsigned ldsw = (unsigned)wid * 1024u;
    const int aoff = lds_byte(wr * 64 + fr, fq * 8), boff = lds_byte(wc * 32 + fr, fq * 8);
#define PG8_SA(b, h) (((b) * 2 + (h)) * HTB)
#define PG8_SB(b, h) ((4 + (b) * 2 + (h)) * HTB)
#define PG8_STAGE(bufoff, gbase, voff) do { _Pragma("unroll") for (int _i = 0; _i < 2; ++_i) \
        __builtin_amdgcn_global_load_lds((const unsigned*)((const char*)(gbase) + (voff)[_i]), (PG8_LAS unsigned*)(lds + (bufoff) + ldsw + _i * 8192), 16, 0, 0); } while (0)
#define PG8_LDA(dst, b, h) do { _Pragma("unroll") for (int m = 0; m < 4; ++m) _Pragma("unroll") for (int k = 0; k < 2; ++k) dst[m][k] = *(const PG8_LAS bf16x8*)(lds + PG8_SA(b, h) + aoff + m * 2048 + k * 1024); } while (0)
#define PG8_LDB(dst, b, h) do { _Pragma("unroll") for (int n = 0; n < 2; ++n) _Pragma("unroll") for (int k = 0; k < 2; ++k) dst[n][k] = *(const PG8_LAS bf16x8*)(lds + PG8_SB(b, h) + boff + n * 2048 + k * 1024); } while (0)
#define PG8_MMA(ai, bj, At, Bt) do { __builtin_amdgcn_s_setprio(1); _Pragma("unroll") for (int m = 0; m < 4; ++m) _Pragma("unroll") for (int n = 0; n < 2; ++n) _Pragma("unroll") for (int k = 0; k < 2; ++k) \
        acc[ai][bj][m][n] = __builtin_amdgcn_mfma_f32_16x16x32_bf16(Bt[n][k], At[m][k], acc[ai][bj][m][n], 0, 0, 0); __builtin_amdgcn_s_setprio(0); } while (0)
#define PG8_WAIT_V(n) asm volatile("s_waitcnt vmcnt(" #n ")" ::: "memory")
#define PG8_WAIT_L(n) asm volatile("s_waitcnt lgkmcnt(" #n ")" ::: "memory")
#define PG8_BAR __builtin_amdgcn_s_barrier()
#define PG8_SCHED __builtin_amdgcn_sched_barrier(0)
    Unit cur, nxt; int ui = 0;
    if (!S.next(0, cur)) return;
    f32x4 acc[2][2][4][2];
#pragma unroll
    for (int a = 0; a < 2; ++a)
#pragma unroll
        for (int b = 0; b < 2; ++b)
#pragma unroll
            for (int m = 0; m < 4; ++m)
#pragma unroll
                for (int n = 0; n < 2; ++n) acc[a][b][m][n] = (f32x4){0.f, 0.f, 0.f, 0.f};
    bf16x8 At[4][2], B0[2][2], B1[2][2];
    const char* cA = (const char*)g.A + (size_t)cur.pm * tstep; const char* cB = (const char*)g.Bt + (size_t)cur.pn * tstep;
    S.a_ready(cur);
    if constexpr (SP2) {
        PG8_STAGE(PG8_SB(0, 0), cB, voffB); PG8_STAGE(PG8_SB(0, 1), cB + hstep, voffB); PG8_STAGE(PG8_SA(0, 0), cA, voffA); PG8_STAGE(PG8_SA(0, 1), cA + hstep, voffA);
        if (wr == 1) PG8_BAR;
        PG8_WAIT_V(2); PG8_BAR;
        PG8_STAGE(PG8_SB(1, 0), cB + kstep, voffB); PG8_STAGE(PG8_SA(1, 0), cA + kstep, voffA); PG8_STAGE(PG8_SB(1, 1), cB + hstep + kstep, voffB);
        PG8_WAIT_V(6); PG8_BAR;
    } else {
        PG8_STAGE(PG8_SB(0, 0), cB, voffB); PG8_STAGE(PG8_SA(0, 0), cA, voffA); PG8_STAGE(PG8_SB(0, 1), cB + hstep, voffB); PG8_STAGE(PG8_SA(0, 1), cA + hstep, voffA);
        if (wr == 1) PG8_BAR;
        PG8_WAIT_V(4); PG8_BAR;
        PG8_STAGE(PG8_SB(1, 0), cB + kstep, voffB); PG8_STAGE(PG8_SA(1, 0), cA + kstep, voffA); PG8_STAGE(PG8_SB(1, 1), cB + hstep + kstep, voffB);
        PG8_WAIT_V(6); PG8_BAR;
    }
    for (;;) {
        const bool has_next = S.next(ui + 1, nxt);
        const char* nA = has_next ? (const char*)g.A + (size_t)nxt.pm * tstep : cA; const char* nB = has_next ? (const char*)g.Bt + (size_t)nxt.pn * tstep : cB;
        for (int t = 0; t < nt; t += 2) {
            const bool last = (t == nt - 2);
            const char* a1 = cA + (size_t)(t + 1) * kstep;
            const char* a2 = last ? nA : cA + (size_t)(t + 2) * kstep; const char* b2 = last ? nB : cB + (size_t)(t + 2) * kstep;
            const char* a3 = a2 + kstep; const char* b3 = b2 + kstep;
            if (last && has_next) S.a_ready(nxt);
            if constexpr (SP2) {
            PG8_LDB(B0, 0, 0); PG8_LDB(B1, 0, 1); PG8_SCHED; PG8_LDA(At, 0, 0); PG8_STAGE(PG8_SA(1, 1), a1 + hstep, voffA);
            PG8_WAIT_V(8); PG8_WAIT_L(0); PG8_BAR; PG8_MMA(0, 0, At, B0); PG8_MMA(0, 1, At, B1); PG8_BAR; PG8_SCHED;
            PG8_LDA(At, 0, 1); PG8_STAGE(PG8_SB(0, 0), b2, voffB); PG8_STAGE(PG8_SB(0, 1), b2 + hstep, voffB); PG8_STAGE(PG8_SA(0, 0), a2, voffA);
            PG8_WAIT_V(8); PG8_WAIT_L(0); PG8_BAR; PG8_MMA(1, 0, At, B0); PG8_MMA(1, 1, At, B1); PG8_BAR; PG8_SCHED;
            PG8_LDB(B0, 1, 0); PG8_LDB(B1, 1, 1); PG8_SCHED; PG8_LDA(At, 1, 0); PG8_STAGE(PG8_SA(0, 1), a2 + hstep, voffA);
            PG8_WAIT_V(8); PG8_WAIT_L(0); PG8_BAR; PG8_MMA(0, 0, At, B0); PG8_MMA(0, 1, At, B1); PG8_BAR; PG8_SCHED;
            PG8_LDA(At, 1, 1); PG8_STAGE(PG8_SB(1, 0), b3, voffB); PG8_STAGE(PG8_SB(1, 1), b3 + hstep, voffB); PG8_STAGE(PG8_SA(1, 0), a3, voffA);
            PG8_WAIT_V(8); PG8_WAIT_L(0); PG8_BAR; PG8_MMA(1, 0, At, B0); PG8_MMA(1, 1, At, B1); PG8_BAR; PG8_SCHED;
            } else {
            PG8_LDB(B0, 0, 0); PG8_SCHED; PG8_LDA(At, 0, 0); PG8_STAGE(PG8_SA(1, 1), a1 + hstep, voffA);
            PG8_WAIT_L(8); PG8_BAR; PG8_WAIT_L(0); PG8_MMA(0, 0, At, B0); PG8_BAR; PG8_SCHED;
            PG8_LDB(B1, 0, 1); PG8_STAGE(PG8_SB(0, 0), b2, voffB);
            PG8_BAR; PG8_WAIT_L(0); PG8_MMA(0, 1, At, B1); PG8_BAR;
            PG8_LDA(At, 0, 1); PG8_STAGE(PG8_SA(0, 0), a2, voffA);
            PG8_BAR; PG8_WAIT_L(0); PG8_MMA(1, 0, At, B0); PG8_BAR; PG8_SCHED;
            PG8_STAGE(PG8_SB(0, 1), b2 + hstep, voffB);
            PG8_WAIT_V(6); PG8_BAR; PG8_MMA(1, 1, At, B1); PG8_BAR;
            PG8_LDB(B0, 1, 0); PG8_SCHED; PG8_LDA(At, 1, 0); PG8_STAGE(PG8_SA(0, 1), a2 + hstep, voffA);
            PG8_WAIT_L(8); PG8_BAR; PG8_WAIT_L(0); PG8_MMA(0, 0, At, B0); PG8_BAR; PG8_SCHED;
            PG8_LDB(B1, 1, 1); PG8_STAGE(PG8_SB(1, 0), b3, voffB);
            PG8_BAR; PG8_WAIT_L(0); PG8_MMA(0, 1, At, B1); PG8_BAR;
            PG8_LDA(At, 1, 1); PG8_STAGE(PG8_SA(1, 0), a3, voffA);
            PG8_BAR; PG8_WAIT_L(0); PG8_MMA(1, 0, At, B0); PG8_BAR; PG8_SCHED;
            PG8_STAGE(PG8_SB(1, 1), b3 + hstep, voffB);
            PG8_WAIT_V(6); PG8_BAR; PG8_MMA(1, 1, At, B1); PG8_BAR;
            }
        }
        if constexpr (ALIGN_EPI) { if (wr == 0) PG8_BAR; }
        if constexpr (!Epi::AFTER_DRAIN) { E(acc, cur, wr, wc, fr, fq); S.done(cur); }
        if (!has_next) break;
#pragma unroll
        for (int a = 0; a < 2; ++a)
#pragma unroll
            for (int b = 0; b < 2; ++b)
#pragma unroll
                for (int m = 0; m < 4; ++m)
#pragma unroll
                    for (int n = 0; n < 2; ++n) acc[a][b][m][n] = (f32x4){0.f, 0.f, 0.f, 0.f};
        cur = nxt; cA = nA; cB = nB; ++ui;
        if constexpr (ALIGN_EPI) { if (wr == 1) PG8_BAR; }
    }
    PG8_WAIT_V(0);
    if constexpr (!ALIGN_EPI) { if (wr == 0) PG8_BAR; }
    PG8_BAR;
    if constexpr (Epi::AFTER_DRAIN) { E.fused(acc, cur, wr, wc, fr, fq, lds, wid, lane); S.done(cur); }
#undef PG8_SA
#undef PG8_SB
#undef PG8_STAGE
#undef PG8_LDA
#undef PG8_LDB
#undef PG8_MMA
#undef PG8_WAIT_V
#undef PG8_WAIT_L
#undef PG8_BAR
#undef PG8_SCHED
}
}

using pg8::f32x4; using pg8::u32x4; using pg8::bf16x8; using pg8::bf16_t; using pg8::Unit; using pg8::cvt_pk_bf16;
typedef unsigned u32x2 __attribute__((ext_vector_type(2)));
typedef float f32x2 __attribute__((ext_vector_type(2)));

constexpr int DM = 1024, NP = 16384, NS = 512, NTOK = NP + NS, NMODROW = 136, DFF = 2816;
constexpr float EPS = 1e-6f;
constexpr int LDS_BYTES = 147456;
constexpr size_t MiB = 1u << 20;
constexpr size_t WS_CTR = 16384;
constexpr size_t WS_MOD = 1 * MiB;
constexpr size_t WS_SP = 5 * MiB;
constexpr size_t WS_MG = 6 * MiB, WS_EG = 10 * MiB, WS_RG = 12 * MiB;
constexpr size_t WS_WIN = 16 * MiB, WS_WGLU = 22 * MiB, WS_WPOOL = 24 * MiB, WS_WOUT = 25 * MiB, WS_WFI = 27 * MiB, WS_WFO = 39 * MiB;
constexpr size_t WS_H = 48 * MiB;
constexpr size_t WS_US = 82 * MiB, WS_UP = 99 * MiB;
constexpr size_t WS_SGS = 116 * MiB, WS_SGP = 149 * MiB;
constexpr size_t WS_GY = 182 * MiB;
constexpr size_t WS_ZS = 199 * MiB;
constexpr size_t WS_XB = 82 * MiB;
constexpr size_t WS_ACT = 116 * MiB;
constexpr int SP_AR = 0, SP_AI = 2048, SP_A16R = 4096, SP_A16I = 6144, SP_BBR = 8192, SP_BBI = 8192 + 32768;

struct Params {
    const float* in[27];
    float* out;
    unsigned char* ws;
    int ph_lo, ph_hi;
};

__device__ __forceinline__ float fsigmoid(float x) { return __builtin_amdgcn_rcpf(1.0f + __builtin_amdgcn_exp2f(-1.44269504089f * x)); }
__device__ __forceinline__ float fsilu(float x) { return x * fsigmoid(x); }
__device__ __forceinline__ float fgelu_tanh(float y) { return y * fsigmoid(1.59576912161f * y * (1.0f + 0.044715f * y * y)); }
__device__ __forceinline__ float bf_lo(unsigned u) { return __builtin_bit_cast(float, u << 16); }
__device__ __forceinline__ float bf_hi(unsigned u) { return __builtin_bit_cast(float, u & 0xffff0000u); }
__device__ __forceinline__ int mrow(int r) { return r < NP ? (r >> 11) : 8 + ((r - NP) >> 2); }
__device__ __forceinline__ bf16x8 pack8(f32x4 a, f32x4 b) {
    u32x4 w; w.x = cvt_pk_bf16(a[0], a[1]); w.y = cvt_pk_bf16(a[2], a[3]); w.z = cvt_pk_bf16(b[0], b[1]); w.w = cvt_pk_bf16(b[2], b[3]);
    return __builtin_bit_cast(bf16x8, w);
}
__device__ __forceinline__ float wave_sum(float v) {
#pragma unroll
    for (int o = 1; o < 64; o <<= 1) v += __shfl_xor(v, o);
    return v;
}
#ifdef NT_STORES
#define GST(ptr, v) __builtin_nontemporal_store((v), (ptr))
#else
#define GST(ptr, v) (*(ptr) = (v))
#endif
#define MFMA16(a, b, c) __builtin_amdgcn_mfma_f32_16x16x32_bf16((a), (b), (c), 0, 0, 0)

struct EpiG1 {
    static constexpr bool PERM = true, AFTER_DRAIN = false;
    bf16_t *US, *UP, *SGS, *SGP; float* ppool; float* spool;
    __device__ __forceinline__ void emit(int r, int c, int cls, f32x4 v0, f32x4 v1) const {
        if (cls < 2) {
            u32x4 w; w.x = cvt_pk_bf16(v0[0], v0[1]); w.y = cvt_pk_bf16(v0[2], v0[3]); w.z = cvt_pk_bf16(v1[0], v1[1]); w.w = cvt_pk_bf16(v1[2], v1[3]);
            GST((u32x4*)(US + (size_t)r * 512 + c), w);
        } else if (cls < 4) {
            const int cc = c - 512;
            u32x4 w; w.x = cvt_pk_bf16(v0[0], v0[1]); w.y = cvt_pk_bf16(v0[2], v0[3]); w.z = cvt_pk_bf16(v1[0], v1[1]); w.w = cvt_pk_bf16(v1[2], v1[3]);
            GST((u32x4*)(UP + (size_t)r * 512 + cc), w);
            if (r < NP) { const int t = r & 2047; if (t >= 2033) { float* o = ppool + ((size_t)(r >> 11) * 15 + (t - 2033)) * 512 + cc; *(f32x4*)o = v0; *(f32x4*)(o + 4) = v1; } }
            else { const int s = (r - NP) >> 2, i = (r - NP) & 3; float* o = spool + ((size_t)s * 15 + 11 + i) * 512 + cc; *(f32x4*)o = v0; *(f32x4*)(o + 4) = v1; }
        } else {
#pragma unroll
            for (int j = 0; j < 4; ++j) { v0[j] = fsigmoid(v0[j]); v1[j] = fsigmoid(v1[j]); }
            u32x4 w; w.x = cvt_pk_bf16(v0[0], v0[1]); w.y = cvt_pk_bf16(v0[2], v0[3]); w.z = cvt_pk_bf16(v1[0], v1[1]); w.w = cvt_pk_bf16(v1[2], v1[3]);
            if (cls < 8) GST((u32x4*)(SGS + (size_t)r * 1024 + (c - 1024)), w); else GST((u32x4*)(SGP + (size_t)r * 1024 + (c - 2048)), w);
        }
    }
    __device__ __forceinline__ void operator()(const f32x4 (&acc)[2][2][4][2], const Unit& u, int wr, int wc, int fr, int fq) const {
        const int row0 = u.pm * 256 + wr * 64 + fr, colt = u.pn * 256 + wc * 32 + 8 * fq;
#pragma unroll
        for (int ai = 0; ai < 2; ++ai)
#pragma unroll
            for (int m = 0; m < 4; ++m)
#pragma unroll
                for (int bj = 0; bj < 2; ++bj) emit(row0 + ai * 128 + m * 16, colt + bj * 128, u.pn, acc[ai][bj][m][0], acc[ai][bj][m][1]);
    }
};
struct EpiGLU {
    static constexpr bool PERM = true, AFTER_DRAIN = false;
    const bf16_t *SGS, *ZS; bf16_t* MGD;
    __device__ __forceinline__ void operator()(const f32x4 (&acc)[2][2][4][2], const Unit& u, int wr, int wc, int fr, int fq) const {
        const int row0 = u.pm * 256 + wr * 64 + fr, j0 = u.pn * 128 + wc * 32 + 8 * fq;
        u32x4 sgv[2][4], zsv[2][4];
#pragma unroll
        for (int ai = 0; ai < 2; ++ai)
#pragma unroll
            for (int m = 0; m < 4; ++m) { const size_t off = (size_t)(row0 + ai * 128 + m * 16) * 1024 + j0; sgv[ai][m] = *(const u32x4*)(SGS + off); zsv[ai][m] = *(const u32x4*)(ZS + off); }
#pragma unroll
        for (int ai = 0; ai < 2; ++ai)
#pragma unroll
            for (int m = 0; m < 4; ++m) {
                const size_t off = (size_t)(row0 + ai * 128 + m * 16) * 1024 + j0;
                const u32x4 sg = sgv[ai][m], zs = zsv[ai][m];
                const f32x4 a0 = acc[ai][0][m][0], a1 = acc[ai][0][m][1], b0 = acc[ai][1][m][0], b1 = acc[ai][1][m][1];
                float o[8];
                o[0] = bf_lo(sg.x) * a0[0] * fsigmoid(b0[0]) + bf_lo(zs.x); o[1] = bf_hi(sg.x) * a0[1] * fsigmoid(b0[1]) + bf_hi(zs.x);
                o[2] = bf_lo(sg.y) * a0[2] * fsigmoid(b0[2]) + bf_lo(zs.y); o[3] = bf_hi(sg.y) * a0[3] * fsigmoid(b0[3]) + bf_hi(zs.y);
                o[4] = bf_lo(sg.z) * a1[0] * fsigmoid(b1[0]) + bf_lo(zs.z); o[5] = bf_hi(sg.z) * a1[1] * fsigmoid(b1[1]) + bf_hi(zs.z);
                o[6] = bf_lo(sg.w) * a1[2] * fsigmoid(b1[2]) + bf_lo(zs.w); o[7] = bf_hi(sg.w) * a1[3] * fsigmoid(b1[3]) + bf_hi(zs.w);
                u32x4 w; w.x = cvt_pk_bf16(o[0], o[1]); w.y = cvt_pk_bf16(o[2], o[3]); w.z = cvt_pk_bf16(o[4], o[5]); w.w = cvt_pk_bf16(o[6], o[7]);
                GST((u32x4*)(MGD + off), w);
            }
    }
};
struct EpiSwiGLU {
    static constexpr bool PERM = true, AFTER_DRAIN = false;
    bf16_t* ACT;
    __device__ __forceinline__ void operator()(const f32x4 (&acc)[2][2][4][2], const Unit& u, int wr, int wc, int fr, int fq) const {
        const int row0 = u.pm * 256 + wr * 64 + fr, j0 = u.pn * 128 + wc * 32 + 8 * fq;
#pragma unroll
        for (int ai = 0; ai < 2; ++ai)
#pragma unroll
            for (int m = 0; m < 4; ++m) {
                const size_t off = (size_t)(row0 + ai * 128 + m * 16) * DFF + j0;
                const f32x4 a0 = acc[ai][0][m][0], a1 = acc[ai][0][m][1], b0 = acc[ai][1][m][0], b1 = acc[ai][1][m][1];
                u32x4 w;
                w.x = cvt_pk_bf16(fsilu(a0[0]) * b0[0], fsilu(a0[1]) * b0[1]); w.y = cvt_pk_bf16(fsilu(a0[2]) * b0[2], fsilu(a0[3]) * b0[3]);
                w.z = cvt_pk_bf16(fsilu(a1[0]) * b1[0], fsilu(a1[1]) * b1[1]); w.w = cvt_pk_bf16(fsilu(a1[2]) * b1[2], fsilu(a1[3]) * b1[3]);
                GST((u32x4*)(ACT + off), w);
            }
    }
};
template <int MODE> struct EpiRes {
    static constexpr bool PERM = false, AFTER_DRAIN = false;
    const float* baseF; const bf16_t* baseB; const float* gate; bf16_t* XO;
    __device__ __forceinline__ void operator()(const f32x4 (&acc)[2][2][4][2], const Unit& u, int wr, int wc, int fr, int fq) const {
        const int row0 = u.pm * 256 + wr * 64 + fr, col0 = u.pn * 256 + wc * 32 + 4 * fq;
        const float* gp = gate + (size_t)((u.pm * 256) >> 11) * 6144 + col0;
        f32x4 gt[2][2];
#pragma unroll
        for (int bj = 0; bj < 2; ++bj)
#pragma unroll
            for (int n = 0; n < 2; ++n) gt[bj][n] = *(const f32x4*)(gp + bj * 128 + n * 16);
        if (MODE == 0) {
#pragma unroll
            for (int ai = 0; ai < 2; ++ai) {
                f32x4 x[4][2][2];
#pragma unroll
                for (int m = 0; m < 4; ++m) { const float* bp = baseF + (size_t)(row0 + ai * 128 + m * 16) * DM + col0;
#pragma unroll
                    for (int bj = 0; bj < 2; ++bj)
#pragma unroll
                        for (int n = 0; n < 2; ++n) x[m][bj][n] = *(const f32x4*)(bp + bj * 128 + n * 16); }
#pragma unroll
                for (int m = 0; m < 4; ++m) { bf16_t* xp = XO + (size_t)(row0 + ai * 128 + m * 16) * DM + col0;
#pragma unroll
                    for (int bj = 0; bj < 2; ++bj)
#pragma unroll
                        for (int n = 0; n < 2; ++n) { const f32x4 v = x[m][bj][n] + gt[bj][n] * acc[ai][bj][m][n];
                            u32x2 w; w.x = cvt_pk_bf16(v[0], v[1]); w.y = cvt_pk_bf16(v[2], v[3]); GST((u32x2*)(xp + bj * 128 + n * 16), w); } }
            }
        } else {
            u32x2 x[2][4][2][2];
#pragma unroll
            for (int ai = 0; ai < 2; ++ai)
#pragma unroll
                for (int m = 0; m < 4; ++m) { const bf16_t* bp = baseB + (size_t)(row0 + ai * 128 + m * 16) * DM + col0;
#pragma unroll
                    for (int bj = 0; bj < 2; ++bj)
#pragma unroll
                        for (int n = 0; n < 2; ++n) x[ai][m][bj][n] = *(const u32x2*)(bp + bj * 128 + n * 16); }
#pragma unroll
            for (int ai = 0; ai < 2; ++ai)
#pragma unroll
                for (int m = 0; m < 4; ++m) { bf16_t* xp = XO + (size_t)(row0 + ai * 128 + m * 16) * DM + col0;
#pragma unroll
                    for (int bj = 0; bj < 2; ++bj)
#pragma unroll
                        for (int n = 0; n < 2; ++n) { const u32x2 q = x[ai][m][bj][n]; const f32x4 xv = (f32x4){bf_lo(q.x), bf_hi(q.x), bf_lo(q.y), bf_hi(q.y)};
                            const f32x4 v = xv + gt[bj][n] * acc[ai][bj][m][n];
                            u32x2 w; w.x = cvt_pk_bf16(v[0], v[1]); w.y = cvt_pk_bf16(v[2], v[3]); GST((u32x2*)(xp + bj * 128 + n * 16), w); } }
        }
    }
};

__device__ __forceinline__ void transpose_item(const float* W, int ldw, int k0, int n0, bf16_t* WT, int ldt, int drow0, float* scr, int lane) {
    float tv[32];
#pragma unroll
    for (int i = 0; i < 32; ++i) tv[i] = W[(size_t)(k0 + 2 * i + (lane >> 5)) * ldw + n0 + (lane & 31)];
#pragma unroll
    for (int i = 0; i < 32; ++i) scr[(2 * i + (lane >> 5)) * 33 + (lane & 31)] = tv[i];
    asm volatile("s_waitcnt lgkmcnt(0)" ::: "memory");
    const int c = lane & 7;
#pragma unroll
    for (int j = 0; j < 4; ++j) { const int n = (lane >> 3) + 8 * j; const float* s = scr + (8 * c) * 33 + n;
        u32x4 o; o.x = cvt_pk_bf16(s[0 * 33], s[1 * 33]); o.y = cvt_pk_bf16(s[2 * 33], s[3 * 33]); o.z = cvt_pk_bf16(s[4 * 33], s[5 * 33]); o.w = cvt_pk_bf16(s[6 * 33], s[7 * 33]);
        *(u32x4*)(WT + (size_t)(drow0 + n) * ldt + k0 + 8 * c) = o; }
    asm volatile("s_waitcnt lgkmcnt(0)" ::: "memory");
}
__device__ __forceinline__ int glu_row(int n, int half) { return n < half ? 256 * (n >> 7) + (n & 127) : 256 * ((n - half) >> 7) + 128 + ((n - half) & 127); }

constexpr int TR_ITEMS[6] = {16 * 96, 8 * 64, 16 * 32, 16 * 176, 44 * 32, 4 * 2 * 8};
__device__ __forceinline__ void tr_item(const Params& p, int which, int r, float* scr, int lane) {
    if (which == 0) { const int kb = r / 96, nb = r % 96; transpose_item(p.in[12], 3072, 64 * kb, 32 * nb, (bf16_t*)(p.ws + WS_WIN), 1024, 32 * nb, scr, lane); }
    else if (which == 1) { const int kb = r / 64, nb = r % 64; transpose_item(p.in[21], 2048, 64 * kb, 32 * nb, (bf16_t*)(p.ws + WS_WGLU), 512, glu_row(32 * nb, 1024), scr, lane); }
    else if (which == 2) { const int kb = r / 32, nb = r % 32; transpose_item(p.in[24], 1024, 64 * kb, 32 * nb, (bf16_t*)(p.ws + WS_WOUT), 1024, 32 * nb, scr, lane); }
    else if (which == 3) { const int kb = r / 176, nb = r % 176; transpose_item(p.in[25], 5632, 64 * kb, 32 * nb, (bf16_t*)(p.ws + WS_WFI), 1024, glu_row(32 * nb, DFF), scr, lane); }
    else if (which == 4) { const int kb = r / 32, nb = r % 32; transpose_item(p.in[26], 1024, 64 * kb, 32 * nb, (bf16_t*)(p.ws + WS_WFO), DFF, 32 * nb, scr, lane); }
    else { const int gk = r / 16, q = r % 16, kb = q / 8, nb = q % 8; transpose_item(p.in[22] + (size_t)gk * 128 * 256, 256, 64 * kb, 32 * nb, (bf16_t*)(p.ws + WS_WPOOL) + (size_t)gk * 256 * 128, 128, 32 * nb, scr, lane); }
}
__device__ __forceinline__ void ada_unit(const Params& p, int unit, unsigned char* lds, int tid) {
    const int lane = tid & 63, w = tid >> 6, lr = lane & 15, lq = lane >> 4, kq = w & 3, mh = w >> 2;
    const int n0 = unit * 32, mt0 = mh ? 5 : 0, mcnt = mh ? 4 : 5;
    const float* cp = p.in[2]; const float* cs = p.in[3]; const float* wa = p.in[10]; const float* ba = p.in[11];
    float* mod = (float*)(p.ws + WS_MOD);
    float* red = (float*)lds;
    f32x4 acc[5][2];
#pragma unroll
    for (int i = 0; i < 5; ++i) { acc[i][0] = (f32x4){0.f, 0.f, 0.f, 0.f}; acc[i][1] = (f32x4){0.f, 0.f, 0.f, 0.f}; }
#pragma unroll 2
    for (int ks = 0; ks < 8; ++ks) {
        const int k0 = kq * 256 + ks * 32 + 8 * lq;
        bf16x8 bfr[2];
#pragma unroll
        for (int nt = 0; nt < 2; ++nt) {
            const float* bp = wa + (size_t)k0 * 6144 + n0 + 16 * nt + lr;
            f32x4 x0, x1;
            x0[0] = bp[0]; x0[1] = bp[6144]; x0[2] = bp[2 * 6144]; x0[3] = bp[3 * 6144]; x1[0] = bp[4 * 6144]; x1[1] = bp[5 * 6144]; x1[2] = bp[6 * 6144]; x1[3] = bp[7 * 6144];
            bfr[nt] = pack8(x0, x1);
        }
#pragma unroll
        for (int mi = 0; mi < 5; ++mi) {
            if (mi < mcnt) {
                const int row = 16 * (mt0 + mi) + lr;
                f32x4 x0 = (f32x4){0.f, 0.f, 0.f, 0.f}, x1 = x0;
                if (row < NMODROW) { const float* ap = (row < 8 ? cp + (size_t)row * DM : cs + (size_t)(row - 8) * DM) + k0; x0 = *(const f32x4*)ap; x1 = *(const f32x4*)(ap + 4); }
#pragma unroll
                for (int j = 0; j < 4; ++j) { x0[j] = fsilu(x0[j]); x1[j] = fsilu(x1[j]); }
                const bf16x8 af = pack8(x0, x1);
                acc[mi][0] = MFMA16(bfr[0], af, acc[mi][0]); acc[mi][1] = MFMA16(bfr[1], af, acc[mi][1]);
            }
        }
    }
#pragma unroll
    for (int mi = 0; mi < 5; ++mi) if (mi < mcnt) {
        const int row = 16 * (mt0 + mi) + lr;
        *(f32x4*)(red + ((size_t)(kq * 144 + row)) * 32 + 4 * lq) = acc[mi][0];
        *(f32x4*)(red + ((size_t)(kq * 144 + row)) * 32 + 16 + 4 * lq) = acc[mi][1];
    }
    __syncthreads();
    for (int o = tid; o < NMODROW * 32; o += 512) {
        const int row = o >> 5, col = o & 31;
        const float v = ((red[(0 * 144 + row) * 32 + col] + red[(1 * 144 + row) * 32 + col]) + (red[(2 * 144 + row) * 32 + col] + red[(3 * 144 + row) * 32 + col])) + ba[n0 + col];
        mod[(size_t)row * 6144 + n0 + col] = v;
    }
    __syncthreads();
}

__device__ __forceinline__ void ssm_prep_unit(const Params& p, int g, int part, unsigned char* lds, int tid) {
    float* L = (float*)lds;
    float* pwr = L;            float* pwi = L + 17 * 64;
    float* bbr = L + 2176;     float* bbi = bbr + 1024;
    float* crT = bbi + 1024;   float* ciT = crT + 1024;
    float* ktab = ciT + 1024;
    float* spf = (float*)(p.ws + WS_SP);
    bf16_t* MG = (bf16_t*)(p.ws + WS_MG) + (size_t)g * 256 * 256;
    bf16_t* EG = (bf16_t*)(p.ws + WS_EG) + (size_t)g * 256 * 128;
    bf16_t* RG = (bf16_t*)(p.ws + WS_RG) + (size_t)g * 128 * 256;
    const float dt = expf(p.in[15][g]);
    for (int i = tid; i < 17 * 64; i += 512) {
        const int pp = i & 63, d = i >> 6, gp = g * 64 + pp;
        const float lr = p.in[13][gp], li = p.in[14][gp];
        const float mag = expf(lr * dt * (float)d), ang = li * dt * (float)d; float sn, cs; sincosf(ang, &sn, &cs); pwr[d * 64 + pp] = mag * cs; pwi[d * 64 + pp] = mag * sn;
    }
    for (int i = tid; i < 1024; i += 512) {
        const int pp = i >> 4, c = i & 15, gp = g * 64 + pp;
        const float lr = p.in[13][gp], li = p.in[14][gp];
        const float mag = expf(lr * dt), ang = li * dt; float sn, cs; sincosf(ang, &sn, &cs);
        const float abr = mag * cs, abi = mag * sn, den = lr * lr + li * li, nr = abr - 1.0f, ni = abi;
        const float fr = (nr * lr + ni * li) / den, fi = (ni * lr - nr * li) / den;
        const float br = p.in[16][(size_t)gp * 16 + c], bi = p.in[17][(size_t)gp * 16 + c];
        const float xr = fr * br - fi * bi, xi = fr * bi + fi * br; bbr[pp * 16 + c] = xr; bbi[pp * 16 + c] = xi;
        if (part == 2) { spf[SP_BBR + gp * 16 + c] = xr; spf[SP_BBI + gp * 16 + c] = xi; }
    }
    for (int i = tid; i < 1024; i += 512) { const int c = i >> 6, pp = i & 63; crT[pp * 16 + c] = p.in[18][(size_t)(g * 16 + c) * 64 + pp]; ciT[pp * 16 + c] = p.in[19][(size_t)(g * 16 + c) * 64 + pp]; }
    __syncthreads();
    if (part == 0) {
        {
            const int pair = tid & 255, d = pair >> 4, c2 = pair & 15, ch = tid >> 8;
            float a8[8];
#pragma unroll
            for (int i = 0; i < 8; ++i) a8[i] = 0.f;
#pragma unroll 8
            for (int pp = 0; pp < 64; ++pp) {
                const float ar = pwr[d * 64 + pp], ai = pwi[d * 64 + pp], br = bbr[pp * 16 + c2], bi = bbi[pp * 16 + c2];
                const float tr = ar * br - ai * bi, ti = ar * bi + ai * br;
                const f32x4 cr0 = *(const f32x4*)(crT + pp * 16 + 8 * ch), cr1 = *(const f32x4*)(crT + pp * 16 + 8 * ch + 4);
                const f32x4 ci0 = *(const f32x4*)(ciT + pp * 16 + 8 * ch), ci1 = *(const f32x4*)(ciT + pp * 16 + 8 * ch + 4);
#pragma unroll
                for (int i = 0; i < 4; ++i) { a8[i] += cr0[i] * tr - ci0[i] * ti; a8[4 + i] += cr1[i] * tr - ci1[i] * ti; }
            }
#pragma unroll
            for (int i = 0; i < 8; ++i) { const int c = 8 * ch + i; float v = a8[i]; if (d == 0 && c == c2) v += p.in[20][g * 16 + c]; ktab[d * 256 + c * 16 + c2] = v; }
        }
        __syncthreads();
        for (int idx = tid; idx < 8192; idx += 512) {
            const int n = idx >> 5, kk = (idx & 31) * 8, tau = n >> 4, c = n & 15, tp = kk >> 4, c0 = kk & 15;
            f32x4 x0 = (f32x4){0.f, 0.f, 0.f, 0.f}, x1 = x0;
            if (tau >= tp) { const float* s = ktab + (tau - tp) * 256 + c * 16 + c0; x0 = *(const f32x4*)s; x1 = *(const f32x4*)(s + 4); }
            *(bf16x8*)(MG + (size_t)n * 256 + kk) = pack8(x0, x1);
        }
    } else if (part == 1) {
        for (int idx = tid; idx < 4096; idx += 512) {
            const int n = idx >> 4, q0 = (idx & 15) * 8, tau = n >> 4, c = n & 15;
            float v[8];
#pragma unroll
            for (int j = 0; j < 8; ++j) { const int q = q0 + j, pp = q & 63; const float pr = pwr[(tau + 1) * 64 + pp], pi = pwi[(tau + 1) * 64 + pp], cr = crT[pp * 16 + c], ci = ciT[pp * 16 + c];
                v[j] = q < 64 ? (cr * pr - ci * pi) : -(cr * pi + ci * pr); }
            *(bf16x8*)(EG + (size_t)n * 128 + q0) = pack8((f32x4){v[0], v[1], v[2], v[3]}, (f32x4){v[4], v[5], v[6], v[7]});
        }
    } else {
        if (tid < 64) { const int gp = g * 64 + tid; spf[SP_AR + gp] = pwr[64 + tid]; spf[SP_AI + gp] = pwi[64 + tid]; spf[SP_A16R + gp] = pwr[16 * 64 + tid]; spf[SP_A16I + gp] = pwi[16 * 64 + tid]; }
        for (int idx = tid; idx < 4096; idx += 512) {
            const int q = idx >> 5, kk = (idx & 31) * 8, tp = kk >> 4, c0 = kk & 15, pp = q & 63;
            const float pr = pwr[(15 - tp) * 64 + pp], pi = pwi[(15 - tp) * 64 + pp];
            const f32x4 br0 = *(const f32x4*)(bbr + pp * 16 + c0), br1 = *(const f32x4*)(bbr + pp * 16 + c0 + 4), bi0 = *(const f32x4*)(bbi + pp * 16 + c0), bi1 = *(const f32x4*)(bbi + pp * 16 + c0 + 4);
            const f32x4 v0 = q < 64 ? (br0 * pr - bi0 * pi) : (bi0 * pr + br0 * pi), v1 = q < 64 ? (br1 * pr - bi1 * pi) : (bi1 * pr + br1 * pi);
            *(bf16x8*)(RG + (size_t)q * 256 + kk) = pack8(v0, v1);
        }
    }
    __syncthreads();
}

template <bool BF> __device__ __forceinline__ void modnorm_rows(const float* xa, const float* xb, const float* gvec, const float* mod, int jshift, int jscale, bf16_t* H, int rbeg, int rend, int wave, int lane) {
    for (int r0 = rbeg + wave; r0 < rend; r0 += 16) {
        const int rr[2] = {r0, (r0 + 8 < rend) ? r0 + 8 : r0};
        f32x4 v[2][4], sc[2][4], sh[2][4], gg[4];
#pragma unroll
        for (int h = 0; h < 2; ++h) {
            const int r = rr[h];
            const float* xr = (r < NP ? xa + (size_t)r * DM : xb + (size_t)(r - NP) * DM) + 4 * lane;
            const bf16_t* xbr = (const bf16_t*)xa + (size_t)r * DM + 4 * lane;
#pragma unroll
            for (int j = 0; j < 4; ++j) { if (BF) { const u32x2 q = *(const u32x2*)(xbr + 256 * j); v[h][j] = (f32x4){bf_lo(q.x), bf_hi(q.x), bf_lo(q.y), bf_hi(q.y)}; } else v[h][j] = *(const f32x4*)(xr + 256 * j); }
            const float* mr = mod + (size_t)mrow(r) * 6144 + 4 * lane;
#pragma unroll
            for (int j = 0; j < 4; ++j) { sc[h][j] = *(const f32x4*)(mr + jscale * DM + 256 * j); sh[h][j] = *(const f32x4*)(mr + jshift * DM + 256 * j); }
        }
#pragma unroll
        for (int j = 0; j < 4; ++j) gg[j] = *(const f32x4*)(gvec + 4 * lane + 256 * j);
        float s[2];
#pragma unroll
        for (int h = 0; h < 2; ++h) { s[h] = 0.f;
#pragma unroll
            for (int j = 0; j < 4; ++j) s[h] += (v[h][j][0] * v[h][j][0] + v[h][j][1] * v[h][j][1]) + (v[h][j][2] * v[h][j][2] + v[h][j][3] * v[h][j][3]); }
#pragma unroll
        for (int o = 1; o < 64; o <<= 1) { s[0] += __shfl_xor(s[0], o); s[1] += __shfl_xor(s[1], o); }
#pragma unroll
        for (int h = 0; h < 2; ++h) {
            const float inv = rsqrtf(s[h] * (1.0f / DM) + EPS);
            if (h == 0 || rr[1] != rr[0]) {
#pragma unroll
                for (int j = 0; j < 4; ++j) {
                    const f32x4 hv = (v[h][j] * inv) * gg[j] * (sc[h][j] + 1.0f) + sh[h][j];
                    u32x2 w; w.x = cvt_pk_bf16(hv[0], hv[1]); w.y = cvt_pk_bf16(hv[2], hv[3]);
                    *(u32x2*)(H + (size_t)rr[h] * DM + 4 * lane + 256 * j) = w;
                }
            }
        }
    }
}

constexpr int UP_PITCH = 264;
constexpr int RS_PITCH = 132;
__device__ __forceinline__ void ssm_block(const Params& p, int b, int g, unsigned char* lds, int tid) {
    const int lane = tid & 63, w = tid >> 6, lr = lane & 15, lq = lane >> 4;
    bf16_t* U = (bf16_t*)lds;
    float* RS = (float*)(lds + 128 * UP_PITCH * 2);
    const bf16_t* US = (const bf16_t*)(p.ws + WS_US);
    bf16_t* GY = (bf16_t*)(p.ws + WS_GY);
    const float* spf = (const float*)(p.ws + WS_SP);
    u32x4 uraw[8];
#pragma unroll
    for (int i = 0; i < 8; ++i) { const int q = tid + 512 * i, tok = q >> 1, half = q & 1; uraw[i] = *(const u32x4*)(US + ((size_t)(b * 2048 + tok) * 512 + g * 16 + half * 8)); }
    const bf16_t* Rb = (const bf16_t*)(p.ws + WS_RG) + ((size_t)g * 128 + 16 * w + lr) * 256 + 8 * lq;
    bf16x8 rf[8];
#pragma unroll
    for (int ks = 0; ks < 8; ++ks) rf[ks] = *(const bf16x8*)(Rb + 32 * ks);
    const bf16_t* Mb = (const bf16_t*)(p.ws + WS_MG) + ((size_t)g * 256 + 32 * w + lr) * 256 + 8 * lq;
    bf16x8 m0[8], m1[8];
#pragma unroll
    for (int ks = 0; ks < 8; ++ks) { m0[ks] = *(const bf16x8*)(Mb + 32 * ks); m1[ks] = *(const bf16x8*)(Mb + 16 * 256 + 32 * ks); }
#pragma unroll
    for (int i = 0; i < 8; ++i) { const int q = tid + 512 * i, tok = q >> 1, half = q & 1; *(u32x4*)(U + (tok >> 4) * UP_PITCH + (tok & 15) * 16 + half * 8) = uraw[i]; }
    __syncthreads();
    f32x4 acc[8][2];
    {
        f32x4 acc1[8];
#pragma unroll
        for (int i = 0; i < 8; ++i) acc1[i] = (f32x4){0.f, 0.f, 0.f, 0.f};
#pragma unroll
        for (int ks = 0; ks < 8; ++ks) {
#pragma unroll
            for (int mt = 0; mt < 8; ++mt) { const bf16x8 af = *(const bf16x8*)(U + (16 * mt + lr) * UP_PITCH + 32 * ks + 8 * lq); acc1[mt] = MFMA16(rf[ks], af, acc1[mt]); }
            __builtin_amdgcn_sched_barrier(0);
        }
#pragma unroll
        for (int mt = 0; mt < 8; ++mt) *(f32x4*)(RS + (16 * mt + lr) * RS_PITCH + 16 * w + 4 * lq) = acc1[mt];
    }
    {
#pragma unroll
        for (int i = 0; i < 8; ++i) { acc[i][0] = (f32x4){0.f, 0.f, 0.f, 0.f}; acc[i][1] = (f32x4){0.f, 0.f, 0.f, 0.f}; }
#pragma unroll
        for (int ks = 0; ks < 8; ++ks) if (ks <= w) {
#pragma unroll
            for (int mt = 0; mt < 8; ++mt) { const bf16x8 af = *(const bf16x8*)(U + (16 * mt + lr) * UP_PITCH + 32 * ks + 8 * lq);
                acc[mt][0] = MFMA16(m0[ks], af, acc[mt][0]); acc[mt][1] = MFMA16(m1[ks], af, acc[mt][1]); }
            __builtin_amdgcn_sched_barrier(0);
        }
    }
    const bf16_t* Eb = (const bf16_t*)(p.ws + WS_EG) + ((size_t)g * 256 + 32 * w + lr) * 128 + 8 * lq;
    bf16x8 e0[4], e1[4];
#pragma unroll
    for (int ks = 0; ks < 4; ++ks) { e0[ks] = *(const bf16x8*)(Eb + 32 * ks); e1[ks] = *(const bf16x8*)(Eb + 16 * 128 + 32 * ks); }
    __syncthreads();
    {
        float* TT = RS + 128 * RS_PITCH;
        const int gp = g * 64 + lane; const float ar = spf[SP_A16R + gp], ai = spf[SP_A16I + gp];
        float sr = 0.f, si = 0.f;
#pragma unroll
        for (int jj = 0; jj < 16; ++jj) {
            const int j = 16 * w + jj;
            const float rr = RS[j * RS_PITCH + lane], ri = RS[j * RS_PITCH + 64 + lane];
            RS[j * RS_PITCH + lane] = sr; RS[j * RS_PITCH + 64 + lane] = si;
            const float nr = ar * sr - ai * si + rr, ni = ar * si + ai * sr + ri; sr = nr; si = ni;
        }
        TT[w * 128 + lane] = sr; TT[w * 128 + 64 + lane] = si;
        float br = ar, bi = ai;
#pragma unroll
        for (int i = 0; i < 4; ++i) { const float xr = br * br - bi * bi, xi = 2.0f * br * bi; br = xr; bi = xi; }
        __syncthreads();
        float cr = 0.f, ci = 0.f;
        for (int v = 0; v < w; ++v) { const float tr = TT[v * 128 + lane], ti = TT[v * 128 + 64 + lane]; const float nr = br * cr - bi * ci + tr, ni = br * ci + bi * cr + ti; cr = nr; ci = ni; }
        float pr = 1.f, pi = 0.f;
#pragma unroll
        for (int jj = 0; jj < 16; ++jj) {
            const int j = 16 * w + jj;
            RS[j * RS_PITCH + lane] += pr * cr - pi * ci; RS[j * RS_PITCH + 64 + lane] += pr * ci + pi * cr;
            const float nr = pr * ar - pi * ai, ni = pr * ai + pi * ar; pr = nr; pi = ni;
        }
        if (w == 7) {
            float* ore = p.out + (size_t)NTOK * DM; float* oim = ore + 16384;
            ore[(size_t)(b * 32 + g) * 64 + lane] = br * cr - bi * ci + sr; oim[(size_t)(b * 32 + g) * 64 + lane] = br * ci + bi * cr + si;
        }
    }
    __syncthreads();
    {
#pragma unroll
        for (int ks = 0; ks < 4; ++ks) {
#pragma unroll
            for (int mt = 0; mt < 8; ++mt) { const float* f = RS + (16 * mt + lr) * RS_PITCH + 32 * ks + 8 * lq;
                const bf16x8 af = pack8(*(const f32x4*)f, *(const f32x4*)(f + 4));
                acc[mt][0] = MFMA16(e0[ks], af, acc[mt][0]); acc[mt][1] = MFMA16(e1[ks], af, acc[mt][1]); }
            __builtin_amdgcn_sched_barrier(0);
        }
#pragma unroll
        for (int mt = 0; mt < 8; ++mt)
#pragma unroll
            for (int nt = 0; nt < 2; ++nt) {
                const int j = 16 * mt + lr, tau = 2 * w + nt; const size_t row = (size_t)b * 2048 + 16 * j + tau;
                const f32x4 y = acc[mt][nt];
                u32x2 o; o.x = cvt_pk_bf16(fgelu_tanh(y[0]), fgelu_tanh(y[1])); o.y = cvt_pk_bf16(fgelu_tanh(y[2]), fgelu_tanh(y[3]));
                *(u32x2*)(GY + row * 512 + g * 16 + 4 * lq) = o;
            }
    }
    __syncthreads();
}

__device__ __forceinline__ void ssm_sample_pair(const Params& p, int s0, int s1, int g, int lane) {
    const bf16_t* US = (const bf16_t*)(p.ws + WS_US);
    bf16_t* GY = (bf16_t*)(p.ws + WS_GY);
    const float* spf = (const float*)(p.ws + WS_SP);
    const int gp = g * 64 + lane;
    const int ss[2] = {s0, s1};
    const float ar = spf[SP_AR + gp], ai = spf[SP_AI + gp];
    float bbr[16], bbi[16];
#pragma unroll
    for (int i = 0; i < 4; ++i) { const f32x4 x = *(const f32x4*)(spf + SP_BBR + (size_t)gp * 16 + 4 * i), y = *(const f32x4*)(spf + SP_BBI + (size_t)gp * 16 + 4 * i);
#pragma unroll
        for (int j = 0; j < 4; ++j) { bbr[4 * i + j] = x[j]; bbi[4 * i + j] = y[j]; } }
    float hr[2], hi[2], sr[2][4], si[2][4];
    u32x4 uraw[2][4][2];
#pragma unroll
    for (int h = 0; h < 2; ++h) { hr[h] = p.in[4][(size_t)(ss[h] * 32 + g) * 64 + lane]; hi[h] = p.in[5][(size_t)(ss[h] * 32 + g) * 64 + lane];
#pragma unroll
        for (int t = 0; t < 4; ++t) { const bf16_t* up = US + (size_t)(NP + 4 * ss[h] + t) * 512 + g * 16; uraw[h][t][0] = *(const u32x4*)up; uraw[h][t][1] = *(const u32x4*)(up + 8); } }
#pragma unroll
    for (int t = 0; t < 4; ++t)
#pragma unroll
        for (int h = 0; h < 2; ++h) {
            const u32x4 u0 = uraw[h][t][0], u1 = uraw[h][t][1];
            float uu[16];
            uu[0] = bf_lo(u0.x); uu[1] = bf_hi(u0.x); uu[2] = bf_lo(u0.y); uu[3] = bf_hi(u0.y); uu[4] = bf_lo(u0.z); uu[5] = bf_hi(u0.z); uu[6] = bf_lo(u0.w); uu[7] = bf_hi(u0.w);
            uu[8] = bf_lo(u1.x); uu[9] = bf_hi(u1.x); uu[10] = bf_lo(u1.y); uu[11] = bf_hi(u1.y); uu[12] = bf_lo(u1.z); uu[13] = bf_hi(u1.z); uu[14] = bf_lo(u1.w); uu[15] = bf_hi(u1.w);
            float br = 0.f, bi = 0.f;
#pragma unroll
            for (int c = 0; c < 16; ++c) { br += bbr[c] * uu[c]; bi += bbi[c] * uu[c]; }
            const float nr = ar * hr[h] - ai * hi[h] + br, ni = ar * hi[h] + ai * hr[h] + bi; hr[h] = nr; hi[h] = ni; sr[h][t] = nr; si[h][t] = ni;
        }
    float* ore = p.out + (size_t)NTOK * DM + 16384 + 16384 + 61440; float* oim = ore + 262144;
#pragma unroll
    for (int h = 0; h < 2; ++h) { ore[(size_t)(ss[h] * 32 + g) * 64 + lane] = hr[h]; oim[(size_t)(ss[h] * 32 + g) * 64 + lane] = hi[h]; }
    float v[2][64];
#pragma unroll
    for (int c = 0; c < 16; ++c) { const float cr = p.in[18][(size_t)(g * 16 + c) * 64 + lane], ci = p.in[19][(size_t)(g * 16 + c) * 64 + lane];
#pragma unroll
        for (int h = 0; h < 2; ++h)
#pragma unroll
            for (int t = 0; t < 4; ++t) v[h][t * 16 + c] = sr[h][t] * cr - si[h][t] * ci; }
#define TR_STEP(OFF) { const bool up = (lane & OFF) != 0; _Pragma("unroll") for (int i = 0; i < OFF; ++i) _Pragma("unroll") for (int h = 0; h < 2; ++h) { const float snd = up ? v[h][i] : v[h][i + OFF], kp = up ? v[h][i + OFF] : v[h][i]; v[h][i] = kp + __shfl_xor(snd, OFF); } }
    TR_STEP(32) TR_STEP(16) TR_STEP(8) TR_STEP(4) TR_STEP(2) TR_STEP(1)
#undef TR_STEP
    const int t = lane >> 4, c = lane & 15; const float dsk = p.in[20][g * 16 + c];
#pragma unroll
    for (int h = 0; h < 2; ++h) {
        const size_t row = (size_t)NP + 4 * ss[h] + t;
        const float uval = __builtin_bit_cast(float, ((unsigned)US[row * 512 + g * 16 + c]) << 16);
        const float y = v[h][0] + dsk * uval;
        GY[row * 512 + g * 16 + c] = (bf16_t)(cvt_pk_bf16(fgelu_tanh(y), 0.f) & 0xffffu);
    }
}

constexpr int PA_PITCH = 136;
template <int KG> __device__ __forceinline__ void pool_fill(const Params& p, int r0, bf16_t* A, int tid, int nseg) {
    if ((tid >> 6) >= nseg) return;
    constexpr int WIN = 2 << KG;
    const bf16_t* UPb = (const bf16_t*)(p.ws + WS_UP);
    const int cp = tid & 63, seg = tid >> 6, ch = 128 * KG + 2 * cp, base = r0 + 16 * seg;
    constexpr float rw = 1.0f / (float)WIN;
    if (r0 < NP) {
        const int t0 = base & 2047;
        unsigned raw[WIN - 1 + 16];
#pragma unroll
        for (int e = 0; e < WIN - 1 + 16; ++e) { const int rel = e - (WIN - 1); raw[e] = (t0 + rel >= 0) ? *(const unsigned*)(UPb + (size_t)(base + rel) * 512 + ch) : 0u; }
        float s0 = 0.f, s1 = 0.f;
#pragma unroll
        for (int e = 0; e < WIN - 1; ++e) { s0 += bf_lo(raw[e]); s1 += bf_hi(raw[e]); }
#pragma unroll
        for (int i = 0; i < 16; ++i) {
            const int t = t0 + i; const float c0 = bf_lo(raw[WIN - 1 + i]), c1 = bf_hi(raw[WIN - 1 + i]);
            s0 += c0; s1 += c1;
            const float rc = (t + 1 < WIN) ? 1.0f / (float)(t + 1) : rw;
            *(unsigned*)(A + (16 * seg + i) * PA_PITCH + 2 * cp) = cvt_pk_bf16(s0 * rc - c0, s1 * rc - c1);
            s0 -= bf_lo(raw[i]); s1 -= bf_hi(raw[i]);
        }
    } else {
        const float* sp = p.in[6];
#pragma unroll
        for (int q = 0; q < 4; ++q) {
            const int r = base + 4 * q, sidx = (r - NP) >> 2;
            float e0[WIN - 1 + 4], e1[WIN - 1 + 4];
#pragma unroll
            for (int e = 0; e < WIN - 1; ++e) { const f32x2 v = *(const f32x2*)(sp + ((size_t)sidx * 15 + (15 - (WIN - 1)) + e) * 512 + ch); e0[e] = v[0]; e1[e] = v[1]; }
#pragma unroll
            for (int i = 0; i < 4; ++i) { const unsigned v = *(const unsigned*)(UPb + (size_t)(r + i) * 512 + ch); e0[WIN - 1 + i] = bf_lo(v); e1[WIN - 1 + i] = bf_hi(v); }
            float s0 = 0.f, s1 = 0.f;
#pragma unroll
            for (int e = 0; e < WIN - 1; ++e) { s0 += e0[e]; s1 += e1[e]; }
#pragma unroll
            for (int i = 0; i < 4; ++i) {
                const float c0 = e0[WIN - 1 + i], c1 = e1[WIN - 1 + i];
                s0 += c0; s1 += c1;
                *(unsigned*)(A + (16 * seg + 4 * q + i) * PA_PITCH + 2 * cp) = cvt_pk_bf16(s0 * rw - c0, s1 * rw - c1);
                s0 -= e0[i]; s1 -= e1[i];
            }
        }
    }
}
template <int KG> __device__ __forceinline__ void pool_fill2(const Params& p, int r0a, int r0b, bf16_t* A, int tid) {
    constexpr int WIN = 2 << KG, NR = WIN - 1 + 16;
    const bf16_t* UPb = (const bf16_t*)(p.ws + WS_UP);
    const int cp = tid & 63, seg = tid >> 6, ch = 128 * KG + 2 * cp;
    constexpr float rw = 1.0f / (float)WIN;
    unsigned raw[2][NR];
#pragma unroll
    for (int h = 0; h < 2; ++h) { const int base = (h ? r0b : r0a) + 16 * seg, t0 = base & 2047;
#pragma unroll
        for (int e = 0; e < NR; ++e) { const int rel = e - (WIN - 1); raw[h][e] = (t0 + rel >= 0) ? *(const unsigned*)(UPb + (size_t)(base + rel) * 512 + ch) : 0u; } }
#pragma unroll
    for (int h = 0; h < 2; ++h) { const int base = (h ? r0b : r0a) + 16 * seg, t0 = base & 2047;
        float s0 = 0.f, s1 = 0.f;
#pragma unroll
        for (int e = 0; e < WIN - 1; ++e) { s0 += bf_lo(raw[h][e]); s1 += bf_hi(raw[h][e]); }
#pragma unroll
        for (int i = 0; i < 16; ++i) {
            const int t = t0 + i; const float c0 = bf_lo(raw[h][WIN - 1 + i]), c1 = bf_hi(raw[h][WIN - 1 + i]);
            s0 += c0; s1 += c1;
            const float rc = (t + 1 < WIN) ? 1.0f / (float)(t + 1) : rw;
            *(unsigned*)(A + (h * 128 + 16 * seg + i) * PA_PITCH + 2 * cp) = cvt_pk_bf16(s0 * rc - c0, s1 * rc - c1);
            s0 -= bf_lo(raw[h][i]); s1 -= bf_hi(raw[h][i]);
        }
    }
}
__device__ __forceinline__ void pool_pair(const Params& p, int rt, int k, unsigned char* lds, int tid) {
    const int lane = tid & 63, w8 = tid >> 6, lr = lane & 15, lq = lane >> 4;
    bf16_t* A = (bf16_t*)lds;
    const bf16_t* Wb = (const bf16_t*)(p.ws + WS_WPOOL) + ((size_t)k * 256 + 32 * w8 + lr) * 128 + 8 * lq;
    bf16x8 b0[4], b1[4];
#pragma unroll
    for (int ks = 0; ks < 4; ++ks) { b0[ks] = *(const bf16x8*)(Wb + 32 * ks); b1[ks] = *(const bf16x8*)(Wb + 16 * 128 + 32 * ks); }
    const int colb = k * 256 + 32 * w8 + 4 * lq;
    const f32x4 ps0 = *(const f32x4*)(p.in[23] + colb), ps1 = *(const f32x4*)(p.in[23] + colb + 16);
    const int r0a = rt * 128, r0b = (rt + 64) * 128;
    if (k == 0) pool_fill2<0>(p, r0a, r0b, A, tid); else if (k == 1) pool_fill2<1>(p, r0a, r0b, A, tid); else if (k == 2) pool_fill2<2>(p, r0a, r0b, A, tid); else pool_fill2<3>(p, r0a, r0b, A, tid);
    const bf16_t* SGP = (const bf16_t*)(p.ws + WS_SGP); bf16_t* ZS = (bf16_t*)(p.ws + WS_ZS);
    __syncthreads();
#pragma unroll 1
    for (int h = 0; h < 2; ++h) {
        const int r0 = h ? r0b : r0a;
        u32x2 sg[8][2];
#pragma unroll
        for (int mt = 0; mt < 8; ++mt) { const size_t off = (size_t)(r0 + 16 * mt + lr) * 1024 + colb; sg[mt][0] = *(const u32x2*)(SGP + off); sg[mt][1] = *(const u32x2*)(SGP + off + 16); }
        f32x4 acc[8][2];
#pragma unroll
        for (int i = 0; i < 8; ++i) { acc[i][0] = (f32x4){0.f, 0.f, 0.f, 0.f}; acc[i][1] = (f32x4){0.f, 0.f, 0.f, 0.f}; }
#pragma unroll
        for (int ks = 0; ks < 4; ++ks) {
#pragma unroll
            for (int mt = 0; mt < 8; ++mt) { const bf16x8 af = *(const bf16x8*)(A + (h * 128 + 16 * mt + lr) * PA_PITCH + 32 * ks + 8 * lq);
                acc[mt][0] = MFMA16(b0[ks], af, acc[mt][0]); acc[mt][1] = MFMA16(b1[ks], af, acc[mt][1]); }
            __builtin_amdgcn_sched_barrier(0);
        }
#pragma unroll
        for (int mt = 0; mt < 8; ++mt) {
            const size_t off = (size_t)(r0 + 16 * mt + lr) * 1024 + colb;
            const f32x4 z0 = acc[mt][0], z1 = acc[mt][1];
            u32x2 o; o.x = cvt_pk_bf16(z0[0] * ps0[0] * bf_lo(sg[mt][0].x), z0[1] * ps0[1] * bf_hi(sg[mt][0].x)); o.y = cvt_pk_bf16(z0[2] * ps0[2] * bf_lo(sg[mt][0].y), z0[3] * ps0[3] * bf_hi(sg[mt][0].y));
            *(u32x2*)(ZS + off) = o;
            o.x = cvt_pk_bf16(z1[0] * ps1[0] * bf_lo(sg[mt][1].x), z1[1] * ps1[1] * bf_hi(sg[mt][1].x)); o.y = cvt_pk_bf16(z1[2] * ps1[2] * bf_lo(sg[mt][1].y), z1[3] * ps1[3] * bf_hi(sg[mt][1].y));
            *(u32x2*)(ZS + off + 16) = o;
        }
    }
    __syncthreads();
}
template <int MT> __device__ __forceinline__ void pool_unit(const Params& p, int r0, int k, unsigned char* lds, int tid) {
    const int lane = tid & 63, w8 = tid >> 6, lr = lane & 15, lq = lane >> 4;
    bf16_t* A = (bf16_t*)lds;
    const bf16_t* Wb = (const bf16_t*)(p.ws + WS_WPOOL) + ((size_t)k * 256 + 32 * w8 + lr) * 128 + 8 * lq;
    bf16x8 b0[4], b1[4];
#pragma unroll
    for (int ks = 0; ks < 4; ++ks) { b0[ks] = *(const bf16x8*)(Wb + 32 * ks); b1[ks] = *(const bf16x8*)(Wb + 16 * 128 + 32 * ks); }
    if (k == 0) pool_fill<0>(p, r0, A, tid, MT); else if (k == 1) pool_fill<1>(p, r0, A, tid, MT); else if (k == 2) pool_fill<2>(p, r0, A, tid, MT); else pool_fill<3>(p, r0, A, tid, MT);
    __syncthreads();
    f32x4 acc[MT][2];
#pragma unroll
    for (int i = 0; i < MT; ++i) { acc[i][0] = (f32x4){0.f, 0.f, 0.f, 0.f}; acc[i][1] = (f32x4){0.f, 0.f, 0.f, 0.f}; }
#pragma unroll
    for (int ks = 0; ks < 4; ++ks) {
#pragma unroll
        for (int mt = 0; mt < MT; ++mt) { const bf16x8 af = *(const bf16x8*)(A + (16 * mt + lr) * PA_PITCH + 32 * ks + 8 * lq);
            acc[mt][0] = MFMA16(b0[ks], af, acc[mt][0]); acc[mt][1] = MFMA16(b1[ks], af, acc[mt][1]); }
    }
    const bf16_t* SGP = (const bf16_t*)(p.ws + WS_SGP); bf16_t* ZS = (bf16_t*)(p.ws + WS_ZS);
#pragma unroll
    for (int nt = 0; nt < 2; ++nt) {
        const int col = k * 256 + 32 * w8 + 16 * nt + 4 * lq;
        const f32x4 ps = *(const f32x4*)(p.in[23] + col);
#pragma unroll
        for (int mt = 0; mt < MT; ++mt) {
            const size_t off = (size_t)(r0 + 16 * mt + lr) * 1024 + col;
            const u32x2 sg = *(const u32x2*)(SGP + off); const f32x4 z = acc[mt][nt];
            u32x2 o; o.x = cvt_pk_bf16(z[0] * ps[0] * bf_lo(sg.x), z[1] * ps[1] * bf_hi(sg.x)); o.y = cvt_pk_bf16(z[2] * ps[2] * bf_lo(sg.y), z[3] * ps[3] * bf_hi(sg.y));
            *(u32x2*)(ZS + off) = o;
        }
    }
    __syncthreads();
}

template <int NT> __device__ __forceinline__ void skinny_unit(const bf16_t* A, int lda, const bf16_t* Bt, int ldb, int K, int arow0, const int (&brow)[NT], unsigned char* lds, int tid) {
    const int lane = tid & 63, w = tid >> 6, lr = lane & 15, lq = lane >> 4, kper = K >> 3, k0 = w * kper;
    constexpr int TW = 16 * NT;
    float* red = (float*)lds;
    f32x4 acc[4][NT];
#pragma unroll
    for (int i = 0; i < 4; ++i)
#pragma unroll
        for (int n = 0; n < NT; ++n) acc[i][n] = (f32x4){0.f, 0.f, 0.f, 0.f};
    const bf16_t* Ap = A + (size_t)(arow0 + lr) * lda + k0 + 8 * lq;
    const bf16_t* Bp[NT];
#pragma unroll
    for (int n = 0; n < NT; ++n) Bp[n] = Bt + (size_t)(brow[n] + lr) * ldb + k0 + 8 * lq;
    const int nks = kper >> 5;
    int ks = 0;
    for (; ks + 2 <= nks; ks += 2) {
        bf16x8 bf[2][NT], af[2][4];
#pragma unroll
        for (int u = 0; u < 2; ++u) {
#pragma unroll
            for (int n = 0; n < NT; ++n) bf[u][n] = *(const bf16x8*)(Bp[n] + 32 * (ks + u));
#pragma unroll
            for (int mt = 0; mt < 4; ++mt) af[u][mt] = *(const bf16x8*)(Ap + (size_t)(16 * mt) * lda + 32 * (ks + u)); }
#pragma unroll
        for (int u = 0; u < 2; ++u)
#pragma unroll
            for (int mt = 0; mt < 4; ++mt)
#pragma unroll
                for (int n = 0; n < NT; ++n) acc[mt][n] = MFMA16(bf[u][n], af[u][mt], acc[mt][n]);
    }
    for (; ks < nks; ++ks) {
        bf16x8 bf[NT];
#pragma unroll
        for (int n = 0; n < NT; ++n) bf[n] = *(const bf16x8*)(Bp[n] + 32 * ks);
#pragma unroll
        for (int mt = 0; mt < 4; ++mt) { const bf16x8 af = *(const bf16x8*)(Ap + (size_t)(16 * mt) * lda + 32 * ks);
#pragma unroll
            for (int n = 0; n < NT; ++n) acc[mt][n] = MFMA16(bf[n], af, acc[mt][n]); }
    }
#pragma unroll
    for (int mt = 0; mt < 4; ++mt)
#pragma unroll
        for (int n = 0; n < NT; ++n) *(f32x4*)(red + ((size_t)(w * 64 + 16 * mt + lr)) * TW + 16 * n + 4 * lq) = acc[mt][n];
    __syncthreads();
#pragma unroll
    for (int q = 0; q < NT / 2; ++q) {
        const int o = (q * 512 + tid) * 4;
        f32x4 s = *(const f32x4*)(red + o);
#pragma unroll
        for (int v = 1; v < 8; ++v) s += *(const f32x4*)(red + v * 64 * TW + o);
        *(f32x4*)(red + o) = s;
    }
    __syncthreads();
}
__device__ __forceinline__ void skinny_wide96(const bf16_t* A, const bf16_t* Bt, int arow0, int bcol0, unsigned char* lds, int tid) {
    const int lane = tid & 63, w = tid >> 6, lr = lane & 15, lq = lane >> 4, kq = w & 3, mh = w >> 2, k0 = kq * 256;
    float* red = (float*)lds;
    f32x4 acc[2][6];
#pragma unroll
    for (int i = 0; i < 2; ++i)
#pragma unroll
        for (int n = 0; n < 6; ++n) acc[i][n] = (f32x4){0.f, 0.f, 0.f, 0.f};
    const bf16_t* Ap = A + (size_t)(arow0 + 32 * mh + lr) * 1024 + k0 + 8 * lq;
    const bf16_t* Bp = Bt + (size_t)(bcol0 + lr) * 1024 + k0 + 8 * lq;
#pragma unroll 1
    for (int ks = 0; ks < 8; ks += 2) {
        bf16x8 bf[2][6], af[2][2];
#pragma unroll
        for (int u = 0; u < 2; ++u) {
#pragma unroll
            for (int n = 0; n < 6; ++n) bf[u][n] = *(const bf16x8*)(Bp + (size_t)(16 * n) * 1024 + 32 * (ks + u));
#pragma unroll
            for (int mt = 0; mt < 2; ++mt) af[u][mt] = *(const bf16x8*)(Ap + (size_t)(16 * mt) * 1024 + 32 * (ks + u)); }
#pragma unroll
        for (int u = 0; u < 2; ++u)
#pragma unroll
            for (int mt = 0; mt < 2; ++mt)
#pragma unroll
                for (int n = 0; n < 6; ++n) acc[mt][n] = MFMA16(bf[u][n], af[u][mt], acc[mt][n]);
    }
#pragma unroll
    for (int mt = 0; mt < 2; ++mt)
#pragma unroll
        for (int n = 0; n < 6; ++n) *(f32x4*)(red + ((size_t)(kq * 64 + 32 * mh + 16 * mt + lr)) * 96 + 16 * n + 4 * lq) = acc[mt][n];
    __syncthreads();
#pragma unroll
    for (int q = 0; q < 3; ++q) {
        const int o = (q * 512 + tid) * 4;
        const f32x4 s = (*(const f32x4*)(red + o) + *(const f32x4*)(red + 6144 + o)) + (*(const f32x4*)(red + 2 * 6144 + o) + *(const f32x4*)(red + 3 * 6144 + o));
        *(f32x4*)(red + o) = s;
    }
    __syncthreads();
}
#define LAS __attribute__((address_space(3)))
#define XB_TMO      128
#define XB_XCNT(j)  (256  + 64 * (j))
#define XB_XSUB(j)  (1280 + 64 * (j))
#define XB_XGEN(j)  (2304 + 64 * (j))
#define XB_TOP      3328
#define XB_TOPGEN   3392
#define XCD_BAR_WORDS 3456
#define XB_SPIN_CAP (1u << 18)

__device__ __forceinline__ unsigned xb_ld(unsigned* p)              { return __hip_atomic_load(p, __ATOMIC_RELAXED, __HIP_MEMORY_SCOPE_AGENT); }
__device__ __forceinline__ unsigned xb_add(unsigned* p, unsigned v) { return __hip_atomic_fetch_add(p, v, __ATOMIC_RELAXED, __HIP_MEMORY_SCOPE_AGENT); }
__device__ __forceinline__ unsigned xb_xcc_id() { return (unsigned)__builtin_amdgcn_s_getreg((3 << 11) | 20) & 0xFu; }
#define XB_SPIN(cond, bar) do { unsigned _sp = 0; while (cond) { __builtin_amdgcn_s_sleep(1); \
    if ((++_sp & 255u) == 0u) { if (xb_ld(&(bar)[XB_TMO])) break; if (_sp > XB_SPIN_CAP) { atomicAdd(&(bar)[XB_TMO], 1u); break; } } } } while (0)

struct XcdBarrier {
    unsigned* bar; unsigned x;
    volatile LAS unsigned* st;
};

__device__ __forceinline__ XcdBarrier xcd_barrier_post(unsigned* bar, volatile LAS unsigned* st) {
    XcdBarrier b; b.bar = bar; b.x = xb_xcc_id(); b.st = st;
    if (threadIdx.x == 0) (void)xb_add(&bar[XB_XCNT(b.x)], 1u);
    return b;
}
__device__ __forceinline__ void xcd_barrier_complete(unsigned* bar, unsigned x, unsigned& nloc, unsigned& nx) {
    const unsigned G = gridDim.x * gridDim.y * gridDim.z;
    unsigned sum, cnt, mine, sp = 0u;
    for (;;) {
        sum = 0u; cnt = 0u; mine = 0u;
#pragma unroll
        for (unsigned j = 0; j < 16; ++j) { const unsigned c = xb_ld(&bar[XB_XCNT(j)]); sum += c; cnt += (c > 0u) ? 1u : 0u; mine = (j == x) ? c : mine; }
        if (sum == G) break;
        __builtin_amdgcn_s_sleep(1);
        if ((++sp & 255u) == 0u) { if (xb_ld(&bar[XB_TMO])) break; if (sp > XB_SPIN_CAP) { atomicAdd(&bar[XB_TMO], 1u); break; } }
    }
    nloc = mine > 0u ? mine : 1u; nx = cnt > 0u ? cnt : 1u;
}

__device__ __forceinline__ void xcd_barrier(const XcdBarrier& b) {
    asm volatile("s_waitcnt vmcnt(0)" ::: "memory");
    __syncthreads();
    if (threadIdx.x == 0) {
        unsigned* bar = b.bar;
        __builtin_amdgcn_s_waitcnt(0);
        unsigned nloc = b.st[0], nx = b.st[1];
        if (nloc == 0u) { xcd_barrier_complete(bar, b.x, nloc, nx); b.st[0] = nloc; b.st[1] = nx; }
        const unsigned old = xb_add(&bar[XB_XSUB(b.x)], 1u);
        const unsigned gen = old / nloc;
        if (old + 1u == (gen + 1u) * nloc) {
            __builtin_amdgcn_fence(__ATOMIC_RELEASE, "agent");
            asm volatile("s_waitcnt vmcnt(0)" ::: "memory");
            const unsigned og = xb_add(&bar[XB_TOP], 1u);
            const unsigned tg = og / nx;
            if (og + 1u == (tg + 1u) * nx) xb_add(&bar[XB_TOPGEN], 1u);
            else XB_SPIN(xb_ld(&bar[XB_TOPGEN]) == tg, bar);
            __builtin_amdgcn_fence(__ATOMIC_ACQUIRE, "agent");
            xb_add(&bar[XB_XGEN(b.x)], 1u);
            asm volatile("s_waitcnt vmcnt(0)" ::: "memory");
        } else {
            XB_SPIN(xb_ld(&bar[XB_XGEN(b.x)]) == gen, bar);
            __builtin_amdgcn_fence(__ATOMIC_ACQUIRE, "agent");
            asm volatile("s_waitcnt vmcnt(0)" ::: "memory");
        }
    }
    __syncthreads();
}

constexpr int MISC_OFF = LDS_BYTES - 64;
constexpr size_t WS_BAR = 0;
#ifndef PG_ALIGN
#define PG_ALIGN true
#endif
#ifndef PG_SP2
#define PG_SP2 true
#endif
#ifndef REP3A
#define REP3A 1
#endif
#ifndef REP3B
#define REP3B 1
#endif
#ifndef REP3C
#define REP3C 1
#endif
#ifndef REP0
#define REP0 1
#endif
#ifndef REP1
#define REP1 1
#endif
#ifndef REP2
#define REP2 1
#endif
#ifndef REP3
#define REP3 1
#endif
#ifndef REP4
#define REP4 1
#endif
#ifndef REP5
#define REP5 1
#endif
#ifndef REP6
#define REP6 1
#endif
#ifndef REP7
#define REP7 1
#endif
#ifndef REP8
#define REP8 1
#endif
#ifndef REP9
#define REP9 1
#endif
__global__ void __launch_bounds__(512, 2) mk_fwd(Params p) {
    extern __shared__ __attribute__((aligned(16))) unsigned char lds[];
    cg::grid_group grid = cg::this_grid();
    const int tid = threadIdx.x, lane = tid & 63, wave = __builtin_amdgcn_readfirstlane(tid >> 6), G = gridDim.x, bid = blockIdx.x;
    const int gw = bid * 8 + wave, NGW = G * 8;
    PG8_LAS unsigned char* ldsg = (PG8_LAS unsigned char*)lds;
    float* mod = (float*)(p.ws + WS_MOD);
    float* out = p.out;
    if (tid < 16) ((volatile LAS unsigned*)(ldsg + MISC_OFF))[tid] = 0u;
    __syncthreads();
    XcdBarrier xbar = xcd_barrier_post((unsigned*)(p.ws + WS_BAR), (volatile LAS unsigned*)(ldsg + MISC_OFF));
    if (p.ph_hi > 1000) grid.sync();
#define IN(k) (p.ph_lo <= (k) && (k) < p.ph_hi)
#define GSYNC() xcd_barrier(xbar)
#define SEAM(k) do { if (IN(k) && IN((k) + 1)) GSYNC(); } while (0)

#ifdef EXTRA_SYNCS
    for (int i_ = 0; i_ < EXTRA_SYNCS; ++i_) GSYNC();
#endif
    if (IN(0)) for (int rep_ = 0; rep_ < REP0; ++rep_) { if (rep_) GSYNC();
        for (int u = bid; u < 192; u += G) ada_unit(p, u, lds, tid);
        float* scr = (float*)lds + wave * (64 * 33);
        {
            const bool freeblk = bid >= 192;
            for (int i = 0; i < (freeblk ? 2 : 1); ++i) {
                int r = freeblk ? i * 512 + (gw - 1536) : 1024 + gw;
                if (r < TR_ITEMS[0]) tr_item(p, 0, r, scr, lane);
                else if ((r -= TR_ITEMS[0]) < TR_ITEMS[1]) tr_item(p, 1, r, scr, lane);
                else if ((r -= TR_ITEMS[1]) < TR_ITEMS[5]) tr_item(p, 5, r, scr, lane);
            }
        }
        {
            float* spool = out + (size_t)NTOK * DM + 16384 + 16384 + 61440 + 262144 + 262144;
            const float* sp = p.in[6];
            for (int i = bid * 512 + tid; i < 128 * 11 * 128; i += G * 512) { const int s = i / (11 * 128), q = i % (11 * 128);
                *(f32x4*)(spool + (size_t)s * 15 * 512 + 4 * q) = *(const f32x4*)(sp + (size_t)s * 15 * 512 + 4 * 512 + 4 * q); }
        }
    }
    SEAM(0);
    if (IN(1)) for (int rep_ = 0; rep_ < REP1; ++rep_) { if (rep_) GSYNC(); for (int u = bid; u < 96; u += G) ssm_prep_unit(p, u / 3, u % 3, lds, tid); modnorm_rows<false>(p.in[0], p.in[1], p.in[7], mod, 0, 1, (bf16_t*)(p.ws + WS_H), bid < 96 ? 44 * bid : 4224 + 80 * (bid - 96), bid < 96 ? 44 * bid + 44 : (4224 + 80 * (bid - 95) < NTOK ? 4224 + 80 * (bid - 95) : NTOK), wave, lane); }
    SEAM(1);
    if (IN(2)) for (int rep_ = 0; rep_ < REP2; ++rep_) { if (rep_) GSYNC();
        pg8::Gemm g{(const bf16_t*)(p.ws + WS_H), (const bf16_t*)(p.ws + WS_WIN), NP, 3072, 1024}; pg8::StaticOrder S; S.init(NP, 3072, G, bid);
        EpiG1 E{(bf16_t*)(p.ws + WS_US), (bf16_t*)(p.ws + WS_UP), (bf16_t*)(p.ws + WS_SGS), (bf16_t*)(p.ws + WS_SGP),
                out + (size_t)NTOK * DM + 32768, out + (size_t)NTOK * DM + 32768 + 61440 + 524288};
        pg8::gemm_phase<EpiG1, pg8::StaticOrder, PG_ALIGN, PG_SP2>(ldsg, g, S, E);
#ifdef DUP2
        GSYNC(); pg8::gemm_phase<EpiG1, pg8::StaticOrder, PG_ALIGN, PG_SP2>(ldsg, g, S, E);
#endif
        for (int u = bid; u < 256; u += G) {
            const int rt = u >> 5, ct = u & 31;
            skinny_wide96((const bf16_t*)(p.ws + WS_H), (const bf16_t*)(p.ws + WS_WIN), NP + 64 * rt, 96 * ct, lds, tid);
            for (int e8 = tid; e8 < 768; e8 += 512) {
                const int row = e8 / 12, c8 = (e8 % 12) * 8, col = 96 * ct + c8;
                const float* tp = (const float*)lds + row * 96 + c8;
                E.emit(NP + 64 * rt + row, col, col >> 8, *(const f32x4*)tp, *(const f32x4*)(tp + 4));
            }
            __syncthreads();
        }
    }
    SEAM(2);
    if (IN(3)) for (int rep_ = 0; rep_ < REP3; ++rep_) { if (rep_) GSYNC();
        for (int ra_ = 0; ra_ < REP3A; ++ra_) for (int u = bid; u < 256; u += G) {
            int ub = u >> 5, ug = u & 31;
            if (G == 256) { const int x = u & 7, y = u >> 3, quad = x + 8 * (y >> 2); ub = quad >> 3; ug = 4 * (quad & 7) + (y & 3); }
            ssm_block(p, ub, ug, lds, tid); }
        for (int rb_ = 0; rb_ < REP3B; ++rb_) { for (int u = bid; u < 256; u += G) pool_pair(p, u >> 2, u & 3, lds, tid); for (int u = G - 1 - bid; u < 64; u += G) pool_unit<2>(p, NP + 32 * (u >> 2), u & 3, lds, tid); }
        for (int rc_ = 0; rc_ < REP3C; ++rc_) for (int it = gw; it < 64 * 32; it += NGW) ssm_sample_pair(p, it >> 5, 64 + (it >> 5), it & 31, lane);
        {
            float* scr = (float*)lds + wave * (64 * 33);
            for (int it = gw; it < TR_ITEMS[2] + TR_ITEMS[3]; it += NGW) { if (it < TR_ITEMS[2]) tr_item(p, 2, it, scr, lane); else tr_item(p, 3, it - TR_ITEMS[2], scr, lane); }
        }
    }
    SEAM(3);
    if (IN(4)) for (int rep_ = 0; rep_ < REP4; ++rep_) { if (rep_) GSYNC();
        pg8::Gemm g{(const bf16_t*)(p.ws + WS_GY), (const bf16_t*)(p.ws + WS_WGLU), NP, 2048, 512}; pg8::StaticOrder S; S.init(NP, 2048, G, bid);
        EpiGLU E{(const bf16_t*)(p.ws + WS_SGS), (const bf16_t*)(p.ws + WS_ZS), (bf16_t*)(p.ws + WS_H)};
        pg8::gemm_phase<EpiGLU, pg8::StaticOrder, PG_ALIGN, PG_SP2>(ldsg, g, S, E);
        for (int u = bid; u < 256; u += G) {
            const int rt = u >> 5, jt = u & 31, j0 = 32 * jt, ra = 256 * (j0 >> 7) + (j0 & 127);
            const int br_[4] = {ra, ra + 16, ra + 128, ra + 144};
            skinny_unit<4>((const bf16_t*)(p.ws + WS_GY), 512, (const bf16_t*)(p.ws + WS_WGLU), 512, 512, NP + 64 * rt, br_, lds, tid);
            const float* tp = (const float*)lds + (tid >> 3) * 64 + (tid & 7) * 4;
            const f32x4 a = *(const f32x4*)tp, b = *(const f32x4*)(tp + 32);
            const size_t off = (size_t)(NP + 64 * rt + (tid >> 3)) * 1024 + j0 + (tid & 7) * 4;
            const u32x2 sg = *(const u32x2*)(E.SGS + off), zs = *(const u32x2*)(E.ZS + off);
            u32x2 o;
            o.x = cvt_pk_bf16(bf_lo(sg.x) * a[0] * fsigmoid(b[0]) + bf_lo(zs.x), bf_hi(sg.x) * a[1] * fsigmoid(b[1]) + bf_hi(zs.x));
            o.y = cvt_pk_bf16(bf_lo(sg.y) * a[2] * fsigmoid(b[2]) + bf_lo(zs.y), bf_hi(sg.y) * a[3] * fsigmoid(b[3]) + bf_hi(zs.y));
            *(u32x2*)(E.MGD + off) = o;
            __syncthreads();
        }
    }
    SEAM(4);
    if (IN(5)) for (int rep_ = 0; rep_ < REP5; ++rep_) { if (rep_) GSYNC();
        pg8::Gemm g{(const bf16_t*)(p.ws + WS_H), (const bf16_t*)(p.ws + WS_WOUT), NP, 1024, 1024}; pg8::StaticOrder S; S.init(NP, 1024, G, bid);
        EpiRes<0> E{p.in[0], nullptr, mod + 2 * DM, (bf16_t*)(p.ws + WS_XB)};
        pg8::gemm_phase<EpiRes<0>, pg8::StaticOrder, PG_ALIGN, PG_SP2>(ldsg, g, S, E);
        for (int u = bid; u < 256; u += G) {
            const int rt = u >> 5, ct = u & 31;
            const int br_[2] = {32 * ct, 32 * ct + 16};
            skinny_unit<2>((const bf16_t*)(p.ws + WS_H), 1024, (const bf16_t*)(p.ws + WS_WOUT), 1024, 1024, NP + 64 * rt, br_, lds, tid);
            const int row = 64 * rt + (tid >> 3), col = 32 * ct + 4 * (tid & 7), r = NP + row;
            const f32x4 a = *(const f32x4*)((const float*)lds + tid * 4);
            const f32x4 x = *(const f32x4*)(p.in[1] + (size_t)row * DM + col), gt = *(const f32x4*)(mod + (size_t)mrow(r) * 6144 + 2 * DM + col);
            { const f32x4 v = x + gt * a; u32x2 wv; wv.x = cvt_pk_bf16(v[0], v[1]); wv.y = cvt_pk_bf16(v[2], v[3]); *(u32x2*)((bf16_t*)(p.ws + WS_XB) + (size_t)r * DM + col) = wv; }
            __syncthreads();
        }
    }
    SEAM(5);
    if (IN(6)) for (int rep_ = 0; rep_ < REP6; ++rep_) { if (rep_) GSYNC(); modnorm_rows<true>((const float*)(p.ws + WS_XB), nullptr, p.in[8], mod, 3, 4, (bf16_t*)(p.ws + WS_H), 66 * bid, 66 * bid + 66, wave, lane); }
    SEAM(6);
    if (IN(7)) for (int rep_ = 0; rep_ < REP7; ++rep_) { if (rep_) GSYNC();
        pg8::Gemm g{(const bf16_t*)(p.ws + WS_H), (const bf16_t*)(p.ws + WS_WFI), NTOK, 2 * DFF, 1024}; pg8::StaticOrder S; S.init(NTOK, 2 * DFF, G, bid);
        EpiSwiGLU E{(bf16_t*)(p.ws + WS_ACT)};
        pg8::gemm_phase<EpiSwiGLU, pg8::StaticOrder, PG_ALIGN, PG_SP2>(ldsg, g, S, E);
#ifdef DUP7
        GSYNC(); pg8::gemm_phase<EpiSwiGLU, pg8::StaticOrder, PG_ALIGN, PG_SP2>(ldsg, g, S, E);
#endif
        {
            const int nun = (NTOK / 256) * (2 * DFF / 256), full = nun / G, rem = nun % G;
            if (rem != 0 && bid >= rem) { float* scr = (float*)lds + wave * (64 * 33); const int nidle = (G - rem) * 8;
                for (int it = (bid - rem) * 8 + wave; it < TR_ITEMS[4]; it += nidle) tr_item(p, 4, it, scr, lane); }
            else if (rem == 0) { float* scr = (float*)lds + wave * (64 * 33); for (int it = gw; it < TR_ITEMS[4]; it += NGW) tr_item(p, 4, it, scr, lane); }
            (void)full;
        }
    }
    SEAM(7);
    if (IN(8)) for (int rep_ = 0; rep_ < REP8; ++rep_) { if (rep_) GSYNC();
        pg8::Gemm g{(const bf16_t*)(p.ws + WS_ACT), (const bf16_t*)(p.ws + WS_WFO), NP, 1024, DFF}; pg8::StaticOrder S; S.init(NP, 1024, G, bid);
        EpiRes<1> E{nullptr, (const bf16_t*)(p.ws + WS_XB), mod + 5 * DM, (bf16_t*)(p.ws + WS_H)};
        pg8::gemm_phase<EpiRes<1>, pg8::StaticOrder, PG_ALIGN, PG_SP2>(ldsg, g, S, E);
#ifdef DUP8
        GSYNC(); pg8::gemm_phase<EpiRes<1>, pg8::StaticOrder, PG_ALIGN, PG_SP2>(ldsg, g, S, E);
#endif
        for (int u = bid; u < 256; u += G) {
            const int rt = u >> 5, ct = u & 31;
            const int br_[2] = {32 * ct, 32 * ct + 16};
            skinny_unit<2>((const bf16_t*)(p.ws + WS_ACT), DFF, (const bf16_t*)(p.ws + WS_WFO), DFF, DFF, NP + 64 * rt, br_, lds, tid);
            const int row = 64 * rt + (tid >> 3), col = 32 * ct + 4 * (tid & 7), r = NP + row;
            const f32x4 a = *(const f32x4*)((const float*)lds + tid * 4);
            const u32x2 xq = *(const u32x2*)((const bf16_t*)(p.ws + WS_XB) + (size_t)r * DM + col);
            const f32x4 x = (f32x4){bf_lo(xq.x), bf_hi(xq.x), bf_lo(xq.y), bf_hi(xq.y)}, gt = *(const f32x4*)(mod + (size_t)mrow(r) * 6144 + 5 * DM + col);
            { const f32x4 v = x + gt * a; u32x2 wv; wv.x = cvt_pk_bf16(v[0], v[1]); wv.y = cvt_pk_bf16(v[2], v[3]); *(u32x2*)((bf16_t*)(p.ws + WS_H) + (size_t)r * DM + col) = wv; }
            __syncthreads();
        }
    }
    SEAM(8);
    if (IN(9)) for (int rep_ = 0; rep_ < REP9; ++rep_) { if (rep_) GSYNC();
        const float* gf = p.in[9];
        f32x4 gg[4];
#pragma unroll
        for (int j = 0; j < 4; ++j) gg[j] = *(const f32x4*)(gf + 4 * lane + 256 * j);
        for (int r0 = gw; r0 < NTOK; r0 += 2 * NGW) {
            const int rr[2] = {r0, (r0 + NGW < NTOK) ? r0 + NGW : r0};
            f32x4 v[2][4]; float s[2];
#pragma unroll
            for (int h = 0; h < 2; ++h) { const bf16_t* xbr = (const bf16_t*)(p.ws + WS_H) + (size_t)rr[h] * DM + 4 * lane;
#pragma unroll
                for (int j = 0; j < 4; ++j) { const u32x2 q = *(const u32x2*)(xbr + 256 * j); v[h][j] = (f32x4){bf_lo(q.x), bf_hi(q.x), bf_lo(q.y), bf_hi(q.y)}; } }
#pragma unroll
            for (int h = 0; h < 2; ++h) { s[h] = 0.f;
#pragma unroll
                for (int j = 0; j < 4; ++j) s[h] += (v[h][j][0] * v[h][j][0] + v[h][j][1] * v[h][j][1]) + (v[h][j][2] * v[h][j][2] + v[h][j][3] * v[h][j][3]); }
#pragma unroll
            for (int o = 1; o < 64; o <<= 1) { s[0] += __shfl_xor(s[0], o); s[1] += __shfl_xor(s[1], o); }
#pragma unroll
            for (int h = 0; h < 2; ++h) if (h == 0 || rr[1] != rr[0]) {
                const float inv = rsqrtf(s[h] * (1.0f / DM) + EPS); float* xr = out + (size_t)rr[h] * DM + 4 * lane;
#pragma unroll
                for (int j = 0; j < 4; ++j) *(f32x4*)(xr + 256 * j) = (v[h][j] * inv) * gg[j];
            }
        }
    }
#undef IN
#undef SEAM
}

#ifndef MK_N_LAUNCHES
#define MK_N_LAUNCHES 1
#endif
extern "C" void kernel_launch(void* const* d_in, const int* in_sizes, int n_in, void* d_out, int out_size, void* d_ws, size_t ws_size, hipStream_t stream) {
    static int grid = 0;
    if (grid == 0) {
        int dev = 0, cus = 0, per_cu = 0;
        if (hipGetDevice(&dev) != hipSuccess || hipDeviceGetAttribute(&cus, hipDeviceAttributeMultiprocessorCount, dev) != hipSuccess) { fprintf(stderr, "kernel_launch: device query failed\n"); grid = -1; return; }
        if (hipFuncSetAttribute((const void*)mk_fwd, hipFuncAttributeMaxDynamicSharedMemorySize, LDS_BYTES) != hipSuccess) { fprintf(stderr, "kernel_launch: hipFuncSetAttribute failed\n"); grid = -1; return; }
        if (hipOccupancyMaxActiveBlocksPerMultiprocessor(&per_cu, (const void*)mk_fwd, 512, LDS_BYTES) != hipSuccess || per_cu < 1) { fprintf(stderr, "kernel_launch: occupancy query says %d blocks/CU\n", per_cu); (void)hipGetLastError(); grid = -1; return; }
        grid = cus * per_cu;
        if (n_in != 27 || ws_size < 232 * MiB) { fprintf(stderr, "kernel_launch: unexpected n_in %d / ws %zu\n", n_in, ws_size); grid = -1; return; }
    }
    if (grid < 0) return;
    if (hipMemsetAsync((char*)d_ws + WS_BAR, 0, 32768, stream) != hipSuccess) { fprintf(stderr, "kernel_launch: memset failed\n"); return; }
    Params p{};
    for (int i = 0; i < 27; ++i) p.in[i] = (const float*)d_in[i];
    p.out = (float*)d_out; p.ws = (unsigned char*)d_ws;
#if MK_N_LAUNCHES == 1
    p.ph_lo = 0; p.ph_hi = 10;
    void* args[] = {&p};
    hipError_t e = hipLaunchCooperativeKernel((const void*)mk_fwd, dim3(grid), dim3(512), args, LDS_BYTES, stream);
    if (e != hipSuccess) fprintf(stderr, "kernel_launch: cooperative launch failed: %s (grid %d)\n", hipGetErrorString(e), grid);
#else
    for (int ph = 0; ph < 10; ++ph) { p.ph_lo = ph; p.ph_hi = ph + 1; hipLaunchKernelGGL(mk_fwd, dim3(grid), dim3(512), LDS_BYTES, stream, p); }
#endif
}
```

```cpp
#include <hip/hip_runtime.h>
#include <hip/hip_cooperative_groups.h>
#include <cstdio>
#include <cstdint>
namespace cg = cooperative_groups;
namespace pg8 {
#define PG8_LAS __attribute__((address_space(3)))
typedef unsigned short bf16_t;
typedef short bf16x8 __attribute__((ext_vector_type(8)));
typedef float f32x4 __attribute__((ext_vector_type(4)));
typedef unsigned u32x4 __attribute__((ext_vector_type(4)));
constexpr int BM = 256, BK = 64, HALF = 128, HTB = HALF * BK * 2  , STAGE_BYTES = 8 * HTB, NXCD = 8, WGM = 8;

__host__ __device__ __forceinline__ int lds_byte(int r, int c) { const int st = (r >> 4) * 2 + (c >> 5), rr = r & 15, cc = c & 31, ob = rr * 64 + cc * 2; return st * 1024 + (ob ^ (((ob >> 9) & 1) << 5)); }
__host__ __device__ __forceinline__ void stage_rc(int b, int& R, int& C) { const int st = b / 1024, sb = b % 1024, swz = sb ^ (((sb >> 9) & 1) << 5); R = (st >> 1) * 16 + swz / 64; C = (st & 1) * 32 + (swz % 64) / 2; }
__host__ __device__ __forceinline__ int perm32(int rho) { const int n = rho >> 4, i = rho & 15; return 8 * (i >> 2) + 4 * n + (i & 3); }

struct Unit { int pm, pn; };
struct Gemm { const bf16_t* A; const bf16_t* Bt; int M, N, K; };

struct StaticOrder {
    int nM, nN, nwg, G, c;
    __host__ __device__ void init(int M, int N, int G_, int c_) { nM = M / BM; nN = N / BM; nwg = nM * nN; G = G_; c = c_; }
    __host__ __device__ bool next(int i, Unit& u) const {
        const long L = (long)i * G + c; if (L >= nwg) return false;
        int wgid = (int)L; { const int q = nwg / NXCD, r = nwg % NXCD, xcd = wgid % NXCD, off = wgid / NXCD; wgid = (xcd < r ? xcd * (q + 1) : r * (q + 1) + (xcd - r) * q) + off; }
        const int nig = WGM * nN, gid = wgid / nig, fm = gid * WGM, gsz = (nM - fm) < WGM ? (nM - fm) : WGM;
        u.pm = fm + ((wgid % nig) % gsz); u.pn = (wgid % nig) / gsz; return true;
    }
    __device__ __forceinline__ void a_ready(const Unit&) const {}
    __device__ __forceinline__ void done(const Unit&) const {}
};
__device__ __forceinline__ unsigned cvt_pk_bf16(float lo, float hi) { unsigned r; asm volatile("v_cvt_pk_bf16_f32 %0, %1, %2" : "=v"(r) : "v"(lo), "v"(hi)); return r; }
template <class Epi, class Sched, bool ALIGN_EPI = false, bool SP2 = false>
__device__ __forceinline__ void gemm_phase(PG8_LAS unsigned char* lds, const Gemm g, const Sched& S, const Epi& E) {
    const int tid = threadIdx.x, wid = __builtin_amdgcn_readfirstlane(tid >> 6), lane = tid & 63, wr = wid >> 2, wc = wid & 3, fr = lane & 15, fq = lane >> 4;
    const int K = g.K, nt = K / BK;
    unsigned voffA[2], voffB[2];
#pragma unroll
    for (int i = 0; i < 2; ++i) { int R, C; stage_rc(tid * 16 + i * 8192, R, C); const int Rb = Epi::PERM ? ((R & ~31) + perm32(R & 31)) : R;
        voffA[i] = (unsigned)(R * K + C) * 2u; voffB[i] = (unsigned)(Rb * K + C) * 2u; }
    const size_t kstep = (size_t)(BK * 2);
    const size_t hstep = (size_t)HALF * K * 2;
    const size_t tstep = 2 * hstep;
    const unsigned ldsw = (unsigned)wid * 1024u;
    const int aoff = lds_byte(wr * 64 + fr, fq * 8), boff = lds_byte(wc * 32 + fr, fq * 8);
#define PG8_SA(b, h) (((b) * 2 + (h)) * HTB)
#define PG8_SB(b, h) ((4 + (b) * 2 + (h)) * HTB)
#define PG8_STAGE(bufoff, gbase, voff) do { _Pragma("unroll") for (int _i = 0; _i < 2; ++_i) \
        __builtin_amdgcn_global_load_lds((const unsigned*)((const char*)(gbase) + (voff)[_i]), (PG8_LAS unsigned*)(lds + (bufoff) + ldsw + _i * 8192), 16, 0, 0); } while (0)
#define PG8_LDA(dst, b, h) do { _Pragma("unroll") for (int m = 0; m < 4; ++m) _Pragma("unroll") for (int k = 0; k < 2; ++k) dst[m][k] = *(const PG8_LAS bf16x8*)(lds + PG8_SA(b, h) + aoff + m * 2048 + k * 1024); } while (0)
#define PG8_LDB(dst, b, h) do { _Pragma("unroll") for (int n = 0; n < 2; ++n) _Pragma("unroll") for (int k = 0; k < 2; ++k) dst[n][k] = *(const PG8_LAS bf16x8*)(lds + PG8_SB(b, h) + boff + n * 2048 + k * 1024); } while (0)
#define PG8_MMA(ai, bj, At, Bt) do { __builtin_amdgcn_s_setprio(1); _Pragma("unroll") for (int m = 0; m < 4; ++m) _Pragma("unroll") for (int n = 0; n < 2; ++n) _Pragma("unroll") for (int k = 0; k < 2; ++k) \
        acc[ai][bj][m][n] = __builtin_amdgcn_mfma_f32_16x16x32_bf16(Bt[n][k], At[m][k], acc[ai][bj][m][n], 0, 0, 0); __builtin_amdgcn_s_setprio(0); } while (0)
#define PG8_WAIT_V(n) asm volatile("s_waitcnt vmcnt(" #n ")" ::: "memory")
#define PG8_WAIT_L(n) asm volatile("s_waitcnt lgkmcnt(" #n ")" ::: "memory")
#define PG8_BAR __builtin_amdgcn_s_barrier()
#define PG8_SCHED __builtin_amdgcn_sched_barrier(0)
    Unit cur, nxt; int ui = 0;
    if (!S.next(0, cur)) return;
    f32x4 acc[2][2][4][2];
#pragma unroll
    for (int a = 0; a < 2; ++a)
#pragma unroll
        for (int b = 0; b < 2; ++b)
#pragma unroll
            for (int m = 0; m < 4; ++m)
#pragma unroll
                for (int n = 0; n < 2; ++n) acc[a][b][m][n] = (f32x4){0.f, 0.f, 0.f, 0.f};
    bf16x8 At[4][2], B0[2][2], B1[2][2];
    const char* cA = (const char*)g.A + (size_t)cur.pm * tstep; const char* cB = (const char*)g.Bt + (size_t)cur.pn * tstep;
    S.a_ready(cur);
    if constexpr (SP2) {
        PG8_STAGE(PG8_SB(0, 0), cB, voffB); PG8_STAGE(PG8_SB(0, 1), cB + hstep, voffB); PG8_STAGE(PG8_SA(0, 0), cA, voffA); PG8_STAGE(PG8_SA(0, 1), cA + hstep, voffA);
        if (wr == 1) PG8_BAR;
        PG8_WAIT_V(2); PG8_BAR;
        PG8_STAGE(PG8_SB(1, 0), cB + kstep, voffB); PG8_STAGE(PG8_SA(1, 0), cA + kstep, voffA); PG8_STAGE(PG8_SB(1, 1), cB + hstep + kstep, voffB);
        PG8_WAIT_V(6); PG8_BAR;
    } else {
        PG8_STAGE(PG8_SB(0, 0), cB, voffB); PG8_STAGE(PG8_SA(0, 0), cA, voffA); PG8_STAGE(PG8_SB(0, 1), cB + hstep, voffB); PG8_STAGE(PG8_SA(0, 1), cA + hstep, voffA);
        if (wr == 1) PG8_BAR;
        PG8_WAIT_V(4); PG8_BAR;
        PG8_STAGE(PG8_SB(1, 0), cB + kstep, voffB); PG8_STAGE(PG8_SA(1, 0), cA + kstep, voffA); PG8_STAGE(PG8_SB(1, 1), cB + hstep + kstep, voffB);
        PG8_WAIT_V(6); PG8_BAR;
    }
    for (;;) {
        const bool has_next = S.next(ui + 1, nxt);
        const char* nA = has_next ? (const char*)g.A + (size_t)nxt.pm * tstep : cA; const char* nB = has_next ? (const char*)g.Bt + (size_t)nxt.pn * tstep : cB;
        for (int t = 0; t < nt; t += 2) {
            const bool last = (t == nt - 2);
            const char* a1 = cA + (size_t)(t + 1) * kstep;
            const char* a2 = last ? nA : cA + (size_t)(t + 2) * kstep; const char* b2 = last ? nB : cB + (size_t)(t + 2) * kstep;
            const char* a3 = a2 + kstep; const char* b3 = b2 + kstep;
            if (last && has_next) S.a_ready(nxt);
            if constexpr (SP2) {
            PG8_LDB(B0, 0, 0); PG8_LDB(B1, 0, 1); PG8_SCHED; PG8_LDA(At, 0, 0); PG8_STAGE(PG8_SA(1, 1), a1 + hstep, voffA);
            PG8_WAIT_V(8); PG8_WAIT_L(0); PG8_BAR; PG8_MMA(0, 0, At, B0); PG8_MMA(0, 1, At, B1); PG8_BAR; PG8_SCHED;
            PG8_LDA(At, 0, 1); PG8_STAGE(PG8_SB(0, 0), b2, voffB); PG8_STAGE(PG8_SB(0, 1), b2 + hstep, voffB); PG8_STAGE(PG8_SA(0, 0), a2, voffA);
            PG8_WAIT_V(8); PG8_WAIT_L(0); PG8_BAR; PG8_MMA(1, 0, At, B0); PG8_MMA(1, 1, At, B1); PG8_BAR; PG8_SCHED;
            PG8_LDB(B0, 1, 0); PG8_LDB(B1, 1, 1); PG8_SCHED; PG8_LDA(At, 1, 0); PG8_STAGE(PG8_SA(0, 1), a2 + hstep, voffA);
            PG8_WAIT_V(8); PG8_WAIT_L(0); PG8_BAR; PG8_MMA(0, 0, At, B0); PG8_MMA(0, 1, At, B1); PG8_BAR; PG8_SCHED;
            PG8_LDA(At, 1, 1); PG8_STAGE(PG8_SB(1, 0), b3, voffB); PG8_STAGE(PG8_SB(1, 1), b3 + hstep, voffB); PG8_STAGE(PG8_SA(1, 0), a3, voffA);
            PG8_WAIT_V(8); PG8_WAIT_L(0); PG8_BAR; PG8_MMA(1, 0, At, B0); PG8_MMA(1, 1, At, B1); PG8_BAR; PG8_SCHED;
            } else {
            PG8_LDB(B0, 0, 0); PG8_SCHED; PG8_LDA(At, 0, 0); PG8_STAGE(PG8_SA(1, 1), a1 + hstep, voffA);
            PG8_WAIT_L(8); PG8_BAR; PG8_WAIT_L(0); PG8_MMA(0, 0, At, B0); PG8_BAR; PG8_SCHED;
            PG8_LDB(B1, 0, 1); PG8_STAGE(PG8_SB(0, 0), b2, voffB);
            PG8_BAR; PG8_WAIT_L(0); PG8_MMA(0, 1, At, B1); PG8_BAR;
            PG8_LDA(At, 0, 1); PG8_STAGE(PG8_SA(0, 0), a2, voffA);
            PG8_BAR; PG8_WAIT_L(0); PG8_MMA(1, 0, At, B0); PG8_BAR; PG8_SCHED;
            PG8_STAGE(PG8_SB(0, 1), b2 + hstep, voffB);
            PG8_WAIT_V(6); PG8_BAR; PG8_MMA(1, 1, At, B1); PG8_BAR;
            PG8_LDB(B0, 1, 0); PG8_SCHED; PG8_LDA(At, 1, 0); PG8_STAGE(PG8_SA(0, 1), a2 + hstep, voffA);
            PG8_WAIT_L(8); PG8_BAR; PG8_WAIT_L(0); PG8_MMA(0, 0, At, B0); PG8_BAR; PG8_SCHED;
            PG8_LDB(B1, 1, 1); PG8_STAGE(PG8_SB(1, 0), b3, voffB);
            PG8_BAR; PG8_WAIT_L(0); PG8_MMA(0, 1, At, B1); PG8_BAR;
            PG8_LDA(At, 1, 1); PG8_STAGE(PG8_SA(1, 0), a3, voffA);
            PG8_BAR; PG8_WAIT_L(0); PG8_MMA(1, 0, At, B0); PG8_BAR; PG8_SCHED;
            PG8_STAGE(PG8_SB(1, 1), b3 + hstep, voffB);
            PG8_WAIT_V(6); PG8_BAR; PG8_MMA(1, 1, At, B1); PG8_BAR;
            }
        }
        if constexpr (ALIGN_EPI) { if (wr == 0) PG8_BAR; }
        if constexpr (!Epi::AFTER_DRAIN) { E(acc, cur, wr, wc, fr, fq); S.done(cur); }
        if (!has_next) break;
#pragma unroll
        for (int a = 0; a < 2; ++a)
#pragma unroll
            for (int b = 0; b < 2; ++b)
#pragma unroll
                for (int m = 0; m < 4; ++m)
#pragma unroll
                    for (int n = 0; n < 2; ++n) acc[a][b][m][n] = (f32x4){0.f, 0.f, 0.f, 0.f};
        cur = nxt; cA = nA; cB = nB; ++ui;
        if constexpr (ALIGN_EPI) { if (wr == 1) PG8_BAR; }
    }
    PG8_WAIT_V(0);
    if constexpr (!ALIGN_EPI) { if (wr == 0) PG8_BAR; }
    PG8_BAR;
    if constexpr (Epi::AFTER_DRAIN) { E.fused(acc, cur, wr, wc, fr, fq, lds, wid, lane); S.done(cur); }
#undef PG8_SA
#undef PG8_SB
#undef PG8_STAGE
#undef PG8_LDA
#undef PG8_LDB
#undef PG8_MMA
#undef PG8_WAIT_V
#undef PG8_WAIT_L
#undef PG8_BAR
#undef PG8_SCHED
}
}

using pg8::f32x4; using pg8::u32x4; using pg8::bf16x8; using pg8::bf16_t; using pg8::Unit; using pg8::cvt_pk_bf16;
typedef unsigned u32x2 __attribute__((ext_vector_type(2)));
typedef float f32x2 __attribute__((ext_vector_type(2)));

constexpr int DM = 1024, NP = 16384, NS = 512, NTOK = NP + NS, NMODROW = 136, DFF = 2816;
constexpr float EPS = 1e-6f;
constexpr int LDS_BYTES = 147456;
constexpr size_t MiB = 1u << 20;
constexpr size_t WS_CTR = 16384;
constexpr size_t WS_MOD = 1 * MiB;
constexpr size_t WS_SP = 5 * MiB;
constexpr size_t WS_MG = 6 * MiB, WS_EG = 10 * MiB, WS_RG = 12 * MiB;
constexpr size_t WS_WIN = 16 * MiB, WS_WGLU = 22 * MiB, WS_WPOOL = 24 * MiB, WS_WOUT = 25 * MiB, WS_WFI = 27 * MiB, WS_WFO = 39 * MiB;
constexpr size_t WS_H = 48 * MiB;
constexpr size_t WS_US = 82 * MiB, WS_UP = 99 * MiB;
constexpr size_t WS_SGS = 116 * MiB, WS_SGP = 149 * MiB;
constexpr size_t WS_GY = 182 * MiB;
constexpr size_t WS_ZS = 199 * MiB;
constexpr size_t WS_XB = 82 * MiB;
constexpr size_t WS_ACT = 116 * MiB;
constexpr int SP_AR = 0, SP_AI = 2048, SP_A16R = 4096, SP_A16I = 6144, SP_BBR = 8192, SP_BBI = 8192 + 32768;

struct Params {
    const float* in[27];
    float* out;
    unsigned char* ws;
    int ph_lo, ph_hi;
};

__device__ __forceinline__ float fsigmoid(float x) { return __builtin_amdgcn_rcpf(1.0f + __builtin_amdgcn_exp2f(-1.44269504089f * x)); }
__device__ __forceinline__ float fsilu(float x) { return x * fsigmoid(x); }
__device__ __forceinline__ float fgelu_tanh(float y) { return y * fsigmoid(1.59576912161f * y * (1.0f + 0.044715f * y * y)); }
__device__ __forceinline__ float bf_lo(unsigned u) { return __builtin_bit_cast(float, u << 16); }
__device__ __forceinline__ float bf_hi(unsigned u) { return __builtin_bit_cast(float, u & 0xffff0000u); }
__device__ __forceinline__ int mrow(int r) { return r < NP ? (r >> 11) : 8 + ((r - NP) >> 2); }
__device__ __forceinline__ bf16x8 pack8(f32x4 a, f32x4 b) {
    u32x4 w; w.x = cvt_pk_bf16(a[0], a[1]); w.y = cvt_pk_bf16(a[2], a[3]); w.z = cvt_pk_bf16(b[0], b[1]); w.w = cvt_pk_bf16(b[2], b[3]);
    return __builtin_bit_cast(bf16x8, w);
}
__device__ __forceinline__ float wave_sum(float v) {
#pragma unroll
    for (int o = 1; o < 64; o <<= 1) v += __shfl_xor(v, o);
    return v;
}
#ifdef NT_STORES
#define GST(ptr, v) __builtin_nontemporal_store((v), (ptr))
#else
#define GST(ptr, v) (*(ptr) = (v))
#endif
#define MFMA16(a, b, c) __builtin_amdgcn_mfma_f32_16x16x32_bf16((a), (b), (c), 0, 0, 0)

struct EpiG1 {
    static constexpr bool PERM = true, AFTER_DRAIN = false;
    bf16_t *US, *UP, *SGS, *SGP; float* ppool; float* spool;
    __device__ __forceinline__ void emit(int r, int c, int cls, f32x4 v0, f32x4 v1) const {
        if (cls < 2) {
            u32x4 w; w.x = cvt_pk_bf16(v0[0], v0[1]); w.y = cvt_pk_bf16(v0[2], v0[3]); w.z = cvt_pk_bf16(v1[0], v1[1]); w.w = cvt_pk_bf16(v1[2], v1[3]);
            GST((u32x4*)(US + (size_t)r * 512 + c), w);
        } else if (cls < 4) {
            const int cc = c - 512;
            u32x4 w; w.x = cvt_pk_bf16(v0[0], v0[1]); w.y = cvt_pk_bf16(v0[2], v0[3]); w.z = cvt_pk_bf16(v1[0], v1[1]); w.w = cvt_pk_bf16(v1[2], v1[3]);
            GST((u32x4*)(UP + (size_t)r * 512 + cc), w);
            if (r < NP) { const int t = r & 2047; if (t >= 2033) { float* o = ppool + ((size_t)(r >> 11) * 15 + (t - 2033)) * 512 + cc; *(f32x4*)o = v0; *(f32x4*)(o + 4) = v1; } }
            else { const int s = (r - NP) >> 2, i = (r - NP) & 3; float* o = spool + ((size_t)s * 15 + 11 + i) * 512 + cc; *(f32x4*)o = v0; *(f32x4*)(o + 4) = v1; }
        } else {
#pragma unroll
            for (int j = 0; j < 4; ++j) { v0[j] = fsigmoid(v0[j]); v1[j] = fsigmoid(v1[j]); }
            u32x4 w; w.x = cvt_pk_bf16(v0[0], v0[1]); w.y = cvt_pk_bf16(v0[2], v0[3]); w.z = cvt_pk_bf16(v1[0], v1[1]); w.w = cvt_pk_bf16(v1[2], v1[3]);
            if (cls < 8) GST((u32x4*)(SGS + (size_t)r * 1024 + (c - 1024)), w); else GST((u32x4*)(SGP + (size_t)r * 1024 + (c - 2048)), w);
        }
    }
    __device__ __forceinline__ void operator()(const f32x4 (&acc)[2][2][4][2], const Unit& u, int wr, int wc, int fr, int fq) const {
        const int row0 = u.pm * 256 + wr * 64 + fr, colt = u.pn * 256 + wc * 32 + 8 * fq;
#pragma unroll
        for (int ai = 0; ai < 2; ++ai)
#pragma unroll
            for (int m = 0; m < 4; ++m)
#pragma unroll
                for (int bj = 0; bj < 2; ++bj) emit(row0 + ai * 128 + m * 16, colt + bj * 128, u.pn, acc[ai][bj][m][0], acc[ai][bj][m][1]);
    }
};
struct EpiGLU {
    static constexpr bool PERM = true, AFTER_DRAIN = false;
    const bf16_t *SGS, *ZS; bf16_t* MGD;
    __device__ __forceinline__ void operator()(const f32x4 (&acc)[2][2][4][2], const Unit& u, int wr, int wc, int fr, int fq) const {
        const int row0 = u.pm * 256 + wr * 64 + fr, j0 = u.pn * 128 + wc * 32 + 8 * fq;
        u32x4 sgv[2][4], zsv[2][4];
#pragma unroll
        for (int ai = 0; ai < 2; ++ai)
#pragma unroll
            for (int m = 0; m < 4; ++m) { const size_t off = (size_t)(row0 + ai * 128 + m * 16) * 1024 + j0; sgv[ai][m] = *(const u32x4*)(SGS + off); zsv[ai][m] = *(const u32x4*)(ZS + off); }
#pragma unroll
        for (int ai = 0; ai < 2; ++ai)
#pragma unroll
            for (int m = 0; m < 4; ++m) {
                const size_t off = (size_t)(row0 + ai * 128 + m * 16) * 1024 + j0;
                const u32x4 sg = sgv[ai][m], zs = zsv[ai][m];
                const f32x4 a0 = acc[ai][0][m][0], a1 = acc[ai][0][m][1], b0 = acc[ai][1][m][0], b1 = acc[ai][1][m][1];
                float o[8];
                o[0] = bf_lo(sg.x) * a0[0] * fsigmoid(b0[0]) + bf_lo(zs.x); o[1] = bf_hi(sg.x) * a0[1] * fsigmoid(b0[1]) + bf_hi(zs.x);
                o[2] = bf_lo(sg.y) * a0[2] * fsigmoid(b0[2]) + bf_lo(zs.y); o[3] = bf_hi(sg.y) * a0[3] * fsigmoid(b0[3]) + bf_hi(zs.y);
                o[4] = bf_lo(sg.z) * a1[0] * fsigmoid(b1[0]) + bf_lo(zs.z); o[5] = bf_hi(sg.z) * a1[1] * fsigmoid(b1[1]) + bf_hi(zs.z);
                o[6] = bf_lo(sg.w) * a1[2] * fsigmoid(b1[2]) + bf_lo(zs.w); o[7] = bf_hi(sg.w) * a1[3] * fsigmoid(b1[3]) + bf_hi(zs.w);
                u32x4 w; w.x = cvt_pk_bf16(o[0], o[1]); w.y = cvt_pk_bf16(o[2], o[3]); w.z = cvt_pk_bf16(o[4], o[5]); w.w = cvt_pk_bf16(o[6], o[7]);
                GST((u32x4*)(MGD + off), w);
            }
    }
};
struct EpiSwiGLU {
    static constexpr bool PERM = true, AFTER_DRAIN = false;
    bf16_t* ACT;
    __device__ __forceinline__ void operator()(const f32x4 (&acc)[2][2][4][2], const Unit& u, int wr, int wc, int fr, int fq) const {
        const int row0 = u.pm * 256 + wr * 64 + fr, j0 = u.pn * 128 + wc * 32 + 8 * fq;
#pragma unroll
        for (int ai = 0; ai < 2; ++ai)
#pragma unroll
            for (int m = 0; m < 4; ++m) {
                const size_t off = (size_t)(row0 + ai * 128 + m * 16) * DFF + j0;
                const f32x4 a0 = acc[ai][0][m][0], a1 = acc[ai][0][m][1], b0 = acc[ai][1][m][0], b1 = acc[ai][1][m][1];
                u32x4 w;
                w.x = cvt_pk_bf16(fsilu(a0[0]) * b0[0], fsilu(a0[1]) * b0[1]); w.y = cvt_pk_bf16(fsilu(a0[2]) * b0[2], fsilu(a0[3]) * b0[3]);
                w.z = cvt_pk_bf16(fsilu(a1[0]) * b1[0], fsilu(a1[1]) * b1[1]); w.w = cvt_pk_bf16(fsilu(a1[2]) * b1[2], fsilu(a1[3]) * b1[3]);
                GST((u32x4*)(ACT + off), w);
            }
    }
};
template <int MODE> struct EpiRes {
    static constexpr bool PERM = false, AFTER_DRAIN = false;
    const float* baseF; const bf16_t* baseB; const float* gate; bf16_t* XO;
    __device__ __forceinline__ void operator()(const f32x4 (&acc)[2][2][4][2], const Unit& u, int wr, int wc, int fr, int fq) const {
        const int row0 = u.pm * 256 + wr * 64 + fr, col0 = u.pn * 256 + wc * 32 + 4 * fq;
        const float* gp = gate + (size_t)((u.pm * 256) >> 11) * 6144 + col0;
        f32x4 gt[2][2];
#pragma unroll
        for (int bj = 0; bj < 2; ++bj)
#pragma unroll
            for (int n = 0; n < 2; ++n) gt[bj][n] = *(const f32x4*)(gp + bj * 128 + n * 16);
        if (MODE == 0) {
#pragma unroll
            for (int ai = 0; ai < 2; ++ai) {
                f32x4 x[4][2][2];
#pragma unroll
                for (int m = 0; m < 4; ++m) { const float* bp = baseF + (size_t)(row0 + ai * 128 + m * 16) * DM + col0;
#pragma unroll
                    for (int bj = 0; bj < 2; ++bj)
#pragma unroll
                        for (int n = 0; n < 2; ++n) x[m][bj][n] = *(const f32x4*)(bp + bj * 128 + n * 16); }
#pragma unroll
                for (int m = 0; m < 4; ++m) { bf16_t* xp = XO + (size_t)(row0 + ai * 128 + m * 16) * DM + col0;
#pragma unroll
                    for (int bj = 0; bj < 2; ++bj)
#pragma unroll
                        for (int n = 0; n < 2; ++n) { const f32x4 v = x[m][bj][n] + gt[bj][n] * acc[ai][bj][m][n];
                            u32x2 w; w.x = cvt_pk_bf16(v[0], v[1]); w.y = cvt_pk_bf16(v[2], v[3]); GST((u32x2*)(xp + bj * 128 + n * 16), w); } }
            }
        } else {
            u32x2 x[2][4][2][2];
#pragma unroll
            for (int ai = 0; ai < 2; ++ai)
#pragma unroll
                for (int m = 0; m < 4; ++m) { const bf16_t* bp = baseB + (size_t)(row0 + ai * 128 + m * 16) * DM + col0;
#pragma unroll
                    for (int bj = 0; bj < 2; ++bj)
#pragma unroll
                        for (int n = 0; n < 2; ++n) x[ai][m][bj][n] = *(const u32x2*)(bp + bj * 128 + n * 16); }
#pragma unroll
            for (int ai = 0; ai < 2; ++ai)
#pragma unroll
                for (int m = 0; m < 4; ++m) { bf16_t* xp = XO + (size_t)(row0 + ai * 128 + m * 16) * DM + col0;
#pragma unroll
                    for (int bj = 0; bj < 2; ++bj)
#pragma unroll
                        for (int n = 0; n < 2; ++n) { const u32x2 q = x[ai][m][bj][n]; const f32x4 xv = (f32x4){bf_lo(q.x), bf_hi(q.x), bf_lo(q.y), bf_hi(q.y)};
                            const f32x4 v = xv + gt[bj][n] * acc[ai][bj][m][n];
                            u32x2 w; w.x = cvt_pk_bf16(v[0], v[1]); w.y = cvt_pk_bf16(v[2], v[3]); GST((u32x2*)(xp + bj * 128 + n * 16), w); } }
        }
    }
};

__device__ __forceinline__ void transpose_item(const float* W, int ldw, int k0, int n0, bf16_t* WT, int ldt, int drow0, float* scr, int lane) {
    float tv[32];
#pragma unroll
    for (int i = 0; i < 32; ++i) tv[i] = W[(size_t)(k0 + 2 * i + (lane >> 5)) * ldw + n0 + (lane & 31)];
#pragma unroll
    for (int i = 0; i < 32; ++i) scr[(2 * i + (lane >> 5)) * 33 + (lane & 31)] = tv[i];
    asm volatile("s_waitcnt lgkmcnt(0)" ::: "memory");
    const int c = lane & 7;
#pragma unroll
    for (int j = 0; j < 4; ++j) { const int n = (lane >> 3) + 8 * j; const float* s = scr + (8 * c) * 33 + n;
        u32x4 o; o.x = cvt_pk_bf16(s[0 * 33], s[1 * 33]); o.y = cvt_pk_bf16(s[2 * 33], s[3 * 33]); o.z = cvt_pk_bf16(s[4 * 33], s[5 * 33]); o.w = cvt_pk_bf16(s[6 * 33], s[7 * 33]);
        *(u32x4*)(WT + (size_t)(drow0 + n) * ldt + k0 + 8 * c) = o; }
    asm volatile("s_waitcnt lgkmcnt(0)" ::: "memory");
}
__device__ __forceinline__ int glu_row(int n, int half) { return n < half ? 256 * (n >> 7) + (n & 127) : 256 * ((n - half) >> 7) + 128 + ((n - half) & 127); }

constexpr int TR_ITEMS[6] = {16 * 96, 8 * 64, 16 * 32, 16 * 176, 44 * 32, 4 * 2 * 8};
__device__ __forceinline__ void tr_item(const Params& p, int which, int r, float* scr, int lane) {
    if (which == 0) { const int kb = r / 96, nb = r % 96; transpose_item(p.in[12], 3072, 64 * kb, 32 * nb, (bf16_t*)(p.ws + WS_WIN), 1024, 32 * nb, scr, lane); }
    else if (which == 1) { const int kb = r / 64, nb = r % 64; transpose_item(p.in[21], 2048, 64 * kb, 32 * nb, (bf16_t*)(p.ws + WS_WGLU), 512, glu_row(32 * nb, 1024), scr, lane); }
    else if (which == 2) { const int kb = r / 32, nb = r % 32; transpose_item(p.in[24], 1024, 64 * kb, 32 * nb, (bf16_t*)(p.ws + WS_WOUT), 1024, 32 * nb, scr, lane); }
    else if (which == 3) { const int kb = r / 176, nb = r % 176; transpose_item(p.in[25], 5632, 64 * kb, 32 * nb, (bf16_t*)(p.ws + WS_WFI), 1024, glu_row(32 * nb, DFF), scr, lane); }
    else if (which == 4) { const int kb = r / 32, nb = r % 32; transpose_item(p.in[26], 1024, 64 * kb, 32 * nb, (bf16_t*)(p.ws + WS_WFO), DFF, 32 * nb, scr, lane); }
    else { const int gk = r / 16, q = r % 16, kb = q / 8, nb = q % 8; transpose_item(p.in[22] + (size_t)gk * 128 * 256, 256, 64 * kb, 32 * nb, (bf16_t*)(p.ws + WS_WPOOL) + (size_t)gk * 256 * 128, 128, 32 * nb, scr, lane); }
}
__device__ __forceinline__ void ada_unit(const Params& p, int unit, unsigned char* lds, int tid) {
    const int lane = tid & 63, w = tid >> 6, lr = lane & 15, lq = lane >> 4, kq = w & 3, mh = w >> 2;
    const int n0 = unit * 32, mt0 = mh ? 5 : 0, mcnt = mh ? 4 : 5;
    const float* cp = p.in[2]; const float* cs = p.in[3]; const float* wa = p.in[10]; const float* ba = p.in[11];
    float* mod = (float*)(p.ws + WS_MOD);
    float* red = (float*)lds;
    f32x4 acc[5][2];
#pragma unroll
    for (int i = 0; i < 5; ++i) { acc[i][0] = (f32x4){0.f, 0.f, 0.f, 0.f}; acc[i][1] = (f32x4){0.f, 0.f, 0.f, 0.f}; }
#pragma unroll 2
    for (int ks = 0; ks < 8; ++ks) {
        const int k0 = kq * 256 + ks * 32 + 8 * lq;
        bf16x8 bfr[2];
#pragma unroll
        for (int nt = 0; nt < 2; ++nt) {
            const float* bp = wa + (size_t)k0 * 6144 + n0 + 16 * nt + lr;
            f32x4 x0, x1;
            x0[0] = bp[0]; x0[1] = bp[6144]; x0[2] = bp[2 * 6144]; x0[3] = bp[3 * 6144]; x1[0] = bp[4 * 6144]; x1[1] = bp[5 * 6144]; x1[2] = bp[6 * 6144]; x1[3] = bp[7 * 6144];
            bfr[nt] = pack8(x0, x1);
        }
#pragma unroll
        for (int mi = 0; mi < 5; ++mi) {
            if (mi < mcnt) {
                const int row = 16 * (mt0 + mi) + lr;
                f32x4 x0 = (f32x4){0.f, 0.f, 0.f, 0.f}, x1 = x0;
                if (row < NMODROW) { const float* ap = (row < 8 ? cp + (size_t)row * DM : cs + (size_t)(row - 8) * DM) + k0; x0 = *(const f32x4*)ap; x1 = *(const f32x4*)(ap + 4); }
#pragma unroll
                for (int j = 0; j < 4; ++j) { x0[j] = fsilu(x0[j]); x1[j] = fsilu(x1[j]); }
                const bf16x8 af = pack8(x0, x1);
                acc[mi][0] = MFMA16(bfr[0], af, acc[mi][0]); acc[mi][1] = MFMA16(bfr[1], af, acc[mi][1]);
            }
        }
    }
#pragma unroll
    for (int mi = 0; mi < 5; ++mi) if (mi < mcnt) {
        const int row = 16 * (mt0 + mi) + lr;
        *(f32x4*)(red + ((size_t)(kq * 144 + row)) * 32 + 4 * lq) = acc[mi][0];
        *(f32x4*)(red + ((size_t)(kq * 144 + row)) * 32 + 16 + 4 * lq) = acc[mi][1];
    }
    __syncthreads();
    for (int o = tid; o < NMODROW * 32; o += 512) {
        const int row = o >> 5, col = o & 31;
        const float v = ((red[(0 * 144 + row) * 32 + col] + red[(1 * 144 + row) * 32 + col]) + (red[(2 * 144 + row) * 32 + col] + red[(3 * 144 + row) * 32 + col])) + ba[n0 + col];
        mod[(size_t)row * 6144 + n0 + col] = v;
    }
    __syncthreads();
}

__device__ __forceinline__ void ssm_prep_unit(const Params& p, int g, int part, unsigned char* lds, int tid) {
    float* L = (float*)lds;
    float* pwr = L;            float* pwi = L + 17 * 64;
    float* bbr = L + 2176;     float* bbi = bbr + 1024;
    float* crT = bbi + 1024;   float* ciT = crT + 1024;
    float* ktab = ciT + 1024;
    float* spf = (float*)(p.ws + WS_SP);
    bf16_t* MG = (bf16_t*)(p.ws + WS_MG) + (size_t)g * 256 * 256;
    bf16_t* EG = (bf16_t*)(p.ws + WS_EG) + (size_t)g * 256 * 128;
    bf16_t* RG = (bf16_t*)(p.ws + WS_RG) + (size_t)g * 128 * 256;
    const float dt = expf(p.in[15][g]);
    for (int i = tid; i < 17 * 64; i += 512) {
        const int pp = i & 63, d = i >> 6, gp = g * 64 + pp;
        const float lr = p.in[13][gp], li = p.in[14][gp];
        const float mag = expf(lr * dt * (float)d), ang = li * dt * (float)d; float sn, cs; sincosf(ang, &sn, &cs); pwr[d * 64 + pp] = mag * cs; pwi[d * 64 + pp] = mag * sn;
    }
    for (int i = tid; i < 1024; i += 512) {
        const int pp = i >> 4, c = i & 15, gp = g * 64 + pp;
        const float lr = p.in[13][gp], li = p.in[14][gp];
        const float mag = expf(lr * dt), ang = li * dt; float sn, cs; sincosf(ang, &sn, &cs);
        const float abr = mag * cs, abi = mag * sn, den = lr * lr + li * li, nr = abr - 1.0f, ni = abi;
        const float fr = (nr * lr + ni * li) / den, fi = (ni * lr - nr * li) / den;
        const float br = p.in[16][(size_t)gp * 16 + c], bi = p.in[17][(size_t)gp * 16 + c];
        const float xr = fr * br - fi * bi, xi = fr * bi + fi * br; bbr[pp * 16 + c] = xr; bbi[pp * 16 + c] = xi;
        if (part == 2) { spf[SP_BBR + gp * 16 + c] = xr; spf[SP_BBI + gp * 16 + c] = xi; }
    }
    for (int i = tid; i < 1024; i += 512) { const int c = i >> 6, pp = i & 63; crT[pp * 16 + c] = p.in[18][(size_t)(g * 16 + c) * 64 + pp]; ciT[pp * 16 + c] = p.in[19][(size_t)(g * 16 + c) * 64 + pp]; }
    __syncthreads();
    if (part == 0) {
        {
            const int pair = tid & 255, d = pair >> 4, c2 = pair & 15, ch = tid >> 8;
            float a8[8];
#pragma unroll
            for (int i = 0; i < 8; ++i) a8[i] = 0.f;
#pragma unroll 8
            for (int pp = 0; pp < 64; ++pp) {
                const float ar = pwr[d * 64 + pp], ai = pwi[d * 64 + pp], br = bbr[pp * 16 + c2], bi = bbi[pp * 16 + c2];
                const float tr = ar * br - ai * bi, ti = ar * bi + ai * br;
                const f32x4 cr0 = *(const f32x4*)(crT + pp * 16 + 8 * ch), cr1 = *(const f32x4*)(crT + pp * 16 + 8 * ch + 4);
                const f32x4 ci0 = *(const f32x4*)(ciT + pp * 16 + 8 * ch), ci1 = *(const f32x4*)(ciT + pp * 16 + 8 * ch + 4);
#pragma unroll
                for (int i = 0; i < 4; ++i) { a8[i] += cr0[i] * tr - ci0[i] * ti; a8[4 + i] += cr1[i] * tr - ci1[i] * ti; }
            }
#pragma unroll
            for (int i = 0; i < 8; ++i) { const int c = 8 * ch + i; float v = a8[i]; if (d == 0 && c == c2) v += p.in[20][g * 16 + c]; ktab[d * 256 + c * 16 + c2] = v; }
        }
        __syncthreads();
        for (int idx = tid; idx < 8192; idx += 512) {
            const int n = idx >> 5, kk = (idx & 31) * 8, tau = n >> 4, c = n & 15, tp = kk >> 4, c0 = kk & 15;
            f32x4 x0 = (f32x4){0.f, 0.f, 0.f, 0.f}, x1 = x0;
            if (tau >= tp) { const float* s = ktab + (tau - tp) * 256 + c * 16 + c0; x0 = *(const f32x4*)s; x1 = *(const f32x4*)(s + 4); }
            *(bf16x8*)(MG + (size_t)n * 256 + kk) = pack8(x0, x1);
        }
    } else if (part == 1) {
        for (int idx = tid; idx < 4096; idx += 512) {
            const int n = idx >> 4, q0 = (idx & 15) * 8, tau = n >> 4, c = n & 15;
            float v[8];
#pragma unroll
            for (int j = 0; j < 8; ++j) { const int q = q0 + j, pp = q & 63; const float pr = pwr[(tau + 1) * 64 + pp], pi = pwi[(tau + 1) * 64 + pp], cr = crT[pp * 16 + c], ci = ciT[pp * 16 + c];
                v[j] = q < 64 ? (cr * pr - ci * pi) : -(cr * pi + ci * pr); }
            *(bf16x8*)(EG + (size_t)n * 128 + q0) = pack8((f32x4){v[0], v[1], v[2], v[3]}, (f32x4){v[4], v[5], v[6], v[7]});
        }
    } else {
        if (tid < 64) { const int gp = g * 64 + tid; spf[SP_AR + gp] = pwr[64 + tid]; spf[SP_AI + gp] = pwi[64 + tid]; spf[SP_A16R + gp] = pwr[16 * 64 + tid]; spf[SP_A16I + gp] = pwi[16 * 64 + tid]; }
        for (int idx = tid; idx < 4096; idx += 512) {
            const int q = idx >> 5, kk = (idx & 31) * 8, tp = kk >> 4, c0 = kk & 15, pp = q & 63;
            const float pr = pwr[(15 - tp) * 64 + pp], pi = pwi[(15 - tp) * 64 + pp];
            const f32x4 br0 = *(const f32x4*)(bbr + pp * 16 + c0), br1 = *(const f32x4*)(bbr + pp * 16 + c0 + 4), bi0 = *(const f32x4*)(bbi + pp * 16 + c0), bi1 = *(const f32x4*)(bbi + pp * 16 + c0 + 4);
            const f32x4 v0 = q < 64 ? (br0 * pr - bi0 * pi) : (bi0 * pr + br0 * pi), v1 = q < 64 ? (br1 * pr - bi1 * pi) : (bi1 * pr + br1 * pi);
            *(bf16x8*)(RG + (size_t)q * 256 + kk) = pack8(v0, v1);
        }
    }
    __syncthreads();
}

template <bool BF> __device__ __forceinline__ void modnorm_rows(const float* xa, const float* xb, const float* gvec, const float* mod, int jshift, int jscale, bf16_t* H, int rbeg, int rend, int wave, int lane) {
    for (int r0 = rbeg + wave; r0 < rend; r0 += 16) {
        const int rr[2] = {r0, (r0 + 8 < rend) ? r0 + 8 : r0};
        f32x4 v[2][4], sc[2][4], sh[2][4], gg[4];
#pragma unroll
        for (int h = 0; h < 2; ++h) {
            const int r = rr[h];
            const float* xr = (r < NP ? xa + (size_t)r * DM : xb + (size_t)(r - NP) * DM) + 4 * lane;
            const bf16_t* xbr = (const bf16_t*)xa + (size_t)r * DM + 4 * lane;
#pragma unroll
            for (int j = 0; j < 4; ++j) { if (BF) { const u32x2 q = *(const u32x2*)(xbr + 256 * j); v[h][j] = (f32x4){bf_lo(q.x), bf_hi(q.x), bf_lo(q.y), bf_hi(q.y)}; } else v[h][j] = *(const f32x4*)(xr + 256 * j); }
            const float* mr = mod + (size_t)mrow(r) * 6144 + 4 * lane;
#pragma unroll
            for (int j = 0; j < 4; ++j) { sc[h][j] = *(const f32x4*)(mr + jscale * DM + 256 * j); sh[h][j] = *(const f32x4*)(mr + jshift * DM + 256 * j); }
        }
#pragma unroll
        for (int j = 0; j < 4; ++j) gg[j] = *(const f32x4*)(gvec + 4 * lane + 256 * j);
        float s[2];
#pragma unroll
        for (int h = 0; h < 2; ++h) { s[h] = 0.f;
#pragma unroll
            for (int j = 0; j < 4; ++j) s[h] += (v[h][j][0] * v[h][j][0] + v[h][j][1] * v[h][j][1]) + (v[h][j][2] * v[h][j][2] + v[h][j][3] * v[h][j][3]); }
#pragma unroll
        for (int o = 1; o < 64; o <<= 1) { s[0] += __shfl_xor(s[0], o); s[1] += __shfl_xor(s[1], o); }
#pragma unroll
        for (int h = 0; h < 2; ++h) {
            const float inv = rsqrtf(s[h] * (1.0f / DM) + EPS);
            if (h == 0 || rr[1] != rr[0]) {
#pragma unroll
                for (int j = 0; j < 4; ++j) {
                    const f32x4 hv = (v[h][j] * inv) * gg[j] * (sc[h][j] + 1.0f) + sh[h][j];
                    u32x2 w; w.x = cvt_pk_bf16(hv[0], hv[1]); w.y = cvt_pk_bf16(hv[2], hv[3]);
                    *(u32x2*)(H + (size_t)rr[h] * DM + 4 * lane + 256 * j) = w;
                }
            }
        }
    }
}

constexpr int UP_PITCH = 264;
constexpr int RS_PITCH = 132;
__device__ __forceinline__ void ssm_block(const Params& p, int b, int g, unsigned char* lds, int tid) {
    const int lane = tid & 63, w = tid >> 6, lr = lane & 15, lq = lane >> 4;
    bf16_t* U = (bf16_t*)lds;
    float* RS = (float*)(lds + 128 * UP_PITCH * 2);
    const bf16_t* US = (const bf16_t*)(p.ws + WS_US);
    bf16_t* GY = (bf16_t*)(p.ws + WS_GY);
    const float* spf = (const float*)(p.ws + WS_SP);
    u32x4 uraw[8];
#pragma unroll
    for (int i = 0; i < 8; ++i) { const int q = tid + 512 * i, tok = q >> 1, half = q & 1; uraw[i] = *(const u32x4*)(US + ((size_t)(b * 2048 + tok) * 512 + g * 16 + half * 8)); }
    const bf16_t* Rb = (const bf16_t*)(p.ws + WS_RG) + ((size_t)g * 128 + 16 * w + lr) * 256 + 8 * lq;
    bf16x8 rf[8];
#pragma unroll
    for (int ks = 0; ks < 8; ++ks) rf[ks] = *(const bf16x8*)(Rb + 32 * ks);
    const bf16_t* Mb = (const bf16_t*)(p.ws + WS_MG) + ((size_t)g * 256 + 32 * w + lr) * 256 + 8 * lq;
    bf16x8 m0[8], m1[8];
#pragma unroll
    for (int ks = 0; ks < 8; ++ks) { m0[ks] = *(const bf16x8*)(Mb + 32 * ks); m1[ks] = *(const bf16x8*)(Mb + 16 * 256 + 32 * ks); }
#pragma unroll
    for (int i = 0; i < 8; ++i) { const int q = tid + 512 * i, tok = q >> 1, half = q & 1; *(u32x4*)(U + (tok >> 4) * UP_PITCH + (tok & 15) * 16 + half * 8) = uraw[i]; }
    __syncthreads();
    f32x4 acc[8][2];
    {
        f32x4 acc1[8];
#pragma unroll
        for (int i = 0; i < 8; ++i) acc1[i] = (f32x4){0.f, 0.f, 0.f, 0.f};
#pragma unroll
        for (int ks = 0; ks < 8; ++ks) {
#pragma unroll
            for (int mt = 0; mt < 8; ++mt) { const bf16x8 af = *(const bf16x8*)(U + (16 * mt + lr) * UP_PITCH + 32 * ks + 8 * lq); acc1[mt] = MFMA16(rf[ks], af, acc1[mt]); }
            __builtin_amdgcn_sched_barrier(0);
        }
#pragma unroll
        for (int mt = 0; mt < 8; ++mt) *(f32x4*)(RS + (16 * mt + lr) * RS_PITCH + 16 * w + 4 * lq) = acc1[mt];
    }
    {
#pragma unroll
        for (int i = 0; i < 8; ++i) { acc[i][0] = (f32x4){0.f, 0.f, 0.f, 0.f}; acc[i][1] = (f32x4){0.f, 0.f, 0.f, 0.f}; }
#pragma unroll
        for (int ks = 0; ks < 8; ++ks) if (ks <= w) {
#pragma unroll
            for (int mt = 0; mt < 8; ++mt) { const bf16x8 af = *(const bf16x8*)(U + (16 * mt + lr) * UP_PITCH + 32 * ks + 8 * lq);
                acc[mt][0] = MFMA16(m0[ks], af, acc[mt][0]); acc[mt][1] = MFMA16(m1[ks], af, acc[mt][1]); }
            __builtin_amdgcn_sched_barrier(0);
        }
    }
    const bf16_t* Eb = (const bf16_t*)(p.ws + WS_EG) + ((size_t)g * 256 + 32 * w + lr) * 128 + 8 * lq;
    bf16x8 e0[4], e1[4];
#pragma unroll
    for (int ks = 0; ks < 4; ++ks) { e0[ks] = *(const bf16x8*)(Eb + 32 * ks); e1[ks] = *(const bf16x8*)(Eb + 16 * 128 + 32 * ks); }
    __syncthreads();
    {
        float* TT = RS + 128 * RS_PITCH;
        const int gp = g * 64 + lane; const float ar = spf[SP_A16R + gp], ai = spf[SP_A16I + gp];
        float sr = 0.f, si = 0.f;
#pragma unroll
        for (int jj = 0; jj < 16; ++jj) {
            const int j = 16 * w + jj;
            const float rr = RS[j * RS_PITCH + lane], ri = RS[j * RS_PITCH + 64 + lane];
            RS[j * RS_PITCH + lane] = sr; RS[j * RS_PITCH + 64 + lane] = si;
            const float nr = ar * sr - ai * si + rr, ni = ar * si + ai * sr + ri; sr = nr; si = ni;
        }
        TT[w * 128 + lane] = sr; TT[w * 128 + 64 + lane] = si;
        float br = ar, bi = ai;
#pragma unroll
        for (int i = 0; i < 4; ++i) { const float xr = br * br - bi * bi, xi = 2.0f * br * bi; br = xr; bi = xi; }
        __syncthreads();
        float cr = 0.f, ci = 0.f;
        for (int v = 0; v < w; ++v) { const float tr = TT[v * 128 + lane], ti = TT[v * 128 + 64 + lane]; const float nr = br * cr - bi * ci + tr, ni = br * ci + bi * cr + ti; cr = nr; ci = ni; }
        float pr = 1.f, pi = 0.f;
#pragma unroll
        for (int jj = 0; jj < 16; ++jj) {
            const int j = 16 * w + jj;
            RS[j * RS_PITCH + lane] += pr * cr - pi * ci; RS[j * RS_PITCH + 64 + lane] += pr * ci + pi * cr;
            const float nr = pr * ar - pi * ai, ni = pr * ai + pi * ar; pr = nr; pi = ni;
        }
        if (w == 7) {
            float* ore = p.out + (size_t)NTOK * DM; float* oim = ore + 16384;
            ore[(size_t)(b * 32 + g) * 64 + lane] = br * cr - bi * ci + sr; oim[(size_t)(b * 32 + g) * 64 + lane] = br * ci + bi * cr + si;
        }
    }
    __syncthreads();
    {
#pragma unroll
        for (int ks = 0; ks < 4; ++ks) {
#pragma unroll
            for (int mt = 0; mt < 8; ++mt) { const float* f = RS + (16 * mt + lr) * RS_PITCH + 32 * ks + 8 * lq;
                const bf16x8 af = pack8(*(const f32x4*)f, *(const f32x4*)(f + 4));
                acc[mt][0] = MFMA16(e0[ks], af, acc[mt][0]); acc[mt][1] = MFMA16(e1[ks], af, acc[mt][1]); }
            __builtin_amdgcn_sched_barrier(0);
        }
#pragma unroll
        for (int mt = 0; mt < 8; ++mt)
#pragma unroll
            for (int nt = 0; nt < 2; ++nt) {
                const int j = 16 * mt + lr, tau = 2 * w + nt; const size_t row = (size_t)b * 2048 + 16 * j + tau;
                const f32x4 y = acc[mt][nt];
                u32x2 o; o.x = cvt_pk_bf16(fgelu_tanh(y[0]), fgelu_tanh(y[1])); o.y = cvt_pk_bf16(fgelu_tanh(y[2]), fgelu_tanh(y[3]));
                *(u32x2*)(GY + row * 512 + g * 16 + 4 * lq) = o;
            }
    }
    __syncthreads();
}

__device__ __forceinline__ void ssm_sample_pair(const Params& p, int s0, int s1, int g, int lane) {
    const bf16_t* US = (const bf16_t*)(p.ws + WS_US);
    bf16_t* GY = (bf16_t*)(p.ws + WS_GY);
    const float* spf = (const float*)(p.ws + WS_SP);
    const int gp = g * 64 + lane;
    const int ss[2] = {s0, s1};
    const float ar = spf[SP_AR + gp], ai = spf[SP_AI + gp];
    float bbr[16], bbi[16];
#pragma unroll
    for (int i = 0; i < 4; ++i) { const f32x4 x = *(const f32x4*)(spf + SP_BBR + (size_t)gp * 16 + 4 * i), y = *(const f32x4*)(spf + SP_BBI + (size_t)gp * 16 + 4 * i);
#pragma unroll
        for (int j = 0; j < 4; ++j) { bbr[4 * i + j] = x[j]; bbi[4 * i + j] = y[j]; } }
    float hr[2], hi[2], sr[2][4], si[2][4];
    u32x4 uraw[2][4][2];
#pragma unroll
    for (int h = 0; h < 2; ++h) { hr[h] = p.in[4][(size_t)(ss[h] * 32 + g) * 64 + lane]; hi[h] = p.in[5][(size_t)(ss[h] * 32 + g) * 64 + lane];
#pragma unroll
        for (int t = 0; t < 4; ++t) { const bf16_t* up = US + (size_t)(NP + 4 * ss[h] + t) * 512 + g * 16; uraw[h][t][0] = *(const u32x4*)up; uraw[h][t][1] = *(const u32x4*)(up + 8); } }
#pragma unroll
    for (int t = 0; t < 4; ++t)
#pragma unroll
        for (int h = 0; h < 2; ++h) {
            const u32x4 u0 = uraw[h][t][0], u1 = uraw[h][t][1];
            float uu[16];
            uu[0] = bf_lo(u0.x); uu[1] = bf_hi(u0.x); uu[2] = bf_lo(u0.y); uu[3] = bf_hi(u0.y); uu[4] = bf_lo(u0.z); uu[5] = bf_hi(u0.z); uu[6] = bf_lo(u0.w); uu[7] = bf_hi(u0.w);
            uu[8] = bf_lo(u1.x); uu[9] = bf_hi(u1.x); uu[10] = bf_lo(u1.y); uu[11] = bf_hi(u1.y); uu[12] = bf_lo(u1.z); uu[13] = bf_hi(u1.z); uu[14] = bf_lo(u1.w); uu[15] = bf_hi(u1.w);
            float br = 0.f, bi = 0.f;
#pragma unroll
            for (int c = 0; c < 16; ++c) { br += bbr[c] * uu[c]; bi += bbi[c] * uu[c]; }
            const float nr = ar * hr[h] - ai * hi[h] + br, ni = ar * hi[h] + ai * hr[h] + bi; hr[h] = nr; hi[h] = ni; sr[h][t] = nr; si[h][t] = ni;
        }
    float* ore = p.out + (size_t)NTOK * DM + 16384 + 16384 + 61440; float* oim = ore + 262144;
#pragma unroll
    for (int h = 0; h < 2; ++h) { ore[(size_t)(ss[h] * 32 + g) * 64 + lane] = hr[h]; oim[(size_t)(ss[h] * 32 + g) * 64 + lane] = hi[h]; }
    float v[2][64];
#pragma unroll
    for (int c = 0; c < 16; ++c) { const float cr = p.in[18][(size_t)(g * 16 + c) * 64 + lane], ci = p.in[19][(size_t)(g * 16 + c) * 64 + lane];
#pragma unroll
        for (int h = 0; h < 2; ++h)
#pragma unroll
            for (int t = 0; t < 4; ++t) v[h][t * 16 + c] = sr[h][t] * cr - si[h][t] * ci; }
#define TR_STEP(OFF) { const bool up = (lane & OFF) != 0; _Pragma("unroll") for (int i = 0; i < OFF; ++i) _Pragma("unroll") for (int h = 0; h < 2; ++h) { const float snd = up ? v[h][i] : v[h][i + OFF], kp = up ? v[h][i + OFF] : v[h][i]; v[h][i] = kp + __shfl_xor(snd, OFF); } }
    TR_STEP(32) TR_STEP(16) TR_STEP(8) TR_STEP(4) TR_STEP(2) TR_STEP(1)
#undef TR_STEP
    const int t = lane >> 4, c = lane & 15; const float dsk = p.in[20][g * 16 + c];
#pragma unroll
    for (int h = 0; h < 2; ++h) {
        const size_t row = (size_t)NP + 4 * ss[h] + t;
        const float uval = __builtin_bit_cast(float, ((unsigned)US[row * 512 + g * 16 + c]) << 16);
        const float y = v[h][0] + dsk * uval;
        GY[row * 512 + g * 16 + c] = (bf16_t)(cvt_pk_bf16(fgelu_tanh(y), 0.f) & 0xffffu);
    }
}

constexpr int PA_PITCH = 136;
template <int KG> __device__ __forceinline__ void pool_fill(const Params& p, int r0, bf16_t* A, int tid, int nseg) {
    if ((tid >> 6) >= nseg) return;
    constexpr int WIN = 2 << KG;
    const bf16_t* UPb = (const bf16_t*)(p.ws + WS_UP);
    const int cp = tid & 63, seg = tid >> 6, ch = 128 * KG + 2 * cp, base = r0 + 16 * seg;
    constexpr float rw = 1.0f / (float)WIN;
    if (r0 < NP) {
        const int t0 = base & 2047;
        unsigned raw[WIN - 1 + 16];
#pragma unroll
        for (int e = 0; e < WIN - 1 + 16; ++e) { const int rel = e - (WIN - 1); raw[e] = (t0 + rel >= 0) ? *(const unsigned*)(UPb + (size_t)(base + rel) * 512 + ch) : 0u; }
        float s0 = 0.f, s1 = 0.f;
#pragma unroll
        for (int e = 0; e < WIN - 1; ++e) { s0 += bf_lo(raw[e]); s1 += bf_hi(raw[e]); }
#pragma unroll
        for (int i = 0; i < 16; ++i) {
            const int t = t0 + i; const float c0 = bf_lo(raw[WIN - 1 + i]), c1 = bf_hi(raw[WIN - 1 + i]);
            s0 += c0; s1 += c1;
            const float rc = (t + 1 < WIN) ? 1.0f / (float)(t + 1) : rw;
            *(unsigned*)(A + (16 * seg + i) * PA_PITCH + 2 * cp) = cvt_pk_bf16(s0 * rc - c0, s1 * rc - c1);
            s0 -= bf_lo(raw[i]); s1 -= bf_hi(raw[i]);
        }
    } else {
        const float* sp = p.in[6];
#pragma unroll
        for (int q = 0; q < 4; ++q) {
            const int r = base + 4 * q, sidx = (r - NP) >> 2;
            float e0[WIN - 1 + 4], e1[WIN - 1 + 4];
#pragma unroll
            for (int e = 0; e < WIN - 1; ++e) { const f32x2 v = *(const f32x2*)(sp + ((size_t)sidx * 15 + (15 - (WIN - 1)) + e) * 512 + ch); e0[e] = v[0]; e1[e] = v[1]; }
#pragma unroll
            for (int i = 0; i < 4; ++i) { const unsigned v = *(const unsigned*)(UPb + (size_t)(r + i) * 512 + ch); e0[WIN - 1 + i] = bf_lo(v); e1[WIN - 1 + i] = bf_hi(v); }
            float s0 = 0.f, s1 = 0.f;
#pragma unroll
            for (int e = 0; e < WIN - 1; ++e) { s0 += e0[e]; s1 += e1[e]; }
#pragma unroll
            for (int i = 0; i < 4; ++i) {
                const float c0 = e0[WIN - 1 + i], c1 = e1[WIN - 1 + i];
                s0 += c0; s1 += c1;
                *(unsigned*)(A + (16 * seg + 4 * q + i) * PA_PITCH + 2 * cp) = cvt_pk_bf16(s0 * rw - c0, s1 * rw - c1);
                s0 -= e0[i]; s1 -= e1[i];
            }
        }
    }
}
template <int KG> __device__ __forceinline__ void pool_fill2(const Params& p, int r0a, int r0b, bf16_t* A, int tid) {
    constexpr int WIN = 2 << KG, NR = WIN - 1 + 16;
    const bf16_t* UPb = (const bf16_t*)(p.ws + WS_UP);
    const int cp = tid & 63, seg = tid >> 6, ch = 128 * KG + 2 * cp;
    constexpr float rw = 1.0f / (float)WIN;
    unsigned raw[2][NR];
#pragma unroll
    for (int h = 0; h < 2; ++h) { const int base = (h ? r0b : r0a) + 16 * seg, t0 = base & 2047;
#pragma unroll
        for (int e = 0; e < NR; ++e) { const int rel = e - (WIN - 1); raw[h][e] = (t0 + rel >= 0) ? *(const unsigned*)(UPb + (size_t)(base + rel) * 512 + ch) : 0u; } }
#pragma unroll
    for (int h = 0; h < 2; ++h) { const int base = (h ? r0b : r0a) + 16 * seg, t0 = base & 2047;
        float s0 = 0.f, s1 = 0.f;
#pragma unroll
        for (int e = 0; e < WIN - 1; ++e) { s0 += bf_lo(raw[h][e]); s1 += bf_hi(raw[h][e]); }
#pragma unroll
        for (int i = 0; i < 16; ++i) {
            const int t = t0 + i; const float c0 = bf_lo(raw[h][WIN - 1 + i]), c1 = bf_hi(raw[h][WIN - 1 + i]);
            s0 += c0; s1 += c1;
            const float rc = (t + 1 < WIN) ? 1.0f / (float)(t + 1) : rw;
            *(unsigned*)(A + (h * 128 + 16 * seg + i) * PA_PITCH + 2 * cp) = cvt_pk_bf16(s0 * rc - c0, s1 * rc - c1);
            s0 -= bf_lo(raw[h][i]); s1 -= bf_hi(raw[h][i]);
        }
    }
}
__device__ __forceinline__ void pool_pair(const Params& p, int rt, int k, unsigned char* lds, int tid) {
    const int lane = tid & 63, w8 = tid >> 6, lr = lane & 15, lq = lane >> 4;
    bf16_t* A = (bf16_t*)lds;
    const bf16_t* Wb = (const bf16_t*)(p.ws + WS_WPOOL) + ((size_t)k * 256 + 32 * w8 + lr) * 128 + 8 * lq;
    bf16x8 b0[4], b1[4];
#pragma unroll
    for (int ks = 0; ks < 4; ++ks) { b0[ks] = *(const bf16x8*)(Wb + 32 * ks); b1[ks] = *(const bf16x8*)(Wb + 16 * 128 + 32 * ks); }
    const int colb = k * 256 + 32 * w8 + 4 * lq;
    const f32x4 ps0 = *(const f32x4*)(p.in[23] + colb), ps1 = *(const f32x4*)(p.in[23] + colb + 16);
    const int r0a = rt * 128, r0b = (rt + 64) * 128;
    if (k == 0) pool_fill2<0>(p, r0a, r0b, A, tid); else if (k == 1) pool_fill2<1>(p, r0a, r0b, A, tid); else if (k == 2) pool_fill2<2>(p, r0a, r0b, A, tid); else pool_fill2<3>(p, r0a, r0b, A, tid);
    const bf16_t* SGP = (const bf16_t*)(p.ws + WS_SGP); bf16_t* ZS = (bf16_t*)(p.ws + WS_ZS);
    __syncthreads();
#pragma unroll 1
    for (int h = 0; h < 2; ++h) {
        const int r0 = h ? r0b : r0a;
        u32x2 sg[8][2];
#pragma unroll
        for (int mt = 0; mt < 8; ++mt) { const size_t off = (size_t)(r0 + 16 * mt + lr) * 1024 + colb; sg[mt][0] = *(const u32x2*)(SGP + off); sg[mt][1] = *(const u32x2*)(SGP + off + 16); }
        f32x4 acc[8][2];
#pragma unroll
        for (int i = 0; i < 8; ++i) { acc[i][0] = (f32x4){0.f, 0.f, 0.f, 0.f}; acc[i][1] = (f32x4){0.f, 0.f, 0.f, 0.f}; }
#pragma unroll
        for (int ks = 0; ks < 4; ++ks) {
#pragma unroll
            for (int mt = 0; mt < 8; ++mt) { const bf16x8 af = *(const bf16x8*)(A + (h * 128 + 16 * mt + lr) * PA_PITCH + 32 * ks + 8 * lq);
                acc[mt][0] = MFMA16(b0[ks], af, acc[mt][0]); acc[mt][1] = MFMA16(b1[ks], af, acc[mt][1]); }
            __builtin_amdgcn_sched_barrier(0);
        }
#pragma unroll
        for (int mt = 0; mt < 8; ++mt) {
            const size_t off = (size_t)(r0 + 16 * mt + lr) * 1024 + colb;
            const f32x4 z0 = acc[mt][0], z1 = acc[mt][1];
            u32x2 o; o.x = cvt_pk_bf16(z0[0] * ps0[0] * bf_lo(sg[mt][0].x), z0[1] * ps0[1] * bf_hi(sg[mt][0].x)); o.y = cvt_pk_bf16(z0[2] * ps0[2] * bf_lo(sg[mt][0].y), z0[3] * ps0[3] * bf_hi(sg[mt][0].y));
            *(u32x2*)(ZS + off) = o;
            o.x = cvt_pk_bf16(z1[0] * ps1[0] * bf_lo(sg[mt][1].x), z1[1] * ps1[1] * bf_hi(sg[mt][1].x)); o.y = cvt_pk_bf16(z1[2] * ps1[2] * bf_lo(sg[mt][1].y), z1[3] * ps1[3] * bf_hi(sg[mt][1].y));
            *(u32x2*)(ZS + off + 16) = o;
        }
    }
    __syncthreads();
}
template <int MT> __device__ __forceinline__ void pool_unit(const Params& p, int r0, int k, unsigned char* lds, int tid) {
    const int lane = tid & 63, w8 = tid >> 6, lr = lane & 15, lq = lane >> 4;
    bf16_t* A = (bf16_t*)lds;
    const bf16_t* Wb = (const bf16_t*)(p.ws + WS_WPOOL) + ((size_t)k * 256 + 32 * w8 + lr) * 128 + 8 * lq;
    bf16x8 b0[4], b1[4];
#pragma unroll
    for (int ks = 0; ks < 4; ++ks) { b0[ks] = *(const bf16x8*)(Wb + 32 * ks); b1[ks] = *(const bf16x8*)(Wb + 16 * 128 + 32 * ks); }
    if (k == 0) pool_fill<0>(p, r0, A, tid, MT); else if (k == 1) pool_fill<1>(p, r0, A, tid, MT); else if (k == 2) pool_fill<2>(p, r0, A, tid, MT); else pool_fill<3>(p, r0, A, tid, MT);
    __syncthreads();
    f32x4 acc[MT][2];
#pragma unroll
    for (int i = 0; i < MT; ++i) { acc[i][0] = (f32x4){0.f, 0.f, 0.f, 0.f}; acc[i][1] = (f32x4){0.f, 0.f, 0.f, 0.f}; }
#pragma unroll
    for (int ks = 0; ks < 4; ++ks) {
#pragma unroll
        for (int mt = 0; mt < MT; ++mt) { const bf16x8 af = *(const bf16x8*)(A + (16 * mt + lr) * PA_PITCH + 32 * ks + 8 * lq);
            acc[mt][0] = MFMA16(b0[ks], af, acc[mt][0]); acc[mt][1] = MFMA16(b1[ks], af, acc[mt][1]); }
    }
    const bf16_t* SGP = (const bf16_t*)(p.ws + WS_SGP); bf16_t* ZS = (bf16_t*)(p.ws + WS_ZS);
#pragma unroll
    for (int nt = 0; nt < 2; ++nt) {
        const int col = k * 256 + 32 * w8 + 16 * nt + 4 * lq;
        const f32x4 ps = *(const f32x4*)(p.in[23] + col);
#pragma unroll
        for (int mt = 0; mt < MT; ++mt) {
            const size_t off = (size_t)(r0 + 16 * mt + lr) * 1024 + col;
            const u32x2 sg = *(const u32x2*)(SGP + off); const f32x4 z = acc[mt][nt];
            u32x2 o; o.x = cvt_pk_bf16(z[0] * ps[0] * bf_lo(sg.x), z[1] * ps[1] * bf_hi(sg.x)); o.y = cvt_pk_bf16(z[2] * ps[2] * bf_lo(sg.y), z[3] * ps[3] * bf_hi(sg.y));
            *(u32x2*)(ZS + off) = o;
        }
    }
    __syncthreads();
}

template <int NT> __device__ __forceinline__ void skinny_unit(const bf16_t* A, int lda, const bf16_t* Bt, int ldb, int K, int arow0, const int (&brow)[NT], unsigned char* lds, int tid) {
    const int lane = tid & 63, w = tid >> 6, lr = lane & 15, lq = lane >> 4, kper = K >> 3, k0 = w * kper;
    constexpr int TW = 16 * NT;
    float* red = (float*)lds;
    f32x4 acc[4][NT];
#pragma unroll
    for (int i = 0; i < 4; ++i)
#pragma unroll
        for (int n = 0; n < NT; ++n) acc[i][n] = (f32x4){0.f, 0.f, 0.f, 0.f};
    const bf16_t* Ap = A + (size_t)(arow0 + lr) * lda + k0 + 8 * lq;
    const bf16_t* Bp[NT];
#pragma unroll
    for (int n = 0; n < NT; ++n) Bp[n] = Bt + (size_t)(brow[n] + lr) * ldb + k0 + 8 * lq;
    const int nks = kper >> 5;
    int ks = 0;
    for (; ks + 2 <= nks; ks += 2) {
        bf16x8 bf[2][NT], af[2][4];
#pragma unroll
        for (int u = 0; u < 2; ++u) {
#pragma unroll
            for (int n = 0; n < NT; ++n) bf[u][n] = *(const bf16x8*)(Bp[n] + 32 * (ks + u));
#pragma unroll
            for (int mt = 0; mt < 4; ++mt) af[u][mt] = *(const bf16x8*)(Ap + (size_t)(16 * mt) * lda + 32 * (ks + u)); }
#pragma unroll
        for (int u = 0; u < 2; ++u)
#pragma unroll
            for (int mt = 0; mt < 4; ++mt)
#pragma unroll
                for (int n = 0; n < NT; ++n) acc[mt][n] = MFMA16(bf[u][n], af[u][mt], acc[mt][n]);
    }
    for (; ks < nks; ++ks) {
        bf16x8 bf[NT];
#pragma unroll
        for (int n = 0; n < NT; ++n) bf[n] = *(const bf16x8*)(Bp[n] + 32 * ks);
#pragma unroll
        for (int mt = 0; mt < 4; ++mt) { const bf16x8 af = *(const bf16x8*)(Ap + (size_t)(16 * mt) * lda + 32 * ks);
#pragma unroll
            for (int n = 0; n < NT; ++n) acc[mt][n] = MFMA16(bf[n], af, acc[mt][n]); }
    }
#pragma unroll
    for (int mt = 0; mt < 4; ++mt)
#pragma unroll
        for (int n = 0; n < NT; ++n) *(f32x4*)(red + ((size_t)(w * 64 + 16 * mt + lr)) * TW + 16 * n + 4 * lq) = acc[mt][n];
    __syncthreads();
#pragma unroll
    for (int q = 0; q < NT / 2; ++q) {
        const int o = (q * 512 + tid) * 4;
        f32x4 s = *(const f32x4*)(red + o);
#pragma unroll
        for (int v = 1; v < 8; ++v) s += *(const f32x4*)(red + v * 64 * TW + o);
        *(f32x4*)(red + o) = s;
    }
    __syncthreads();
}
__device__ __forceinline__ void skinny_wide96(const bf16_t* A, const bf16_t* Bt, int arow0, int bcol0, unsigned char* lds, int tid) {
    const int lane = tid & 63, w = tid >> 6, lr = lane & 15, lq = lane >> 4, kq = w & 3, mh = w >> 2, k0 = kq * 256;
    float* red = (float*)lds;
    f32x4 acc[2][6];
#pragma unroll
    for (int i = 0; i < 2; ++i)
#pragma unroll
        for (int n = 0; n < 6; ++n) acc[i][n] = (f32x4){0.f, 0.f, 0.f, 0.f};
    const bf16_t* Ap = A + (size_t)(arow0 + 32 * mh + lr) * 1024 + k0 + 8 * lq;
    const bf16_t* Bp = Bt + (size_t)(bcol0 + lr) * 1024 + k0 + 8 * lq;
#pragma unroll 1
    for (int ks = 0; ks < 8; ks += 2) {
        bf16x8 bf[2][6], af[2][2];
#pragma unroll
        for (int u = 0; u < 2; ++u) {
#pragma unroll
            for (int n = 0; n < 6; ++n) bf[u][n] = *(const bf16x8*)(Bp + (size_t)(16 * n) * 1024 + 32 * (ks + u));
#pragma unroll
            for (int mt = 0; mt < 2; ++mt) af[u][mt] = *(const bf16x8*)(Ap + (size_t)(16 * mt) * 1024 + 32 * (ks + u)); }
#pragma unroll
        for (int u = 0; u < 2; ++u)
#pragma unroll
            for (int mt = 0; mt < 2; ++mt)
#pragma unroll
                for (int n = 0; n < 6; ++n) acc[mt][n] = MFMA16(bf[u][n], af[u][mt], acc[mt][n]);
    }
#pragma unroll
    for (int mt = 0; mt < 2; ++mt)
#pragma unroll
        for (int n = 0; n < 6; ++n) *(f32x4*)(red + ((size_t)(kq * 64 + 32 * mh + 16 * mt + lr)) * 96 + 16 * n + 4 * lq) = acc[mt][n];
    __syncthreads();
#pragma unroll
    for (int q = 0; q < 3; ++q) {
        const int o = (q * 512 + tid) * 4;
        const f32x4 s = (*(const f32x4*)(red + o) + *(const f32x4*)(red + 6144 + o)) + (*(const f32x4*)(red + 2 * 6144 + o) + *(const f32x4*)(red + 3 * 6144 + o));
        *(f32x4*)(red + o) = s;
    }
    __syncthreads();
}
#define LAS __attribute__((address_space(3)))
#define XB_TMO      128
#define XB_XCNT(j)  (256  + 64 * (j))
#define XB_XSUB(j)  (1280 + 64 * (j))
#define XB_XGEN(j)  (2304 + 64 * (j))
#define XB_TOP      3328
#define XB_TOPGEN   3392
#define XCD_BAR_WORDS 3456
#define XB_SPIN_CAP (1u << 18)

__device__ __forceinline__ unsigned xb_ld(unsigned* p)              { return __hip_atomic_load(p, __ATOMIC_RELAXED, __HIP_MEMORY_SCOPE_AGENT); }
__device__ __forceinline__ unsigned xb_add(unsigned* p, unsigned v) { return __hip_atomic_fetch_add(p, v, __ATOMIC_RELAXED, __HIP_MEMORY_SCOPE_AGENT); }
__device__ __forceinline__ unsigned xb_xcc_id() { return (unsigned)__builtin_amdgcn_s_getreg((3 << 11) | 20) & 0xFu; }
#define XB_SPIN(cond, bar) do { unsigned _sp = 0; while (cond) { __builtin_amdgcn_s_sleep(1); \
    if ((++_sp & 255u) == 0u) { if (xb_ld(&(bar)[XB_TMO])) break; if (_sp > XB_SPIN_CAP) { atomicAdd(&(bar)[XB_TMO], 1u); break; } } } } while (0)

struct XcdBarrier {
    unsigned* bar; unsigned x;
    volatile LAS unsigned* st;
};

__device__ __forceinline__ XcdBarrier xcd_barrier_post(unsigned* bar, volatile LAS unsigned* st) {
    XcdBarrier b; b.bar = bar; b.x = xb_xcc_id(); b.st = st;
    if (threadIdx.x == 0) (void)xb_add(&bar[XB_XCNT(b.x)], 1u);
    return b;
}
__device__ __forceinline__ void xcd_barrier_complete(unsigned* bar, unsigned x, unsigned& nloc, unsigned& nx) {
    const unsigned G = gridDim.x * gridDim.y * gridDim.z;
    unsigned sum, cnt, mine, sp = 0u;
    for (;;) {
        sum = 0u; cnt = 0u; mine = 0u;
#pragma unroll
        for (unsigned j = 0; j < 16; ++j) { const unsigned c = xb_ld(&bar[XB_XCNT(j)]); sum += c; cnt += (c > 0u) ? 1u : 0u; mine = (j == x) ? c : mine; }
        if (sum == G) break;
        __builtin_amdgcn_s_sleep(1);
        if ((++sp & 255u) == 0u) { if (xb_ld(&bar[XB_TMO])) break; if (sp > XB_SPIN_CAP) { atomicAdd(&bar[XB_TMO], 1u); break; } }
    }
    nloc = mine > 0u ? mine : 1u; nx = cnt > 0u ? cnt : 1u;
}

__device__ __forceinline__ void xcd_barrier(const XcdBarrier& b) {
    asm volatile("s_waitcnt vmcnt(0)" ::: "memory");
    __syncthreads();
    if (threadIdx.x == 0) {
        unsigned* bar = b.bar;
        __builtin_amdgcn_s_waitcnt(0);
        unsigned nloc = b.st[0], nx = b.st[1];
        if (nloc == 0u) { xcd_barrier_complete(bar, b.x, nloc, nx); b.st[0] = nloc; b.st[1] = nx; }
        const unsigned old = xb_add(&bar[XB_XSUB(b.x)], 1u);
        const unsigned gen = old / nloc;
        if (old + 1u == (gen + 1u) * nloc) {
            __builtin_amdgcn_fence(__ATOMIC_RELEASE, "agent");
            asm volatile("s_waitcnt vmcnt(0)" ::: "memory");
            const unsigned og = xb_add(&bar[XB_TOP], 1u);
            const unsigned tg = og / nx;
            if (og + 1u == (tg + 1u) * nx) xb_add(&bar[XB_TOPGEN], 1u);
            else XB_SPIN(xb_ld(&bar[XB_TOPGEN]) == tg, bar);
            __builtin_amdgcn_fence(__ATOMIC_ACQUIRE, "agent");
            xb_add(&bar[XB_XGEN(b.x)], 1u);
            asm volatile("s_waitcnt vmcnt(0)" ::: "memory");
        } else {
            XB_SPIN(xb_ld(&bar[XB_XGEN(b.x)]) == gen, bar);
            __builtin_amdgcn_fence(__ATOMIC_ACQUIRE, "agent");
            asm volatile("s_waitcnt vmcnt(0)" ::: "memory");
        }
    }
    __syncthreads();
}

constexpr int MISC_OFF = LDS_BYTES - 64;
constexpr size_t WS_BAR = 0;
#ifndef PG_ALIGN
#define PG_ALIGN true
#endif
#ifndef PG_SP2
#define PG_SP2 true
#endif
#ifndef REP3A
#define REP3A 1
#endif
#ifndef REP3B
#define REP3B 1
#endif
#ifndef REP3C
#define REP3C 1
#endif
#ifndef REP0
#define REP0 1
#endif
#ifndef REP1
#define REP1 1
#endif
#ifndef REP2
#define REP2 1
#endif
#ifndef REP3
#define REP3 1
#endif
#ifndef REP4
#define REP4 1
#endif
#ifndef REP5
#define REP5 1
#endif
#ifndef REP6
#define REP6 1
#endif
#ifndef REP7
#define REP7 1
#endif
#ifndef REP8
#define REP8 1
#endif
#ifndef REP9
#define REP9 1
#endif
__global__ void __launch_bounds__(512, 2) mk_fwd(Params p) {
    extern __shared__ __attribute__((aligned(16))) unsigned char lds[];
    cg::grid_group grid = cg::this_grid();
    const int tid = threadIdx.x, lane = tid & 63, wave = __builtin_amdgcn_readfirstlane(tid >> 6), G = gridDim.x, bid = blockIdx.x;
    const int gw = bid * 8 + wave, NGW = G * 8;
    PG8_LAS unsigned char* ldsg = (PG8_LAS unsigned char*)lds;
    float* mod = (float*)(p.ws + WS_MOD);
    float* out = p.out;
    if (tid < 16) ((volatile LAS unsigned*)(ldsg + MISC_OFF))[tid] = 0u;
    __syncthreads();
    XcdBarrier xbar = xcd_barrier_post((unsigned*)(p.ws + WS_BAR), (volatile LAS unsigned*)(ldsg + MISC_OFF));
    if (p.ph_hi > 1000) grid.sync();
#define IN(k) (p.ph_lo <= (k) && (k) < p.ph_hi)
#define GSYNC() xcd_barrier(xbar)
#define SEAM(k) do { if (IN(k) && IN((k) + 1)) GSYNC(); } while (0)

#ifdef EXTRA_SYNCS
    for (int i_ = 0; i_ < EXTRA_SYNCS; ++i_) GSYNC();
#endif
    if (IN(0)) for (int rep_ = 0; rep_ < REP0; ++rep_) { if (rep_) GSYNC();
        for (int u = bid; u < 192; u += G) ada_unit(p, u, lds, tid);
        float* scr = (float*)lds + wave * (64 * 33);
        {
            const bool freeblk = bid >= 192;
            constexpr int NIT0 = TR_ITEMS[0] + TR_ITEMS[1] + TR_ITEMS[5];
            const int nmine = (G == 256) ? (freeblk ? 2 : 1) : (NIT0 + NGW - 1) / NGW;
            for (int i = 0; i < nmine; ++i) {
                int r = (G == 256) ? (freeblk ? i * 512 + (gw - 1536) : 1024 + gw) : i * NGW + gw;
                if (r < TR_ITEMS[0]) tr_item(p, 0, r, scr, lane);
                else if ((r -= TR_ITEMS[0]) < TR_ITEMS[1]) tr_item(p, 1, r, scr, lane);
                else if ((r -= TR_ITEMS[1]) < TR_ITEMS[5]) tr_item(p, 5, r, scr, lane);
            }
        }
        {
            float* spool = out + (size_t)NTOK * DM + 16384 + 16384 + 61440 + 262144 + 262144;
            const float* sp = p.in[6];
            for (int i = bid * 512 + tid; i < 128 * 11 * 128; i += G * 512) { const int s = i / (11 * 128), q = i % (11 * 128);
                *(f32x4*)(spool + (size_t)s * 15 * 512 + 4 * q) = *(const f32x4*)(sp + (size_t)s * 15 * 512 + 4 * 512 + 4 * q); }
        }
    }
    SEAM(0);
    const int rpb_ = (NTOK + G - 1) / G;
    const int p1_beg = (G == 256) ? (bid < 96 ? 44 * bid : 4224 + 80 * (bid - 96)) : (bid * rpb_ < NTOK ? bid * rpb_ : NTOK);
    const int p1_end = (G == 256) ? (bid < 96 ? 44 * bid + 44 : (4224 + 80 * (bid - 95) < NTOK ? 4224 + 80 * (bid - 95) : NTOK)) : (bid * rpb_ + rpb_ < NTOK ? bid * rpb_ + rpb_ : NTOK);
    if (IN(1)) for (int rep_ = 0; rep_ < REP1; ++rep_) { if (rep_) GSYNC(); for (int u = bid; u < 96; u += G) ssm_prep_unit(p, u / 3, u % 3, lds, tid); modnorm_rows<false>(p.in[0], p.in[1], p.in[7], mod, 0, 1, (bf16_t*)(p.ws + WS_H), p1_beg, p1_end, wave, lane); }
    SEAM(1);
    if (IN(2)) for (int rep_ = 0; rep_ < REP2; ++rep_) { if (rep_) GSYNC();
        pg8::Gemm g{(const bf16_t*)(p.ws + WS_H), (const bf16_t*)(p.ws + WS_WIN), NP, 3072, 1024}; pg8::StaticOrder S; S.init(NP, 3072, G, bid);
        EpiG1 E{(bf16_t*)(p.ws + WS_US), (bf16_t*)(p.ws + WS_UP), (bf16_t*)(p.ws + WS_SGS), (bf16_t*)(p.ws + WS_SGP),
                out + (size_t)NTOK * DM + 32768, out + (size_t)NTOK * DM + 32768 + 61440 + 524288};
        pg8::gemm_phase<EpiG1, pg8::StaticOrder, PG_ALIGN, PG_SP2>(ldsg, g, S, E);
#ifdef DUP2
        GSYNC(); pg8::gemm_phase<EpiG1, pg8::StaticOrder, PG_ALIGN, PG_SP2>(ldsg, g, S, E);
#endif
        for (int u = bid; u < 256; u += G) {
            const int rt = u >> 5, ct = u & 31;
            skinny_wide96((const bf16_t*)(p.ws + WS_H), (const bf16_t*)(p.ws + WS_WIN), NP + 64 * rt, 96 * ct, lds, tid);
            for (int e8 = tid; e8 < 768; e8 += 512) {
                const int row = e8 / 12, c8 = (e8 % 12) * 8, col = 96 * ct + c8;
                const float* tp = (const float*)lds + row * 96 + c8;
                E.emit(NP + 64 * rt + row, col, col >> 8, *(const f32x4*)tp, *(const f32x4*)(tp + 4));
            }
            __syncthreads();
        }
    }
    SEAM(2);
    if (IN(3)) for (int rep_ = 0; rep_ < REP3; ++rep_) { if (rep_) GSYNC();
        for (int ra_ = 0; ra_ < REP3A; ++ra_) for (int u = bid; u < 256; u += G) {
            int ub = u >> 5, ug = u & 31;
            if (G == 256) { const int x = u & 7, y = u >> 3, quad = x + 8 * (y >> 2); ub = quad >> 3; ug = 4 * (quad & 7) + (y & 3); }
            ssm_block(p, ub, ug, lds, tid); }
        for (int rb_ = 0; rb_ < REP3B; ++rb_) { for (int u = bid; u < 256; u += G) pool_pair(p, u >> 2, u & 3, lds, tid); for (int u = G - 1 - bid; u < 64; u += G) pool_unit<2>(p, NP + 32 * (u >> 2), u & 3, lds, tid); }
        for (int rc_ = 0; rc_ < REP3C; ++rc_) for (int it = gw; it < 64 * 32; it += NGW) ssm_sample_pair(p, it >> 5, 64 + (it >> 5), it & 31, lane);
        {
            float* scr = (float*)lds + wave * (64 * 33);
            for (int it = gw; it < TR_ITEMS[2] + TR_ITEMS[3]; it += NGW) { if (it < TR_ITEMS[2]) tr_item(p, 2, it, scr, lane); else tr_item(p, 3, it - TR_ITEMS[2], scr, lane); }
        }
    }
    SEAM(3);
    if (IN(4)) for (int rep_ = 0; rep_ < REP4; ++rep_) { if (rep_) GSYNC();
        pg8::Gemm g{(const bf16_t*)(p.ws + WS_GY), (const bf16_t*)(p.ws + WS_WGLU), NP, 2048, 512}; pg8::StaticOrder S; S.init(NP, 2048, G, bid);
        EpiGLU E{(const bf16_t*)(p.ws + WS_SGS), (const bf16_t*)(p.ws + WS_ZS), (bf16_t*)(p.ws + WS_H)};
        pg8::gemm_phase<EpiGLU, pg8::StaticOrder, PG_ALIGN, PG_SP2>(ldsg, g, S, E);
        for (int u = bid; u < 256; u += G) {
            const int rt = u >> 5, jt = u & 31, j0 = 32 * jt, ra = 256 * (j0 >> 7) + (j0 & 127);
            const int br_[4] = {ra, ra + 16, ra + 128, ra + 144};
            skinny_unit<4>((const bf16_t*)(p.ws + WS_GY), 512, (const bf16_t*)(p.ws + WS_WGLU), 512, 512, NP + 64 * rt, br_, lds, tid);
            const float* tp = (const float*)lds + (tid >> 3) * 64 + (tid & 7) * 4;
            const f32x4 a = *(const f32x4*)tp, b = *(const f32x4*)(tp + 32);
            const size_t off = (size_t)(NP + 64 * rt + (tid >> 3)) * 1024 + j0 + (tid & 7) * 4;
            const u32x2 sg = *(const u32x2*)(E.SGS + off), zs = *(const u32x2*)(E.ZS + off);
            u32x2 o;
            o.x = cvt_pk_bf16(bf_lo(sg.x) * a[0] * fsigmoid(b[0]) + bf_lo(zs.x), bf_hi(sg.x) * a[1] * fsigmoid(b[1]) + bf_hi(zs.x));
            o.y = cvt_pk_bf16(bf_lo(sg.y) * a[2] * fsigmoid(b[2]) + bf_lo(zs.y), bf_hi(sg.y) * a[3] * fsigmoid(b[3]) + bf_hi(zs.y));
            *(u32x2*)(E.MGD + off) = o;
            __syncthreads();
        }
    }
    SEAM(4);
    if (IN(5)) for (int rep_ = 0; rep_ < REP5; ++rep_) { if (rep_) GSYNC();
        pg8::Gemm g{(const bf16_t*)(p.ws + WS_H), (const bf16_t*)(p.ws + WS_WOUT), NP, 1024, 1024}; pg8::StaticOrder S; S.init(NP, 1024, G, bid);
        EpiRes<0> E{p.in[0], nullptr, mod + 2 * DM, (bf16_t*)(p.ws + WS_XB)};
        pg8::gemm_phase<EpiRes<0>, pg8::StaticOrder, PG_ALIGN, PG_SP2>(ldsg, g, S, E);
        for (int u = bid; u < 256; u += G) {
            const int rt = u >> 5, ct = u & 31;
            const int br_[2] = {32 * ct, 32 * ct + 16};
            skinny_unit<2>((const bf16_t*)(p.ws + WS_H), 1024, (const bf16_t*)(p.ws + WS_WOUT), 1024, 1024, NP + 64 * rt, br_, lds, tid);
            const int row = 64 * rt + (tid >> 3), col = 32 * ct + 4 * (tid & 7), r = NP + row;
            const f32x4 a = *(const f32x4*)((const float*)lds + tid * 4);
            const f32x4 x = *(const f32x4*)(p.in[1] + (size_t)row * DM + col), gt = *(const f32x4*)(mod + (size_t)mrow(r) * 6144 + 2 * DM + col);
            { const f32x4 v = x + gt * a; u32x2 wv; wv.x = cvt_pk_bf16(v[0], v[1]); wv.y = cvt_pk_bf16(v[2], v[3]); *(u32x2*)((bf16_t*)(p.ws + WS_XB) + (size_t)r * DM + col) = wv; }
            __syncthreads();
        }
    }
    SEAM(5);
    if (IN(6)) for (int rep_ = 0; rep_ < REP6; ++rep_) { if (rep_) GSYNC(); modnorm_rows<true>((const float*)(p.ws + WS_XB), nullptr, p.in[8], mod, 3, 4, (bf16_t*)(p.ws + WS_H), (bid * rpb_ < NTOK ? bid * rpb_ : NTOK), (bid * rpb_ + rpb_ < NTOK ? bid * rpb_ + rpb_ : NTOK), wave, lane); }
    SEAM(6);
    if (IN(7)) for (int rep_ = 0; rep_ < REP7; ++rep_) { if (rep_) GSYNC();
        pg8::Gemm g{(const bf16_t*)(p.ws + WS_H), (const bf16_t*)(p.ws + WS_WFI), NTOK, 2 * DFF, 1024}; pg8::StaticOrder S; S.init(NTOK, 2 * DFF, G, bid);
        EpiSwiGLU E{(bf16_t*)(p.ws + WS_ACT)};
        pg8::gemm_phase<EpiSwiGLU, pg8::StaticOrder, PG_ALIGN, PG_SP2>(ldsg, g, S, E);
#ifdef DUP7
        GSYNC(); pg8::gemm_phase<EpiSwiGLU, pg8::StaticOrder, PG_ALIGN, PG_SP2>(ldsg, g, S, E);
#endif
        {
            const int nun = (NTOK / 256) * (2 * DFF / 256), full = nun / G, rem = nun % G;
            if (rem != 0 && bid >= rem) { float* scr = (float*)lds + wave * (64 * 33); const int nidle = (G - rem) * 8;
                for (int it = (bid - rem) * 8 + wave; it < TR_ITEMS[4]; it += nidle) tr_item(p, 4, it, scr, lane); }
            else if (rem == 0) { float* scr = (float*)lds + wave * (64 * 33); for (int it = gw; it < TR_ITEMS[4]; it += NGW) tr_item(p, 4, it, scr, lane); }
            (void)full;
        }
    }
    SEAM(7);
    if (IN(8)) for (int rep_ = 0; rep_ < REP8; ++rep_) { if (rep_) GSYNC();
        pg8::Gemm g{(const bf16_t*)(p.ws + WS_ACT), (const bf16_t*)(p.ws + WS_WFO), NP, 1024, DFF}; pg8::StaticOrder S; S.init(NP, 1024, G, bid);
        EpiRes<1> E{nullptr, (const bf16_t*)(p.ws + WS_XB), mod + 5 * DM, (bf16_t*)(p.ws + WS_H)};
        pg8::gemm_phase<EpiRes<1>, pg8::StaticOrder, PG_ALIGN, PG_SP2>(ldsg, g, S, E);
#ifdef DUP8
        GSYNC(); pg8::gemm_phase<EpiRes<1>, pg8::StaticOrder, PG_ALIGN, PG_SP2>(ldsg, g, S, E);
#endif
        for (int u = bid; u < 256; u += G) {
            const int rt = u >> 5, ct = u & 31;
            const int br_[2] = {32 * ct, 32 * ct + 16};
            skinny_unit<2>((const bf16_t*)(p.ws + WS_ACT), DFF, (const bf16_t*)(p.ws + WS_WFO), DFF, DFF, NP + 64 * rt, br_, lds, tid);
            const int row = 64 * rt + (tid >> 3), col = 32 * ct + 4 * (tid & 7), r = NP + row;
            const f32x4 a = *(const f32x4*)((const float*)lds + tid * 4);
            const u32x2 xq = *(const u32x2*)((const bf16_t*)(p.ws + WS_XB) + (size_t)r * DM + col);
            const f32x4 x = (f32x4){bf_lo(xq.x), bf_hi(xq.x), bf_lo(xq.y), bf_hi(xq.y)}, gt = *(const f32x4*)(mod + (size_t)mrow(r) * 6144 + 5 * DM + col);
            { const f32x4 v = x + gt * a; u32x2 wv; wv.x = cvt_pk_bf16(v[0], v[1]); wv.y = cvt_pk_bf16(v[2], v[3]); *(u32x2*)((bf16_t*)(p.ws + WS_H) + (size_t)r * DM + col) = wv; }
            __syncthreads();
        }
    }
    SEAM(8);
    if (IN(9)) for (int rep_ = 0; rep_ < REP9; ++rep_) { if (rep_) GSYNC();
        const float* gf = p.in[9];
        f32x4 gg[4];
#pragma unroll
        for (int j = 0; j < 4; ++j) gg[j] = *(const f32x4*)(gf + 4 * lane + 256 * j);
        for (int r0 = gw; r0 < NTOK; r0 += 2 * NGW) {
            const int rr[2] = {r0, (r0 + NGW < NTOK) ? r0 + NGW : r0};
            f32x4 v[2][4]; float s[2];
#pragma unroll
            for (int h = 0; h < 2; ++h) { const bf16_t* xbr = (const bf16_t*)(p.ws + WS_H) + (size_t)rr[h] * DM + 4 * lane;
#pragma unroll
                for (int j = 0; j < 4; ++j) { const u32x2 q = *(const u32x2*)(xbr + 256 * j); v[h][j] = (f32x4){bf_lo(q.x), bf_hi(q.x), bf_lo(q.y), bf_hi(q.y)}; } }
#pragma unroll
            for (int h = 0; h < 2; ++h) { s[h] = 0.f;
#pragma unroll
                for (int j = 0; j < 4; ++j) s[h] += (v[h][j][0] * v[h][j][0] + v[h][j][1] * v[h][j][1]) + (v[h][j][2] * v[h][j][2] + v[h][j][3] * v[h][j][3]); }
#pragma unroll
            for (int o = 1; o < 64; o <<= 1) { s[0] += __shfl_xor(s[0], o); s[1] += __shfl_xor(s[1], o); }
#pragma unroll
            for (int h = 0; h < 2; ++h) if (h == 0 || rr[1] != rr[0]) {
                const float inv = rsqrtf(s[h] * (1.0f / DM) + EPS); float* xr = out + (size_t)rr[h] * DM + 4 * lane;
#pragma unroll
                for (int j = 0; j < 4; ++j) *(f32x4*)(xr + 256 * j) = (v[h][j] * inv) * gg[j];
            }
        }
    }
#undef IN
#undef SEAM
}

#ifndef MK_N_LAUNCHES
#define MK_N_LAUNCHES 1
#endif
extern "C" void kernel_launch(void* const* d_in, const int* in_sizes, int n_in, void* d_out, int out_size, void* d_ws, size_t ws_size, hipStream_t stream) {
    static int grid = 0;
    if (grid == 0) {
        int dev = 0, cus = 0, per_cu = 0;
        if (hipGetDevice(&dev) != hipSuccess || hipDeviceGetAttribute(&cus, hipDeviceAttributeMultiprocessorCount, dev) != hipSuccess) { fprintf(stderr, "kernel_launch: device query failed\n"); grid = -1; return; }
        if (hipFuncSetAttribute((const void*)mk_fwd, hipFuncAttributeMaxDynamicSharedMemorySize, LDS_BYTES) != hipSuccess) { fprintf(stderr, "kernel_launch: hipFuncSetAttribute failed\n"); grid = -1; return; }
        if (hipOccupancyMaxActiveBlocksPerMultiprocessor(&per_cu, (const void*)mk_fwd, 512, LDS_BYTES) != hipSuccess || per_cu < 1) { fprintf(stderr, "kernel_launch: occupancy query says %d blocks/CU\n", per_cu); (void)hipGetLastError(); grid = -1; return; }
        grid = cus * per_cu; if (grid > 256) grid = 256;
        if (n_in != 27 || ws_size < 232 * MiB) { fprintf(stderr, "kernel_launch: unexpected n_in %d / ws %zu\n", n_in, ws_size); grid = -1; return; }
    }
    if (grid < 0) return;
    if (hipMemsetAsync((char*)d_ws + WS_BAR, 0, 32768, stream) != hipSuccess) { fprintf(stderr, "kernel_launch: memset failed\n"); return; }
    Params p{};
    for (int i = 0; i < 27; ++i) p.in[i] = (const float*)d_in[i];
    p.out = (float*)d_out; p.ws = (unsigned char*)d_ws;
#if MK_N_LAUNCHES == 1
    p.ph_lo = 0; p.ph_hi = 10;
    void* args[] = {&p};
    hipError_t e = hipLaunchCooperativeKernel((const void*)mk_fwd, dim3(grid), dim3(512), args, LDS_BYTES, stream);
    if (e != hipSuccess) fprintf(stderr, "kernel_launch: cooperative launch failed: %s (grid %d)\n", hipGetErrorString(e), grid);
#else
    for (int ph = 0; ph < 10; ++ph) { p.ph_lo = ph; p.ph_hi = ph + 1; hipLaunchKernelGGL(mk_fwd, dim3(grid), dim3(512), LDS_BYTES, stream, p); }
#endif
}
```
